# Optimizing an MI355X kernel written in HIP

```python
import jax
import jax.numpy as jnp
from jax import lax
import numpy as np

D_MODEL = 2048
BATCH = 4
SEQ = 2048
DEPTH = 4

N_A_LAYERS = DEPTH // 2
N_B_LAYERS = DEPTH - N_A_LAYERS
MEM_LEN = 256
MEM_HEADS = 4
MEM_WIDTH = D_MODEL // 4
MEM_HEAD_DIM = MEM_WIDTH // MEM_HEADS
MIX_WIDTH = D_MODEL - MEM_WIDTH
LRU_WIDTH = MIX_WIDTH
LRU_BLOCKS = 12
LRU_BLOCK = LRU_WIDTH // LRU_BLOCKS
CONV_WIDTH = 4
LRU_C = 8.0
V_DIM = 128
MLA_HEADS = MIX_WIDTH // V_DIM
QK_NOPE = 128
QK_ROPE = 64
QK_DIM = QK_NOPE + QK_ROPE
Q_RANK = 512
KV_RANK = 256
ROPE_THETA = 10000.0
Q_BLOCK = 128
N_GROUPS = 8
EXPERTS_PER_GROUP = 4
TOP_K_IN_GROUP = 2
D_EXPERT = 512
EPS = 1e-6
IN_A_WIDTH = 2 * LRU_WIDTH + MEM_WIDTH
IN_B_WIDTH = Q_RANK + MEM_WIDTH
F32 = jnp.float32

kernel_name = 'hawk_mla_yoco_hier_moe_trunk'


def rmsnorm(x, g):
    xf = x.astype(F32)
    y = xf * lax.rsqrt(jnp.mean(xf * xf, axis=-1, keepdims=True) + EPS)
    return (y * g.astype(F32)).astype(x.dtype)


def rope(t, positions):
    half = QK_ROPE // 2
    inv_freq = ROPE_THETA ** (-jnp.arange(half, dtype=F32) / half)
    ang = positions.astype(F32)[..., None] * inv_freq
    cos = jnp.cos(ang)[:, :, None, :]
    sin = jnp.sin(ang)[:, :, None, :]
    tf = t.astype(F32)
    t1, t2 = tf[..., :half], tf[..., half:]
    out = jnp.concatenate([t1 * cos - t2 * sin, t2 * cos + t1 * sin], axis=-1)
    return out.astype(t.dtype)


def head_norm_rope(t, g, positions):
    t = rmsnorm(t, g)
    return jnp.concatenate([t[..., :QK_NOPE], rope(t[..., QK_NOPE:], positions)], axis=-1)


def causal_block_attention(q, k, v):
    B, S, H, _ = q.shape
    nb = S // Q_BLOCK
    scale = QK_DIM ** -0.5
    qb = q.reshape(B, nb, Q_BLOCK, H, QK_DIM).transpose(1, 0, 2, 3, 4)
    key_idx = jnp.arange(S)

    def one_block(args):
        q_blk, start = args
        s = jnp.einsum('bqhd,bkhd->bhqk', q_blk, k, preferred_element_type=F32) * scale
        q_idx = start + jnp.arange(Q_BLOCK)
        mask = key_idx[None, :] <= q_idx[:, None]
        s = jnp.where(mask[None, None], s, jnp.finfo(F32).min)
        p = jax.nn.softmax(s, axis=-1).astype(v.dtype)
        return jnp.einsum('bhqk,bkhd->bqhd', p, v)

    out = lax.map(one_block, (qb, jnp.arange(nb) * Q_BLOCK))
    return out.transpose(1, 0, 2, 3, 4).reshape(B, S, H * V_DIM).astype(q.dtype)


def memory_attention(q, mem, mem_norm_g, w_mem_kv, q_g, k_g):
    B, S, _ = q.shape
    qh = rmsnorm(q.reshape(B, S, MEM_HEADS, MEM_HEAD_DIM), q_g)
    kv = rmsnorm(mem, mem_norm_g) @ w_mem_kv
    M = kv.shape[1]
    kh = rmsnorm(kv[..., :MEM_WIDTH].reshape(B, M, MEM_HEADS, MEM_HEAD_DIM), k_g)
    vh = kv[..., MEM_WIDTH:].reshape(B, M, MEM_HEADS, MEM_HEAD_DIM)
    s = jnp.einsum('bshd,bmhd->bhsm', qh, kh, preferred_element_type=F32) * (MEM_HEAD_DIM ** -0.5)
    p = jax.nn.softmax(s, axis=-1).astype(vh.dtype)
    out = jnp.einsum('bhsm,bmhd->bshd', p, vh)
    return out.reshape(B, S, MEM_WIDTH).astype(q.dtype)


def rglru_branch(u, conv_w, conv_b, w_r, b_r, w_i, b_i, lam):
    B, S, W = u.shape
    up = jnp.pad(u, ((0, 0), (CONV_WIDTH - 1, 0), (0, 0)))
    y = conv_b
    for kk in range(CONV_WIDTH):
        y = y + conv_w[kk] * up[:, CONV_WIDTH - 1 - kk: CONV_WIDTH - 1 - kk + S]
    yb = y.reshape(B, S, LRU_BLOCKS, LRU_BLOCK)
    r = jax.nn.sigmoid(jnp.einsum('bsni,nij->bsnj', yb, w_r).reshape(B, S, W).astype(F32) + b_r.astype(F32))
    i = jax.nn.sigmoid(jnp.einsum('bsni,nij->bsnj', yb, w_i).reshape(B, S, W).astype(F32) + b_i.astype(F32))
    log_a = -LRU_C * r * jax.nn.softplus(-lam.astype(F32))
    a = jnp.exp(log_a)
    b = jnp.sqrt(-jnp.expm1(2.0 * log_a)) * (i * y.astype(F32))

    def combine(left, right):
        a1, b1 = left
        a2, b2 = right
        return a1 * a2, a2 * b1 + b2

    _, h = lax.associative_scan(combine, (a, b), axis=1)
    return h.astype(u.dtype)


def shared_latent_kv(h, positions, kv_in_norm_g, w_dkv, kv_latent_norm_g, w_uk, w_uv, k_head_norm_g):
    B, S, _ = h.shape
    ckv = rmsnorm(h, kv_in_norm_g) @ w_dkv
    c = rmsnorm(ckv[..., :KV_RANK], kv_latent_norm_g)
    k_pe = ckv[..., KV_RANK:]
    k_nope = (c @ w_uk).reshape(B, S, MLA_HEADS, QK_NOPE)
    v = (c @ w_uv).reshape(B, S, MLA_HEADS, V_DIM)
    k = jnp.concatenate([k_nope, jnp.broadcast_to(k_pe[:, :, None, :], (B, S, MLA_HEADS, QK_ROPE))], axis=-1)
    k = head_norm_rope(k, k_head_norm_g, positions)
    return k, v


def hier_moe(x, w_rg, b_rg, w_re, b_re, w_gate, w_up, w_down):
    B, S, D = x.shape
    xt = x.reshape(B * S, D)
    xf = xt.astype(F32)
    grp_logits = xf @ w_rg.astype(F32) + b_rg.astype(F32)
    p_grp = jax.nn.softmax(grp_logits, axis=-1)
    p_top, g_idx = lax.top_k(p_grp, 1)
    exp_logits = (xf @ w_re.astype(F32) + b_re.astype(F32)).reshape(-1, N_GROUPS, EXPERTS_PER_GROUP)
    sel = jnp.take_along_axis(exp_logits, g_idx[:, :, None], axis=1)[:, 0]
    p_in = jax.nn.softmax(sel, axis=-1)
    w_top, e_idx = lax.top_k(p_in, TOP_K_IN_GROUP)
    w_top = w_top / jnp.sum(w_top, axis=-1, keepdims=True)
    w_in = jnp.sum(jax.nn.one_hot(e_idx, EXPERTS_PER_GROUP, dtype=F32) * w_top[..., None], axis=1)
    gate = jax.nn.one_hot(g_idx[:, 0], N_GROUPS, dtype=F32)[:, :, None] * (p_top[:, :, None] * w_in[:, None, :])
    out = jnp.zeros(xf.shape, F32)
    for g in range(N_GROUPS):
        hg = jnp.einsum('td,edf->tef', xt, w_gate[g])
        hu = jnp.einsum('td,edf->tef', xt, w_up[g])
        hh = jax.nn.silu(hg) * hu * gate[:, g, :, None].astype(xt.dtype)
        out = out + jnp.einsum('tef,efd->td', hh, w_down[g]).astype(F32)
    return out.astype(x.dtype).reshape(B, S, D)


def setup_inputs(seed: int = 0) -> dict:
    key = jax.random.key(seed)
    ks = iter(jax.random.split(key, 40))

    def nrm(shape, scale):
        return jax.random.normal(next(ks), shape, F32) * scale

    def gain(shape):
        return 1.0 + 0.02 * jax.random.normal(next(ks), shape, F32)

    x = nrm((BATCH, SEQ, D_MODEL), 1.0)
    mem = nrm((BATCH, MEM_LEN, D_MODEL), 1.0)
    positions = jax.random.randint(next(ks), (BATCH, 1), 0, 1024, dtype=jnp.int32) + jnp.arange(SEQ, dtype=jnp.int32)[None, :]
    a0 = jax.random.uniform(next(ks), (N_A_LAYERS, LRU_WIDTH), F32, minval=0.9, maxval=0.999)
    lru_lambda = jnp.log(a0) - jnp.log1p(-a0)
    return {
        'x': x,
        'mem': mem,
        'positions': positions,
        'norm_mix_g': gain((DEPTH, D_MODEL)),
        'norm_ffn_g': gain((DEPTH, D_MODEL)),
        'w_o': nrm((DEPTH, D_MODEL, D_MODEL), D_MODEL ** -0.5),
        'mem_norm_g': gain((DEPTH, D_MODEL)),
        'w_mem_kv': nrm((DEPTH, D_MODEL, 2 * MEM_WIDTH), D_MODEL ** -0.5),
        'mem_q_norm_g': gain((DEPTH, MEM_HEAD_DIM)),
        'mem_k_norm_g': gain((DEPTH, MEM_HEAD_DIM)),
        'w_in_a': nrm((N_A_LAYERS, D_MODEL, IN_A_WIDTH), D_MODEL ** -0.5),
        'conv_w': nrm((N_A_LAYERS, CONV_WIDTH, LRU_WIDTH), CONV_WIDTH ** -0.5),
        'conv_b': nrm((N_A_LAYERS, LRU_WIDTH), 0.01),
        'w_lru_r': nrm((N_A_LAYERS, LRU_BLOCKS, LRU_BLOCK, LRU_BLOCK), LRU_BLOCK ** -0.5),
        'b_lru_r': nrm((N_A_LAYERS, LRU_WIDTH), 0.01),
        'w_lru_i': nrm((N_A_LAYERS, LRU_BLOCKS, LRU_BLOCK, LRU_BLOCK), LRU_BLOCK ** -0.5),
        'b_lru_i': nrm((N_A_LAYERS, LRU_WIDTH), 0.01),
        'lru_lambda': lru_lambda,
        'kv_in_norm_g': gain((D_MODEL,)),
        'w_dkv': nrm((D_MODEL, KV_RANK + QK_ROPE), D_MODEL ** -0.5),
        'kv_latent_norm_g': gain((KV_RANK,)),
        'w_uk': nrm((KV_RANK, MLA_HEADS * QK_NOPE), KV_RANK ** -0.5),
        'w_uv': nrm((KV_RANK, MLA_HEADS * V_DIM), KV_RANK ** -0.5),
        'k_head_norm_g': gain((QK_DIM,)),
        'w_in_b': nrm((N_B_LAYERS, D_MODEL, IN_B_WIDTH), D_MODEL ** -0.5),
        'q_latent_norm_g': gain((N_B_LAYERS, Q_RANK)),
        'w_uq': nrm((N_B_LAYERS, Q_RANK, MLA_HEADS * QK_DIM), Q_RANK ** -0.5),
        'q_head_norm_g': gain((N_B_LAYERS, QK_DIM)),
        'w_router_grp': nrm((DEPTH, D_MODEL, N_GROUPS), D_MODEL ** -0.5),
        'b_router_grp': nrm((DEPTH, N_GROUPS), 0.01),
        'w_router_exp': nrm((DEPTH, D_MODEL, N_GROUPS * EXPERTS_PER_GROUP), D_MODEL ** -0.5),
        'b_router_exp': nrm((DEPTH, N_GROUPS * EXPERTS_PER_GROUP), 0.01),
        'w_exp_gate': nrm((DEPTH, N_GROUPS, EXPERTS_PER_GROUP, D_MODEL, D_EXPERT), D_MODEL ** -0.5),
        'w_exp_up': nrm((DEPTH, N_GROUPS, EXPERTS_PER_GROUP, D_MODEL, D_EXPERT), D_MODEL ** -0.5),
        'w_exp_down': nrm((DEPTH, N_GROUPS, EXPERTS_PER_GROUP, D_EXPERT, D_MODEL), D_EXPERT ** -0.5),
    }


def reference(x, mem, positions, norm_mix_g, norm_ffn_g, w_o, mem_norm_g, w_mem_kv, mem_q_norm_g, mem_k_norm_g,
              w_in_a, conv_w, conv_b, w_lru_r, b_lru_r, w_lru_i, b_lru_i, lru_lambda,
              kv_in_norm_g, w_dkv, kv_latent_norm_g, w_uk, w_uv, k_head_norm_g,
              w_in_b, q_latent_norm_g, w_uq, q_head_norm_g,
              w_router_grp, b_router_grp, w_router_exp, b_router_exp, w_exp_gate, w_exp_up, w_exp_down):
    B, S, _ = x.shape
    k_sh = None
    v_sh = None
    for l in range(DEPTH):
        xn = rmsnorm(x, norm_mix_g[l])
        if l < N_A_LAYERS:
            i = l
            proj = xn @ w_in_a[i]
            u = proj[..., :LRU_WIDTH]
            g_br = proj[..., LRU_WIDTH:2 * LRU_WIDTH]
            q_mem = proj[..., 2 * LRU_WIDTH:]
            h = rglru_branch(u, conv_w[i], conv_b[i], w_lru_r[i], b_lru_r[i], w_lru_i[i], b_lru_i[i], lru_lambda[i])
            y_mix = jax.nn.gelu(g_br) * h
        else:
            j = l - N_A_LAYERS
            proj = xn @ w_in_b[j]
            c_q = rmsnorm(proj[..., :Q_RANK], q_latent_norm_g[j])
            q_mem = proj[..., Q_RANK:]
            q = (c_q @ w_uq[j]).reshape(B, S, MLA_HEADS, QK_DIM)
            q = head_norm_rope(q, q_head_norm_g[j], positions)
            y_mix = causal_block_attention(q, k_sh, v_sh)
        y_mem = memory_attention(q_mem, mem, mem_norm_g[l], w_mem_kv[l], mem_q_norm_g[l], mem_k_norm_g[l])
        x = x + jnp.concatenate([y_mix, y_mem], axis=-1) @ w_o[l]
        x = x + hier_moe(rmsnorm(x, norm_ffn_g[l]), w_router_grp[l], b_router_grp[l], w_router_exp[l], b_router_exp[l],
                         w_exp_gate[l], w_exp_up[l], w_exp_down[l])
        if l == N_A_LAYERS - 1:
            k_sh, v_sh = shared_latent_kv(x, positions, kv_in_norm_g, w_dkv, kv_latent_norm_g, w_uk, w_uv, k_head_norm_g)
    return x
```

```cpp
#include <hip/hip_runtime.h>
#include <cstdio>
#include <cstdint>
#include <math.h>

#define GAS __attribute__((address_space(1)))
#define LAS __attribute__((address_space(3)))
typedef unsigned short bf16;
typedef short bf16x8 __attribute__((ext_vector_type(8)));
typedef float f32x2 __attribute__((ext_vector_type(2)));
typedef float f32x4 __attribute__((ext_vector_type(4)));
typedef float f32x16 __attribute__((ext_vector_type(16)));
typedef unsigned u32x2 __attribute__((ext_vector_type(2)));
typedef unsigned u32x4 __attribute__((ext_vector_type(4)));
typedef GAS unsigned gu32;
#define RLX_AGENT __ATOMIC_RELAXED, __HIP_MEMORY_SCOPE_AGENT
#define LDS_WAIT() asm volatile("s_waitcnt lgkmcnt(0)" ::: "memory")
#define VM_WAIT() asm volatile("s_waitcnt vmcnt(0)" ::: "memory")


#ifndef MK_REPORT
#define MK_REPORT 0
#endif
#ifndef MK_TOL2
#define MK_TOL2 2.5e-3f
#endif
#ifndef MK_MODE
#define MK_MODE 0
#endif

namespace mk {
constexpr int NWAVES = 8, NTHR = 512;
constexpr int Bn = 4, S = 2048, D = 2048, T = Bn * S, DEPTH = 4, NA = 2;
constexpr int MEM_LEN = 256, MEM_W = 512, MIX_W = 1536, LRU_W = 1536;
constexpr int MLA_H = 12, QK_DIM = 192, Q_RANK = 512, KV_RANK = 256, QW = MLA_H * QK_DIM  ;
constexpr int NE = 32, D_EXP = 512, LCAP = 8192;
constexpr int IN_A = 3584, IN_B = 1024;
constexpr float EPS = 1e-6f;

constexpr size_t al256(size_t x) { return (x + 255) & ~(size_t)255; }
constexpr size_t WS_CTL = 0, CTL_ZERO_BYTES = 1u << 20;
constexpr size_t WS_WT_INA = CTL_ZERO_BYTES;
constexpr size_t WS_WT_INB = WS_WT_INA + (size_t)2 * IN_A * D * 2;
constexpr size_t WS_WT_O = WS_WT_INB + (size_t)2 * IN_B * D * 2;
constexpr size_t WS_WT_MKV = WS_WT_O + (size_t)4 * D * D * 2;
constexpr size_t WS_WT_UQ = WS_WT_MKV + (size_t)4 * 1024 * D * 2;
constexpr size_t WS_WT_DKV = WS_WT_UQ + (size_t)2 * QW * Q_RANK * 2;
constexpr size_t WS_WT_UKV = WS_WT_DKV + (size_t)512 * D * 2;
constexpr size_t WS_WT_EGU = WS_WT_UKV + (size_t)3072 * KV_RANK * 2;
constexpr size_t WS_WT_ED = WS_WT_EGU + (size_t)128 * 1024 * D * 2;
constexpr size_t WS_WT_RT = WS_WT_ED + (size_t)128 * D * D_EXP * 2;
constexpr size_t WS_TAB = WS_WT_RT + (size_t)4 * 40 * D * 4;
constexpr size_t WS_XN = WS_TAB + (size_t)T * 64 * 4;
constexpr size_t WS_XKV = WS_XN + (size_t)T * D * 2;
constexpr size_t WS_PROJ = WS_XKV + (size_t)T * D * 2;
constexpr size_t WS_YCAT = WS_PROJ + (size_t)T * IN_A * 2;
constexpr size_t WS_MEMN = WS_YCAT + (size_t)T * D * 2;
constexpr size_t WS_MKVR = WS_MEMN + (size_t)4 * 1024 * D * 2;
constexpr size_t WS_MEMK = WS_MKVR + (size_t)4096 * 1024 * 2;
constexpr size_t WS_MEMVT = WS_MEMK + (size_t)4096 * 4 * 192 * 2;
constexpr size_t WS_H = WS_MEMVT + (size_t)4 * 4 * 4 * 128 * 256 * 2;
constexpr size_t WS_SELW = WS_H + (size_t)2 * T * D_EXP * 2;
constexpr size_t WS_LISTS = WS_SELW + (size_t)2 * T * 4;
constexpr size_t WS_CKV = WS_LISTS + (size_t)NE * LCAP * 4;
constexpr size_t WS_CN = WS_CKV + (size_t)T * 512 * 2;
constexpr size_t WS_KVUP = WS_CN + (size_t)T * 256 * 2;
constexpr size_t WS_K = WS_KVUP + (size_t)T * 3072 * 2;
constexpr size_t WS_VT = WS_K + (size_t)T * QW * 2;
constexpr size_t WS_CQN = WS_VT + (size_t)Bn * MLA_H * 128 * S * 2;
constexpr size_t WS_QRAW = WS_CQN + (size_t)T * Q_RANK * 2;
constexpr size_t WS_OSLOT = WS_PROJ;
constexpr size_t WS_END = WS_QRAW + (size_t)T * QW * 2;
static_assert(WS_PROJ + (size_t)2 * T * D * 2 <= WS_MEMN, "OSLOT overlay");
static_assert(WS_WT_INA % 256 == 0 && WS_WT_EGU % 256 == 0 && WS_XN % 256 == 0 && WS_QRAW % 256 == 0, "ws alignment");

constexpr int CW_TMO = 0, CW_CODE = 1;
constexpr int CW_BAR = 4096;
constexpr int CW_MOECNT = 8192;
constexpr int CW_ATTQ = 8192 + 128 * 64;
static_assert((CW_ATTQ + 4 * 64) * 4 <= (int)CTL_ZERO_BYTES, "ctl");

constexpr int RING_OFF = 0, RING_BYTES = 131072;
constexpr int LDSCTL_OFF = RING_BYTES, MISC_OFF = LDSCTL_OFF + 320;
constexpr int MOE_TAB_OFF = MISC_OFF + 128;
constexpr int LDS_BYTES = 147456;
static_assert(MOE_TAB_OFF + 65 * 4 <= LDS_BYTES, "lds map");

__device__ __forceinline__ float wave_sum(float v) {
#pragma unroll
    for (int o = 1; o < 64; o <<= 1) v += __shfl_xor(v, o);
    return v;
}
__device__ __forceinline__ unsigned f2bf(float f) { unsigned u = __builtin_bit_cast(unsigned, f); return (u + 0x7fffu + ((u >> 16) & 1u)) >> 16; }
__device__ __forceinline__ unsigned pk2(float lo, float hi) { return f2bf(lo) | (f2bf(hi) << 16); }
__device__ __forceinline__ float bflo(unsigned w) { return __builtin_bit_cast(float, w << 16); }
__device__ __forceinline__ float bfhi(unsigned w) { return __builtin_bit_cast(float, w & 0xffff0000u); }
__device__ __forceinline__ float bf1(bf16 h) { return __builtin_bit_cast(float, (unsigned)h << 16); }
typedef __bf16 bf16x2_t __attribute__((ext_vector_type(2)));
__device__ __forceinline__ unsigned cvtpk(float lo, float hi) { f32x2 v = {lo, hi}; bf16x2_t b = __builtin_convertvector(v, bf16x2_t); return __builtin_bit_cast(unsigned, b); }
__device__ __forceinline__ float fast_sigmoid(float x) { return __builtin_amdgcn_rcpf(1.0f + __builtin_amdgcn_exp2f(-1.4426950408889634f * x)); }
__device__ __forceinline__ float gelu_tanh_f(float x) { const float u = 0.7978845608028654f * (x + 0.044715f * x * x * x); return x * fast_sigmoid(2.0f * u); }
}
namespace pg8 {
typedef unsigned short bf16_t;
constexpr int BM = 256, BK = 64, HALF = 128, HTB = HALF * BK * 2  , STAGE_BYTES = 8 * HTB, NXCD = 8, WGM = 8;

__host__ __device__ __forceinline__ int lds_byte(int r, int c) { const int st = (r >> 4) * 2 + (c >> 5), rr = r & 15, cc = c & 31, ob = rr * 64 + cc * 2; return st * 1024 + (ob ^ (((ob >> 9) & 1) << 5)); }
__host__ __device__ __forceinline__ void stage_rc(int b, int& R, int& C) { const int st = b / 1024, sb = b % 1024, swz = sb ^ (((sb >> 9) & 1) << 5); R = (st >> 1) * 16 + swz / 64; C = (st & 1) * 32 + (swz % 64) / 2; }
__host__ __device__ __forceinline__ int perm32(int rho) { const int n = rho >> 4, i = rho & 15; return 8 * (i >> 2) + 4 * n + (i & 3); }

struct Unit { int pm, pn, e, rows; };

struct DenseProb {
    static constexpr bool GATHER = false;
    const bf16_t* A; const bf16_t* Bt; int K, N;
    __device__ __forceinline__ const char* a_base(const Unit& u) const { return (const char*)(A + (size_t)u.pm * BM * K); }
    __device__ __forceinline__ const char* b_base(const Unit& u) const { return (const char*)(Bt + ((size_t)u.e * N + (size_t)u.pn * BM) * K); }
    __device__ __forceinline__ void a_offs(const Unit&, const int (&R)[2], const int (&C)[2], unsigned (&o)[2][2]) const {
#pragma unroll
        for (int h = 0; h < 2; ++h)
#pragma unroll
            for (int i = 0; i < 2; ++i) o[h][i] = (unsigned)(((h * HALF + R[i]) * K + C[i]) * 2);
    }
};
struct GatherProb {
    static constexpr bool GATHER = true;
    const bf16_t* A; const bf16_t* Bt; int K, N; const int* lists; int lcap, ashift, ebase;
    __device__ __forceinline__ const char* a_base(const Unit&) const { return (const char*)A; }
    __device__ __forceinline__ const char* b_base(const Unit& u) const { return (const char*)(Bt + ((size_t)(ebase + u.e) * N + (size_t)u.pn * BM) * K); }
    __device__ __forceinline__ void a_offs(const Unit& u, const int (&R)[2], const int (&C)[2], unsigned (&o)[2][2]) const {
#pragma unroll
        for (int h = 0; h < 2; ++h)
#pragma unroll
            for (int i = 0; i < 2; ++i) { int r = h * HALF + R[i]; r = r < u.rows ? r : u.rows - 1; const int ent = lists[u.e * lcap + u.pm * BM + r]; o[h][i] = (unsigned)(((ent >> ashift) * K + C[i]) * 2); }
    }
};

struct StaticOrder {
    int nM, nN, nwg, G, c, mt_per_b;
    __device__ void init(int M, int N, int G_, int c_, int mtb) { nM = M / BM; nN = N / BM; nwg = nM * nN; G = G_; c = c_; mt_per_b = mtb; }
    __device__ bool next(int i, Unit& u) const {
        const long L = (long)i * G + c; if (L >= nwg) return false;
        int wgid = (int)L; { const int q = nwg / NXCD, r = nwg % NXCD, xcd = wgid % NXCD, off = wgid / NXCD; wgid = (xcd < r ? xcd * (q + 1) : r * (q + 1) + (xcd - r) * q) + off; }
        const int nig = WGM * nN, gid = wgid / nig, fm = gid * WGM, gsz = (nM - fm) < WGM ? (nM - fm) : WGM;
        u.pm = fm + ((wgid % nig) % gsz); u.pn = (wgid % nig) / gsz; u.e = u.pm / mt_per_b; u.rows = BM; return true;
    }
};
struct MoeOrder {
    const LAS int* tab; int G, c, ntl;
    __device__ bool next(int i, Unit& u) const {
        const int L = i * G + c; if (L >= tab[32]) return false;
        int e = 0; while (e < 31 && L >= tab[e + 1]) ++e;
        const int local = L - tab[e], cnt = tab[33 + e];
        u.e = e; u.pn = local % ntl; u.pm = local / ntl; const int rem = cnt - u.pm * BM; u.rows = rem < BM ? rem : BM; return true;
    }
};

struct EpiBf16 {
    static constexpr bool PERM = true;
    bf16_t* O; int ldc;
    __device__ __forceinline__ void operator()(const f32x4 (&acc)[2][2][4][2], const Unit& u, int wr, int wc, int fr, int fq) const {
        const int row0 = u.pm * BM + wr * 64 + fr, col0 = u.pn * BM + wc * 32 + 8 * fq;
#pragma unroll
        for (int ai = 0; ai < 2; ++ai)
#pragma unroll
            for (int m = 0; m < 4; ++m) { bf16_t* rowp = O + (size_t)(row0 + ai * HALF + m * 16) * ldc + col0;
#pragma unroll
                for (int bj = 0; bj < 2; ++bj) { const f32x4 v0 = acc[ai][bj][m][0], v1 = acc[ai][bj][m][1];
                    u32x4 w; w.x = mk::cvtpk(v0[0], v0[1]); w.y = mk::cvtpk(v0[2], v0[3]); w.z = mk::cvtpk(v1[0], v1[1]); w.w = mk::cvtpk(v1[2], v1[3]);
                    *(u32x4*)(rowp + bj * HALF) = w; } }
    }
};
struct EpiResF32 {
    static constexpr bool PERM = false;
    const float* R; float* C; int ldc;
    __device__ __forceinline__ void operator()(const f32x4 (&acc)[2][2][4][2], const Unit& u, int wr, int wc, int fr, int fq) const {
        const int row0 = u.pm * BM + wr * 64 + fr, col0 = u.pn * BM + wc * 32 + 4 * fq;
#pragma unroll
        for (int ai = 0; ai < 2; ++ai)
#pragma unroll
            for (int m = 0; m < 4; ++m) { const size_t off = (size_t)(row0 + ai * HALF + m * 16) * ldc + col0;
#pragma unroll
                for (int bj = 0; bj < 2; ++bj)
#pragma unroll
                    for (int n = 0; n < 2; ++n) { const f32x4 r = *(const f32x4*)(R + off + bj * HALF + n * 16); *(f32x4*)(C + off + bj * HALF + n * 16) = r + acc[ai][bj][m][n]; } }
    }
};
struct EpiMoe1 {
    static constexpr bool PERM = true;
    bf16_t* H; const int* lists; const float* selw; int lcap;
    __device__ __forceinline__ void operator()(const f32x4 (&acc)[2][2][4][2], const Unit& u, int wr, int wc, int fr, int fq) const {
        const int col0 = u.pn * HALF + wc * 32 + 8 * fq;
#pragma unroll
        for (int ai = 0; ai < 2; ++ai)
#pragma unroll
            for (int m = 0; m < 4; ++m) { const int r = ai * HALF + wr * 64 + m * 16 + fr;
                if (r < u.rows) { const int slot = lists[u.e * lcap + u.pm * BM + r]; const float w = selw[slot];
                    float o[8];
#pragma unroll
                    for (int n = 0; n < 2; ++n)
#pragma unroll
                        for (int j = 0; j < 4; ++j) { const float g = acc[ai][0][m][n][j], up = acc[ai][1][m][n][j]; o[n * 4 + j] = g * mk::fast_sigmoid(g) * up * w; }
                    u32x4 q; q.x = mk::cvtpk(o[0], o[1]); q.y = mk::cvtpk(o[2], o[3]); q.z = mk::cvtpk(o[4], o[5]); q.w = mk::cvtpk(o[6], o[7]);
                    *(u32x4*)(H + (size_t)slot * 512 + col0) = q; } }
    }
};
struct EpiMoe2 {
    static constexpr bool PERM = true;
    bf16_t* O; const int* lists; int lcap; int ldc;
    __device__ __forceinline__ void operator()(const f32x4 (&acc)[2][2][4][2], const Unit& u, int wr, int wc, int fr, int fq) const {
        const int col0 = u.pn * BM + wc * 32 + 8 * fq;
#pragma unroll
        for (int ai = 0; ai < 2; ++ai)
#pragma unroll
            for (int m = 0; m < 4; ++m) { const int r = ai * HALF + wr * 64 + m * 16 + fr;
                if (r < u.rows) { const int slot = lists[u.e * lcap + u.pm * BM + r]; bf16_t* rowp = O + (size_t)slot * ldc + col0;
#pragma unroll
                    for (int bj = 0; bj < 2; ++bj) { const f32x4 v0 = acc[ai][bj][m][0], v1 = acc[ai][bj][m][1];
                        u32x4 w; w.x = mk::cvtpk(v0[0], v0[1]); w.y = mk::cvtpk(v0[2], v0[3]); w.z = mk::cvtpk(v1[0], v1[1]); w.w = mk::cvtpk(v1[2], v1[3]);
                        *(u32x4*)(rowp + bj * HALF) = w; } } }
    }
};

template <class Prob, class Epi, class Sched, bool ALIGN_EPI>
__device__ __forceinline__ void gemm_phase(LAS unsigned char* lds, const Prob& P, const Sched& S, const Epi& E) {
    int tid_ = threadIdx.x; asm volatile("" : "+v"(tid_));
    const int tid = tid_, wid = __builtin_amdgcn_readfirstlane(tid >> 6), lane = tid & 63, wr = wid >> 2, wc = wid & 3, fr = lane & 15, fq = lane >> 4;
    const int K = P.K, nt = K / BK;
    int Rr[2], Cc[2]; unsigned voffB[2];
#pragma unroll
    for (int i = 0; i < 2; ++i) { int R, C; stage_rc(tid * 16 + i * 8192, R, C); Rr[i] = R; Cc[i] = C; const int Rb = Epi::PERM ? ((R & ~31) + perm32(R & 31)) : R; voffB[i] = (unsigned)(Rb * K + C) * 2u; }
    const size_t kstep = (size_t)(BK * 2);
    const size_t hstep = (size_t)HALF * K * 2;
    const unsigned ldsw = (unsigned)wid * 1024u;
    const int aoff = lds_byte(wr * 64 + fr, fq * 8), boff = lds_byte(wc * 32 + fr, fq * 8);
#define PG8_SA(b, h) (((b) * 2 + (h)) * HTB)
#define PG8_SB(b, h) ((4 + (b) * 2 + (h)) * HTB)
#define PG8_STAGE(bufoff, gbase, voff) do { _Pragma("unroll") for (int _i = 0; _i < 2; ++_i) \
        __builtin_amdgcn_global_load_lds((const unsigned*)((const char*)(gbase) + (voff)[_i]), (LAS unsigned*)(lds + (bufoff) + ldsw + _i * 8192), 16, 0, 0); } while (0)
#define PG8_LDA(dst, b, h) do { _Pragma("unroll") for (int m = 0; m < 4; ++m) _Pragma("unroll") for (int k = 0; k < 2; ++k) dst[m][k] = *(const LAS bf16x8*)(lds + PG8_SA(b, h) + aoff + m * 2048 + k * 1024); } while (0)
#define PG8_LDB(dst, b, h) do { _Pragma("unroll") for (int n = 0; n < 2; ++n) _Pragma("unroll") for (int k = 0; k < 2; ++k) dst[n][k] = *(const LAS bf16x8*)(lds + PG8_SB(b, h) + boff + n * 2048 + k * 1024); } while (0)
#define PG8_MMA(ai, bj, At, Bt) do { __builtin_amdgcn_s_setprio(1); _Pragma("unroll") for (int m = 0; m < 4; ++m) _Pragma("unroll") for (int n = 0; n < 2; ++n) _Pragma("unroll") for (int k = 0; k < 2; ++k) \
        acc[ai][bj][m][n] = __builtin_amdgcn_mfma_f32_16x16x32_bf16(Bt[n][k], At[m][k], acc[ai][bj][m][n], 0, 0, 0); __builtin_amdgcn_s_setprio(0); } while (0)
#define PG8_WAIT_V(n) asm volatile("s_waitcnt vmcnt(" #n ")" ::: "memory")
#define PG8_WAIT_L(n) asm volatile("s_waitcnt lgkmcnt(" #n ")" ::: "memory")
#define PG8_BAR __builtin_amdgcn_s_barrier()
#define PG8_SCHED __builtin_amdgcn_sched_barrier(0)
    Unit cur, nxt; int ui = 0;
    if (!S.next(0, cur)) return;
    f32x4 acc[2][2][4][2];
#pragma unroll
    for (int a = 0; a < 2; ++a)
#pragma unroll
        for (int b = 0; b < 2; ++b)
#pragma unroll
            for (int m = 0; m < 4; ++m)
#pragma unroll
                for (int n = 0; n < 2; ++n) acc[a][b][m][n] = (f32x4){0.f, 0.f, 0.f, 0.f};
    bf16x8 At[4][2], B0[2][2], B1[2][2];
    unsigned aoC[2][2], aoN[2][2];
    P.a_offs(cur, Rr, Cc, aoC);
    if (Prob::GATHER) asm volatile("" : "+v"(aoC[0][0]), "+v"(aoC[0][1]), "+v"(aoC[1][0]), "+v"(aoC[1][1]));
#pragma unroll
    for (int h = 0; h < 2; ++h)
#pragma unroll
        for (int i = 0; i < 2; ++i) aoN[h][i] = aoC[h][i];
    const char* cA = P.a_base(cur); const char* cB = P.b_base(cur);
    PG8_STAGE(PG8_SB(0, 0), cB, voffB); PG8_STAGE(PG8_SB(0, 1), cB + hstep, voffB); PG8_STAGE(PG8_SA(0, 0), cA, aoC[0]); PG8_STAGE(PG8_SA(0, 1), cA, aoC[1]);
    if (wr == 1) PG8_BAR;
    PG8_WAIT_V(2); PG8_BAR;
    PG8_STAGE(PG8_SB(1, 0), cB + kstep, voffB); PG8_STAGE(PG8_SA(1, 0), cA + kstep, aoC[0]); PG8_STAGE(PG8_SB(1, 1), cB + hstep + kstep, voffB);
    PG8_WAIT_V(6); PG8_BAR;
    for (;;) {
        const bool has_next = S.next(ui + 1, nxt);
        const char* nA = has_next ? P.a_base(nxt) : cA; const char* nB = has_next ? P.b_base(nxt) : cB;
        if (Prob::GATHER) {
            if (has_next) { P.a_offs(nxt, Rr, Cc, aoN); asm volatile("" : "+v"(aoN[0][0]), "+v"(aoN[0][1]), "+v"(aoN[1][0]), "+v"(aoN[1][1])); }
            else {
#pragma unroll
                for (int h = 0; h < 2; ++h)
#pragma unroll
                    for (int i = 0; i < 2; ++i) aoN[h][i] = aoC[h][i]; }
        }
        for (int t = 0; t < nt; t += 2) {
            const bool last = (t == nt - 2);
            const char* a1 = cA + (size_t)(t + 1) * kstep;
            const char* a2 = last ? nA : cA + (size_t)(t + 2) * kstep; const char* b2 = last ? nB : cB + (size_t)(t + 2) * kstep;
            const char* a3 = a2 + kstep; const char* b3 = b2 + kstep;
            unsigned o2[2][2];
#pragma unroll
            for (int h = 0; h < 2; ++h)
#pragma unroll
                for (int i = 0; i < 2; ++i) o2[h][i] = (Prob::GATHER && last) ? aoN[h][i] : aoC[h][i];
            PG8_LDB(B0, 0, 0); PG8_LDB(B1, 0, 1); PG8_SCHED; PG8_LDA(At, 0, 0); PG8_STAGE(PG8_SA(1, 1), a1, aoC[1]);
            PG8_WAIT_V(8); PG8_WAIT_L(0); PG8_BAR; PG8_MMA(0, 0, At, B0); PG8_MMA(0, 1, At, B1); PG8_BAR; PG8_SCHED;
            PG8_LDA(At, 0, 1); PG8_STAGE(PG8_SB(0, 0), b2, voffB); PG8_STAGE(PG8_SB(0, 1), b2 + hstep, voffB); PG8_STAGE(PG8_SA(0, 0), a2, o2[0]);
            PG8_WAIT_V(8); PG8_WAIT_L(0); PG8_BAR; PG8_MMA(1, 0, At, B0); PG8_MMA(1, 1, At, B1); PG8_BAR; PG8_SCHED;
            PG8_LDB(B0, 1, 0); PG8_LDB(B1, 1, 1); PG8_SCHED; PG8_LDA(At, 1, 0); PG8_STAGE(PG8_SA(0, 1), a2, o2[1]);
            PG8_WAIT_V(8); PG8_WAIT_L(0); PG8_BAR; PG8_MMA(0, 0, At, B0); PG8_MMA(0, 1, At, B1); PG8_BAR; PG8_SCHED;
            PG8_LDA(At, 1, 1); PG8_STAGE(PG8_SB(1, 0), b3, voffB); PG8_STAGE(PG8_SB(1, 1), b3 + hstep, voffB); PG8_STAGE(PG8_SA(1, 0), a3, o2[0]);
            PG8_WAIT_V(8); PG8_WAIT_L(0); PG8_BAR; PG8_MMA(1, 0, At, B0); PG8_MMA(1, 1, At, B1); PG8_BAR; PG8_SCHED;
        }
        if constexpr (ALIGN_EPI) { if (wr == 0) PG8_BAR; }
        E(acc, cur, wr, wc, fr, fq);
        if (!has_next) break;
#pragma unroll
        for (int a = 0; a < 2; ++a)
#pragma unroll
            for (int b = 0; b < 2; ++b)
#pragma unroll
                for (int m = 0; m < 4; ++m)
#pragma unroll
                    for (int n = 0; n < 2; ++n) acc[a][b][m][n] = (f32x4){0.f, 0.f, 0.f, 0.f};
        cur = nxt; cA = nA; cB = nB; ++ui;
#pragma unroll
        for (int h = 0; h < 2; ++h)
#pragma unroll
            for (int i = 0; i < 2; ++i) aoC[h][i] = aoN[h][i];
        if constexpr (ALIGN_EPI) { if (wr == 1) PG8_BAR; }
    }
    PG8_WAIT_V(0);
    if constexpr (!ALIGN_EPI) { if (wr == 0) PG8_BAR; }
    PG8_BAR;
#undef PG8_SA
#undef PG8_SB
#undef PG8_STAGE
#undef PG8_LDA
#undef PG8_LDB
#undef PG8_MMA
#undef PG8_WAIT_V
#undef PG8_WAIT_L
#undef PG8_BAR
#undef PG8_SCHED
}
}
namespace mk {
#define XB_TMO      128
#define XB_XCNT(j)  (256  + 64 * (j))
#define XB_XSUB(j)  (1280 + 64 * (j))
#define XB_XGEN(j)  (2304 + 64 * (j))
#define XB_TOP      3328
#define XB_TOPGEN   3392
#define XCD_BAR_WORDS 3456
#define XB_SPIN_CAP (1u << 18)

__device__ __forceinline__ unsigned xb_ld(unsigned* p)              { return __hip_atomic_load(p, __ATOMIC_RELAXED, __HIP_MEMORY_SCOPE_AGENT); }
__device__ __forceinline__ unsigned xb_add(unsigned* p, unsigned v) { return __hip_atomic_fetch_add(p, v, __ATOMIC_RELAXED, __HIP_MEMORY_SCOPE_AGENT); }
__device__ __forceinline__ unsigned xb_xcc_id() { return (unsigned)__builtin_amdgcn_s_getreg((3 << 11) | 20) & 0xFu; }
#define XB_SPIN(cond, bar) do { unsigned _sp = 0; while (cond) { __builtin_amdgcn_s_sleep(1); \
    if ((++_sp & 255u) == 0u) { if (xb_ld(&(bar)[XB_TMO])) break; if (_sp > XB_SPIN_CAP) { atomicAdd(&(bar)[XB_TMO], 1u); break; } } } } while (0)

struct XcdBarrier {
    unsigned* bar; unsigned x;
    volatile LAS unsigned* st;
};

__device__ __forceinline__ XcdBarrier xcd_barrier_post(unsigned* bar, volatile LAS unsigned* st) {
    XcdBarrier b; b.bar = bar; b.x = xb_xcc_id(); b.st = st;
    if (threadIdx.x == 0) (void)xb_add(&bar[XB_XCNT(b.x)], 1u);
    return b;
}
__device__ __forceinline__ void xcd_barrier_complete(unsigned* bar, unsigned x, unsigned& nloc, unsigned& nx) {
    const unsigned G = gridDim.x * gridDim.y * gridDim.z;
    unsigned sum, cnt, mine, sp = 0u;
    for (;;) {
        sum = 0u; cnt = 0u; mine = 0u;
#pragma unroll
        for (unsigned j = 0; j < 16; ++j) { const unsigned c = xb_ld(&bar[XB_XCNT(j)]); sum += c; cnt += (c > 0u) ? 1u : 0u; mine = (j == x) ? c : mine; }
        if (sum == G) break;
        __builtin_amdgcn_s_sleep(1);
        if ((++sp & 255u) == 0u) { if (xb_ld(&bar[XB_TMO])) break; if (sp > XB_SPIN_CAP) { atomicAdd(&bar[XB_TMO], 1u); break; } }
    }
    nloc = mine > 0u ? mine : 1u; nx = cnt > 0u ? cnt : 1u;
}

__device__ __forceinline__ void xcd_barrier(const XcdBarrier& b) {
    asm volatile("s_waitcnt vmcnt(0)" ::: "memory");
    __syncthreads();
    if (threadIdx.x == 0) {
        unsigned* bar = b.bar;
        __builtin_amdgcn_s_waitcnt(0);
        unsigned nloc = b.st[0], nx = b.st[1];
        if (nloc == 0u) { xcd_barrier_complete(bar, b.x, nloc, nx); b.st[0] = nloc; b.st[1] = nx; }
        const unsigned old = xb_add(&bar[XB_XSUB(b.x)], 1u);
        const unsigned gen = old / nloc;
        if (old + 1u == (gen + 1u) * nloc) {
            __builtin_amdgcn_fence(__ATOMIC_RELEASE, "agent");
            asm volatile("s_waitcnt vmcnt(0)" ::: "memory");
            const unsigned og = xb_add(&bar[XB_TOP], 1u);
            const unsigned tg = og / nx;
            if (og + 1u == (tg + 1u) * nx) xb_add(&bar[XB_TOPGEN], 1u);
            else XB_SPIN(xb_ld(&bar[XB_TOPGEN]) == tg, bar);
            __builtin_amdgcn_fence(__ATOMIC_ACQUIRE, "agent");
            xb_add(&bar[XB_XGEN(b.x)], 1u);
            asm volatile("s_waitcnt vmcnt(0)" ::: "memory");
        } else {
            XB_SPIN(xb_ld(&bar[XB_XGEN(b.x)]) == gen, bar);
            __builtin_amdgcn_fence(__ATOMIC_ACQUIRE, "agent");
            asm volatile("s_waitcnt vmcnt(0)" ::: "memory");
        }
    }
    __syncthreads();
}
struct Args { const void* in[35]; float* out; unsigned char* ws; int ph_lo, ph_hi; };
struct Frame {
    LAS unsigned char* lds; volatile LAS unsigned* MISC; gu32* ctl; unsigned char* ws;
    int tid, lane, wave, G, bid;
};
#define INF(i) ((const float*)args.in[i])
#define WSP(T_, off) ((T_*)(F.ws + (off)))

__device__ __forceinline__ void transpose_item(const float* W, int K, int N, bf16* WT, int drow0, LAS float* scr, int kb, int nb, int lane) {
    const int k0 = 64 * kb, n0 = 32 * nb;
#pragma unroll 8
    for (int i = 0; i < 32; ++i) { const int kk = 2 * i + (lane >> 5); scr[kk * 33 + (lane & 31)] = W[(size_t)(k0 + kk) * N + n0 + (lane & 31)]; }
    LDS_WAIT(); asm volatile("" ::: "memory");
    const int c = lane & 7;
#pragma unroll
    for (int j = 0; j < 4; ++j) { const int n = (lane >> 3) + 8 * j; const LAS float* s = scr + (8 * c) * 33 + n;
        u32x4 o; o.x = pk2(s[0 * 33], s[1 * 33]); o.y = pk2(s[2 * 33], s[3 * 33]); o.z = pk2(s[4 * 33], s[5 * 33]); o.w = pk2(s[6 * 33], s[7 * 33]);
        *(GAS u32x4*)(WT + (size_t)(drow0 + n) * K + k0 + 8 * c) = o; }
    LDS_WAIT(); asm volatile("" ::: "memory");
}
__device__ __forceinline__ void norm_rows(Frame& F, const float* x, int rows, const float* g1, bf16* o1, const float* g2, bf16* o2) {
    const int gw = F.bid * NWAVES + F.wave, NGW = F.G * NWAVES;
    for (int m = gw; m < rows; m += NGW) {
        const GAS f32x4* xr = (const GAS f32x4*)(x + (size_t)m * D) + F.lane;
        f32x4 v[8]; float ss = 0.f;
#pragma unroll
        for (int j = 0; j < 8; ++j) { v[j] = xr[64 * j]; ss += (v[j].x * v[j].x + v[j].y * v[j].y) + (v[j].z * v[j].z + v[j].w * v[j].w); }
        const float rstd = 1.0f / sqrtf(wave_sum(ss) * (1.0f / D) + EPS);
        GAS u32x2* o = (GAS u32x2*)(o1 + (size_t)m * D) + F.lane;
#pragma unroll
        for (int j = 0; j < 8; ++j) { const f32x4 g = ((const GAS f32x4*)g1)[F.lane + 64 * j]; u32x2 w; w.x = pk2(v[j].x * rstd * g.x, v[j].y * rstd * g.y); w.y = pk2(v[j].z * rstd * g.z, v[j].w * rstd * g.w); o[64 * j] = w; }
        if (g2) { GAS u32x2* oo = (GAS u32x2*)(o2 + (size_t)m * D) + F.lane;
#pragma unroll
            for (int j = 0; j < 8; ++j) { const f32x4 g = ((const GAS f32x4*)g2)[F.lane + 64 * j]; u32x2 w; w.x = pk2(v[j].x * rstd * g.x, v[j].y * rstd * g.y); w.y = pk2(v[j].z * rstd * g.z, v[j].w * rstd * g.w); oo[64 * j] = w; } }
    }
}
__device__ __forceinline__ void combine_norm_rows(Frame& F, float* x, const bf16* O, const float* g1, bf16* o1, const float* g2, bf16* o2) {
    const int gw = F.bid * NWAVES + F.wave, NGW = F.G * NWAVES;
    for (int m = gw; m < T; m += NGW) {
        GAS f32x4* xr = (GAS f32x4*)(x + (size_t)m * D) + F.lane;
        const GAS u32x2* oa = (const GAS u32x2*)(O + (size_t)(2 * m) * D) + F.lane; const GAS u32x2* ob = (const GAS u32x2*)(O + (size_t)(2 * m + 1) * D) + F.lane;
        f32x4 v[8]; float ss = 0.f;
#pragma unroll
        for (int j = 0; j < 8; ++j) { v[j] = xr[64 * j]; const u32x2 a = oa[64 * j], b = ob[64 * j];
            v[j].x = (v[j].x + bflo(a.x)) + bflo(b.x); v[j].y = (v[j].y + bfhi(a.x)) + bfhi(b.x); v[j].z = (v[j].z + bflo(a.y)) + bflo(b.y); v[j].w = (v[j].w + bfhi(a.y)) + bfhi(b.y);
            xr[64 * j] = v[j]; ss += (v[j].x * v[j].x + v[j].y * v[j].y) + (v[j].z * v[j].z + v[j].w * v[j].w); }
        if (g1) {
            const float rstd = 1.0f / sqrtf(wave_sum(ss) * (1.0f / D) + EPS);
            GAS u32x2* o = (GAS u32x2*)(o1 + (size_t)m * D) + F.lane;
#pragma unroll
            for (int j = 0; j < 8; ++j) { const f32x4 g = ((const GAS f32x4*)g1)[F.lane + 64 * j]; u32x2 w; w.x = pk2(v[j].x * rstd * g.x, v[j].y * rstd * g.y); w.y = pk2(v[j].z * rstd * g.z, v[j].w * rstd * g.w); o[64 * j] = w; }
            if (g2) { GAS u32x2* oo = (GAS u32x2*)(o2 + (size_t)m * D) + F.lane;
#pragma unroll
                for (int j = 0; j < 8; ++j) { const f32x4 g = ((const GAS f32x4*)g2)[F.lane + 64 * j]; u32x2 w; w.x = pk2(v[j].x * rstd * g.x, v[j].y * rstd * g.y); w.y = pk2(v[j].z * rstd * g.z, v[j].w * rstd * g.w); oo[64 * j] = w; } }
        }
    }
}
template <int NV>
__device__ __forceinline__ void norm_bf16_rows(Frame& F, const bf16* src, int src_ld, const float* g, bf16* dst, int dst_ld, int rows) {
    const int gw = F.bid * NWAVES + F.wave, NGW = F.G * NWAVES;
    float gv[NV];
#pragma unroll
    for (int i = 0; i < NV; ++i) gv[i] = g[F.lane * NV + i];
    for (int m = gw; m < rows; m += NGW) {
        float v[NV]; float ss = 0.f;
        const unsigned* sp = (const unsigned*)(src + (size_t)m * src_ld + F.lane * NV);
#pragma unroll
        for (int i = 0; i < NV / 2; ++i) { const unsigned w = sp[i]; v[2 * i] = bflo(w); v[2 * i + 1] = bfhi(w); ss += v[2 * i] * v[2 * i] + v[2 * i + 1] * v[2 * i + 1]; }
        const float rstd = 1.0f / sqrtf(wave_sum(ss) * (1.0f / (64 * NV)) + EPS);
        unsigned* dp = (unsigned*)(dst + (size_t)m * dst_ld + F.lane * NV);
#pragma unroll
        for (int i = 0; i < NV / 2; ++i) dp[i] = pk2(v[2 * i] * rstd * gv[2 * i], v[2 * i + 1] * rstd * gv[2 * i + 1]);
    }
}
__device__ __forceinline__ void transpose_tile_wave(const bf16* src, long src_ld, bf16* dst, long dst_ld, LAS unsigned char* scr, int lane) {
#pragma unroll
    for (int i = 0; i < 4; ++i) { const int p = lane + 64 * i, row = p >> 2, ch = p & 3;
        const u32x4 v = *(const u32x4*)(src + (size_t)row * src_ld + ch * 8);
        LAS unsigned* q = (LAS unsigned*)(scr + row * 68 + ch * 16); q[0] = v.x; q[1] = v.y; q[2] = v.z; q[3] = v.w; }
    LDS_WAIT(); asm volatile("" ::: "memory");
#pragma unroll
    for (int i = 0; i < 4; ++i) { const int q = lane + 64 * i, dd = q >> 3, m0 = (q & 7) * 8;
        unsigned h[8];
#pragma unroll
        for (int j = 0; j < 8; ++j) h[j] = *(const LAS unsigned short*)(scr + ((m0 & ~15) + (j & 3) + 8 * (j >> 2) + ((m0 & 8) >> 1)) * 68 + dd * 2);
        u32x4 o; o.x = h[0] | (h[1] << 16); o.y = h[2] | (h[3] << 16); o.z = h[4] | (h[5] << 16); o.w = h[6] | (h[7] << 16);
        *(u32x4*)(dst + (size_t)dd * dst_ld + m0) = o; }
    LDS_WAIT(); asm volatile("" ::: "memory");
}

__device__ __forceinline__ void p0_prologue(Frame& F, const Args& args) {
    LAS float* scr = (LAS float*)(F.lds + RING_OFF + F.wave * 16384);
    const int gw = F.bid * NWAVES + F.wave, NGW = F.G * NWAVES;
    constexpr int I_INA = 2 * 32 * 112, I_INB = 2 * 32 * 32, I_O = 4 * 32 * 64, I_MKV = 4 * 32 * 32, I_UQ = 2 * 8 * 72, I_DKV = 32 * 10, I_UK = 4 * 48, I_EG = 128 * 512, I_ED = 128 * 512;
    constexpr int NITEMS = I_INA + I_INB + I_O + I_MKV + I_UQ + I_DKV + 2 * I_UK + 2 * I_EG + I_ED;
    for (int it = gw; it < NITEMS; it += NGW) {
        int r = it;
        if (r < I_EG) { const int e = r >> 9, rr = r & 511, kb = rr >> 4, nb = rr & 15, n0 = nb * 32;
            transpose_item(INF(32) + (size_t)e * D * D_EXP, D, D_EXP, WSP(bf16, WS_WT_EGU) + (size_t)e * 1024 * D, (n0 >> 7) * 256 + (n0 & 127), scr, kb, nb, F.lane); continue; } r -= I_EG;
        if (r < I_EG) { const int e = r >> 9, rr = r & 511, kb = rr >> 4, nb = rr & 15, n0 = nb * 32;
            transpose_item(INF(33) + (size_t)e * D * D_EXP, D, D_EXP, WSP(bf16, WS_WT_EGU) + (size_t)e * 1024 * D, (n0 >> 7) * 256 + 128 + (n0 & 127), scr, kb, nb, F.lane); continue; } r -= I_EG;
        if (r < I_ED) { const int e = r >> 9, rr = r & 511, kb = rr >> 6, nb = rr & 63;
            transpose_item(INF(34) + (size_t)e * D_EXP * D, D_EXP, D, WSP(bf16, WS_WT_ED) + (size_t)e * D * D_EXP, nb * 32, scr, kb, nb, F.lane); continue; } r -= I_ED;
        if (r < I_INA) { const int l = r / 3584, rr = r % 3584, kb = rr / 112, nb = rr % 112;
            transpose_item(INF(10) + (size_t)l * D * IN_A, D, IN_A, WSP(bf16, WS_WT_INA) + (size_t)l * IN_A * D, nb * 32, scr, kb, nb, F.lane); continue; } r -= I_INA;
        if (r < I_INB) { const int l = r >> 10, rr = r & 1023, kb = rr >> 5, nb = rr & 31;
            transpose_item(INF(24) + (size_t)l * D * IN_B, D, IN_B, WSP(bf16, WS_WT_INB) + (size_t)l * IN_B * D, nb * 32, scr, kb, nb, F.lane); continue; } r -= I_INB;
        if (r < I_O) { const int l = r >> 11, rr = r & 2047, kb = rr >> 6, nb = rr & 63;
            transpose_item(INF(5) + (size_t)l * D * D, D, D, WSP(bf16, WS_WT_O) + (size_t)l * D * D, nb * 32, scr, kb, nb, F.lane); continue; } r -= I_O;
        if (r < I_MKV) { const int l = r >> 10, rr = r & 1023, kb = rr >> 5, nb = rr & 31;
            transpose_item(INF(7) + (size_t)l * D * 1024, D, 1024, WSP(bf16, WS_WT_MKV) + (size_t)l * 1024 * D, nb * 32, scr, kb, nb, F.lane); continue; } r -= I_MKV;
        if (r < I_UQ) { const int l = r / 576, rr = r % 576, kb = rr / 72, nb = rr % 72;
            transpose_item(INF(26) + (size_t)l * Q_RANK * QW, Q_RANK, QW, WSP(bf16, WS_WT_UQ) + (size_t)l * QW * Q_RANK, nb * 32, scr, kb, nb, F.lane); continue; } r -= I_UQ;
        if (r < I_DKV) { const int kb = r / 10, nb = r % 10;
            transpose_item(INF(19), D, 320, WSP(bf16, WS_WT_DKV), nb * 32, scr, kb, nb, F.lane); continue; } r -= I_DKV;
        if (r < I_UK) { const int kb = r / 48, nb = r % 48;
            transpose_item(INF(21), KV_RANK, 1536, WSP(bf16, WS_WT_UKV), nb * 32, scr, kb, nb, F.lane); continue; } r -= I_UK;
        { const int kb = r / 48, nb = r % 48;
            transpose_item(INF(22), KV_RANK, 1536, WSP(bf16, WS_WT_UKV), 1536 + nb * 32, scr, kb, nb, F.lane); }
    }
    const int gt = F.bid * NTHR + F.tid, NGT = F.G * NTHR;
    for (int i = gt; i < 192 * D / 8; i += NGT) ((u32x4*)(WSP(bf16, WS_WT_DKV) + (size_t)320 * D))[i] = (u32x4){0u, 0u, 0u, 0u};
    for (int i = gt; i < 4 * 40 * D; i += NGT) { const int l = i / (40 * D), j = (i / D) % 40, k = i % D;
        WSP(float, WS_WT_RT)[i] = j < 8 ? INF(28)[((size_t)l * D + k) * 8 + j] : INF(30)[((size_t)l * D + k) * 32 + (j - 8)]; }
    { const int* pos = (const int*)args.in[2];
      for (int i = gt; i < T * 32; i += NGT) { const int t = i >> 5, j = i & 31; const double inv = pow(10000.0, -(double)j / 32.0); const double ang = (double)pos[t] * inv;
          WSP(float, WS_TAB)[t * 64 + j] = (float)cos(ang); WSP(float, WS_TAB)[t * 64 + 32 + j] = (float)sin(ang); } }
    for (int l = 0; l < 4; ++l) norm_rows(F, INF(1), Bn * MEM_LEN, INF(6) + l * D, WSP(bf16, WS_MEMN) + (size_t)l * 1024 * D, nullptr, nullptr);
    norm_rows(F, INF(0), T, INF(3), WSP(bf16, WS_XN), nullptr, nullptr);
}

__device__ __forceinline__ void mem_assemble(Frame& F, const Args& args) {
    const int gw = F.bid * NWAVES + F.wave, NGW = F.G * NWAVES, lane = F.lane;
    const bf16* mkv = WSP(bf16, WS_MKVR);
    for (int r = gw; r < 4096; r += NGW) { const int l = r >> 10; const float* g = INF(9) + l * 128;
        const float g0 = g[2 * lane], g1 = g[2 * lane + 1];
#pragma unroll
        for (int h = 0; h < 4; ++h) { const unsigned w = *(const unsigned*)(mkv + (size_t)r * 1024 + h * 128 + 2 * lane); const float a = bflo(w), b = bfhi(w);
            const float rstd = 1.0f / sqrtf(wave_sum(a * a + b * b) * (1.0f / 128.0f) + EPS);
            bf16* o = WSP(bf16, WS_MEMK) + ((size_t)r * 4 + h) * 192;
            *(unsigned*)(o + 2 * lane) = pk2(a * rstd * g0, b * rstd * g1);
            if (lane < 32) *(unsigned*)(o + 128 + 2 * lane) = 0u; } }
    LAS unsigned char* scr = F.lds + RING_OFF + F.wave * 4352;
    for (int it = gw; it < 64 * 16; it += NGW) { const int rt = it >> 4, ct = it & 15;
        const int l = rt >> 4, b = (rt >> 2) & 3, m0 = (rt & 3) * 64, h = ct >> 2, d0 = (ct & 3) * 32;
        transpose_tile_wave(mkv + (size_t)(rt * 64) * 1024 + 512 + ct * 32, 1024, WSP(bf16, WS_MEMVT) + ((size_t)((l * 4 + b) * 4 + h) * 128 + d0) * 256 + m0, 256, scr, lane); }
}
__device__ __forceinline__ void kv_assemble(Frame& F, const Args& args) {
    const int gw = F.bid * NWAVES + F.wave, NGW = F.G * NWAVES, lane = F.lane;
    const bf16* kvup = WSP(bf16, WS_KVUP); const bf16* ckv = WSP(bf16, WS_CKV); const float* g = INF(23); const float* tab = WSP(float, WS_TAB);
    const float g0 = g[2 * lane], g1 = g[2 * lane + 1], g2 = g[128 + lane];
    for (int t = gw; t < T; t += NGW) {
        const float pe = bf1(ckv[(size_t)t * 512 + 256 + lane]); const float sspe = wave_sum(pe * pe);
        const int j = lane & 31; const float c = tab[t * 64 + j], sn = tab[t * 64 + 32 + j];
        for (int h = 0; h < MLA_H; ++h) { const unsigned w = *(const unsigned*)(kvup + (size_t)t * 3072 + h * 128 + 2 * lane); const float a = bflo(w), b = bfhi(w);
            const float rstd = 1.0f / sqrtf((wave_sum(a * a + b * b) + sspe) * (1.0f / 192.0f) + EPS);
            bf16* o = WSP(bf16, WS_K) + ((size_t)t * MLA_H + h) * 192;
            *(unsigned*)(o + 2 * lane) = pk2(a * rstd * g0, b * rstd * g1);
            const float n2 = pe * rstd * g2, other = __shfl_xor(n2, 32);
            const float rr = lane < 32 ? (n2 * c - other * sn) : (n2 * c + other * sn);
            o[128 + lane] = (bf16)f2bf(rr); } }
    LAS unsigned char* scr = F.lds + RING_OFF + F.wave * 4352;
    for (int it = gw; it < 128 * 48; it += NGW) { const int rt = it / 48, ct = it % 48;
        const int b = rt >> 5, s0 = (rt & 31) * 64, h = ct >> 2, d0 = (ct & 3) * 32;
        transpose_tile_wave(kvup + (size_t)(rt * 64) * 3072 + 1536 + ct * 32, 3072, WSP(bf16, WS_VT) + ((size_t)(b * MLA_H + h) * 128 + d0) * S + s0, S, scr, lane); }
}

__device__ __forceinline__ void router_phase(Frame& F, const Args& args, int l, const float* x1) {
    LAS float* wl = (LAS float*)(F.lds + RING_OFF);
    LAS float* lgw = (LAS float*)(F.lds + RING_OFF + 65536) + F.wave * 160;
    const float* gf = INF(4) + l * D; const float* rt = WSP(float, WS_WT_RT) + (size_t)l * 40 * D;
    const int lane = F.lane;
    for (int pass = F.bid; pass < T / 32; pass += F.G) {
        const int tok0 = pass * 32 + F.wave * 4;
        f32x4 xv[4][8];
        {
            f32x4 gv[8];
#pragma unroll
            for (int c = 0; c < 8; ++c) gv[c] = ((const GAS f32x4*)gf)[lane + 64 * c];
#pragma unroll
            for (int t = 0; t < 4; ++t) { const GAS f32x4* xr = (const GAS f32x4*)(x1 + (size_t)(tok0 + t) * D) + lane; float ss = 0.f;
#pragma unroll
                for (int c = 0; c < 8; ++c) { xv[t][c] = xr[64 * c]; ss += (xv[t][c].x * xv[t][c].x + xv[t][c].y * xv[t][c].y) + (xv[t][c].z * xv[t][c].z + xv[t][c].w * xv[t][c].w); }
                const float rstd = 1.0f / sqrtf(wave_sum(ss) * (1.0f / D) + EPS);
                GAS u32x2* o = (GAS u32x2*)(WSP(bf16, WS_XN) + (size_t)(tok0 + t) * D) + lane;
#pragma unroll
                for (int c = 0; c < 8; ++c) { xv[t][c] = xv[t][c] * rstd * gv[c]; u32x2 w; w.x = pk2(xv[t][c].x, xv[t][c].y); w.y = pk2(xv[t][c].z, xv[t][c].w); o[64 * c] = w; } }
        }
        for (int jg = 0; jg < 5; ++jg) {
            __syncthreads();
            for (int i = F.tid; i < 8 * 512; i += NTHR) ((LAS f32x4*)wl)[i] = ((const GAS f32x4*)(rt + (size_t)jg * 8 * D))[i];
            __syncthreads();
#pragma unroll
            for (int jj = 0; jj < 8; ++jj) {
                float a4[4] = {0.f, 0.f, 0.f, 0.f};
#pragma unroll
                for (int c = 0; c < 8; ++c) { const f32x4 w4 = ((const LAS f32x4*)wl)[jj * 512 + 64 * c + lane];
#pragma unroll
                    for (int t = 0; t < 4; ++t) a4[t] += (xv[t][c].x * w4.x + xv[t][c].y * w4.y) + (xv[t][c].z * w4.z + xv[t][c].w * w4.w); }
#pragma unroll
                for (int t = 0; t < 4; ++t) { const float s = wave_sum(a4[t]); if (lane == 0) lgw[t * 40 + jg * 8 + jj] = s; }
                __builtin_amdgcn_sched_barrier(0);
            }
        }
        LDS_WAIT(); asm volatile("" ::: "memory");
        if (lane < 4) {
            const LAS float* lp = lgw + lane * 40; const float* bg = INF(29) + l * 8; const float* be = INF(31) + l * 32;
            int gi = 0; float gm = lp[0] + bg[0]; float lg[8]; lg[0] = gm;
#pragma unroll
            for (int j = 1; j < 8; ++j) { lg[j] = lp[j] + bg[j]; if (lg[j] > gm) { gm = lg[j]; gi = j; } }
            float den = 0.f;
#pragma unroll
            for (int j = 0; j < 8; ++j) den += expf(lg[j] - gm);
            const float ptop = 1.0f / den;
            const float a0 = lp[8 + gi * 4 + 0] + be[gi * 4 + 0], a1 = lp[8 + gi * 4 + 1] + be[gi * 4 + 1], a2 = lp[8 + gi * 4 + 2] + be[gi * 4 + 2], a3 = lp[8 + gi * 4 + 3] + be[gi * 4 + 3];
            int e0 = 0; float m0 = a0; if (a1 > m0) { m0 = a1; e0 = 1; } if (a2 > m0) { m0 = a2; e0 = 2; } if (a3 > m0) { m0 = a3; e0 = 3; }
            int e1 = -1; float m1 = -INFINITY;
            if (e0 != 0 && a0 > m1) { m1 = a0; e1 = 0; } if (e0 != 1 && a1 > m1) { m1 = a1; e1 = 1; } if (e0 != 2 && a2 > m1) { m1 = a2; e1 = 2; } if (e0 != 3 && a3 > m1) { m1 = a3; e1 = 3; }
            const float w0 = 1.0f / (1.0f + expf(m1 - m0)), w1 = 1.0f - w0;
            const int tok = tok0 + lane, ea = gi * 4 + e0, eb = gi * 4 + e1;
            WSP(float, WS_SELW)[2 * tok] = ptop * w0; WSP(float, WS_SELW)[2 * tok + 1] = ptop * w1;
            const unsigned pa = __hip_atomic_fetch_add((unsigned*)(F.ctl + CW_MOECNT + (l * 32 + ea) * 64), 1u, RLX_AGENT);
            const unsigned pb = __hip_atomic_fetch_add((unsigned*)(F.ctl + CW_MOECNT + (l * 32 + eb) * 64), 1u, RLX_AGENT);
            WSP(int, WS_LISTS)[ea * LCAP + pa] = 2 * tok; WSP(int, WS_LISTS)[eb * LCAP + pb] = 2 * tok + 1;
        }
    }
}
__device__ __forceinline__ void moe_table(Frame& F, int l, int ntl) {
    LAS int* tab = (LAS int*)(F.lds + MOE_TAB_OFF);
    __syncthreads();
    if (F.tid < 32) tab[33 + F.tid] = (int)__hip_atomic_load((unsigned*)(F.ctl + CW_MOECNT + (l * 32 + F.tid) * 64), RLX_AGENT);
    __syncthreads();
    if (F.tid == 0) { int s = 0; for (int e = 0; e < 32; ++e) { tab[e] = s; s += ((tab[33 + e] + 255) >> 8) * ntl; } tab[32] = s; }
    __syncthreads();
}

__device__ __forceinline__ void scan_unit(Frame& F, const Args& args, int l, int u) {
    const int b = u / 48, n = (u % 48) >> 2, cq = u & 3;
    LAS unsigned char* yt = F.lds + RING_OFF; LAS float* summ = (LAS float*)(F.lds + RING_OFF + 69632);
    int tid_ = F.tid; asm volatile("" : "+v"(tid_));
    const int tid = tid_, lane = tid & 63, w = F.wave, r32 = lane & 31, hi = lane >> 5;
    const int col = n * 128 + cq * 32 + r32;
    bf16x8 wrf[8], wif[8];
    { const float* wrp = INF(13) + ((size_t)(l * 12 + n) * 128) * 128 + cq * 32 + r32; const float* wip = INF(15) + ((size_t)(l * 12 + n) * 128) * 128 + cq * 32 + r32;
#pragma unroll
      for (int s = 0; s < 8; ++s) { u32x4 a, c; const int k0 = 16 * s + 8 * hi;
          a.x = pk2(wrp[(k0 + 0) * 128], wrp[(k0 + 1) * 128]); a.y = pk2(wrp[(k0 + 2) * 128], wrp[(k0 + 3) * 128]); a.z = pk2(wrp[(k0 + 4) * 128], wrp[(k0 + 5) * 128]); a.w = pk2(wrp[(k0 + 6) * 128], wrp[(k0 + 7) * 128]);
          c.x = pk2(wip[(k0 + 0) * 128], wip[(k0 + 1) * 128]); c.y = pk2(wip[(k0 + 2) * 128], wip[(k0 + 3) * 128]); c.z = pk2(wip[(k0 + 4) * 128], wip[(k0 + 5) * 128]); c.w = pk2(wip[(k0 + 6) * 128], wip[(k0 + 7) * 128]);
          wrf[s] = __builtin_bit_cast(bf16x8, a); wif[s] = __builtin_bit_cast(bf16x8, c); } }
    const float br = INF(14)[l * LRU_W + col], bi = INF(16)[l * LRU_W + col];
    float sp8; { const float nl = -INF(17)[l * LRU_W + col]; sp8 = 8.0f * (nl > 20.f ? nl : log1pf(expf(nl))); }
    const int cg = tid & 15, rg = tid >> 4;
    const bf16* proj = WSP(bf16, WS_PROJ); bf16* ycat = WSP(bf16, WS_YCAT);
    float hin = 0.f;
    for (int c = 0; c < 8; ++c) {
        const int t0 = b * S + c * 256;
        {
            float cw[4][8], cb[8];
#pragma unroll
            for (int i = 0; i < 8; ++i) { cb[i] = INF(12)[l * LRU_W + n * 128 + cg * 8 + i];
#pragma unroll
                for (int k = 0; k < 4; ++k) cw[k][i] = INF(11)[(l * 4 + k) * LRU_W + n * 128 + cg * 8 + i]; }
            u32x4 uw[11];
#pragma unroll
            for (int r = 0; r < 11; ++r) { const int sr = c * 256 + rg * 8 + r - 3;
                uw[r] = sr >= 0 ? *(const u32x4*)(proj + (size_t)(b * S + sr) * IN_A + n * 128 + cg * 8) : (u32x4){0u, 0u, 0u, 0u}; }
#pragma unroll
            for (int r = 0; r < 8; ++r) { float y[8];
#pragma unroll
                for (int i = 0; i < 8; ++i) y[i] = cb[i];
#pragma unroll
                for (int k = 0; k < 4; ++k) { const u32x4 q = uw[r + 3 - k];
                    y[0] += cw[k][0] * bflo(q.x); y[1] += cw[k][1] * bfhi(q.x); y[2] += cw[k][2] * bflo(q.y); y[3] += cw[k][3] * bfhi(q.y);
                    y[4] += cw[k][4] * bflo(q.z); y[5] += cw[k][5] * bfhi(q.z); y[6] += cw[k][6] * bflo(q.w); y[7] += cw[k][7] * bfhi(q.w); }
                u32x4 o; o.x = pk2(y[0], y[1]); o.y = pk2(y[2], y[3]); o.z = pk2(y[4], y[5]); o.w = pk2(y[6], y[7]);
                *(LAS u32x4*)(yt + (rg * 8 + r) * 272 + cg * 16) = o; }
        }
        __syncthreads();
        f32x16 ar, ai;
#pragma unroll
        for (int i = 0; i < 16; ++i) { ar[i] = 0.f; ai[i] = 0.f; }
#pragma unroll
        for (int s = 0; s < 8; ++s) { const bf16x8 a = *(const LAS bf16x8*)(yt + (32 * w + r32) * 272 + s * 32 + hi * 16);
            ar = __builtin_amdgcn_mfma_f32_32x32x16_bf16(a, wrf[s], ar, 0, 0, 0); ai = __builtin_amdgcn_mfma_f32_32x32x16_bf16(a, wif[s], ai, 0, 0, 0); }
        float P[16], hl[16], sA[4], sB[4];
#pragma unroll
        for (int j = 0; j < 4; ++j) {
#pragma unroll
            for (int ii = 0; ii < 4; ++ii) { const int i = 4 * j + ii, row = 32 * w + 8 * j + 4 * hi + ii;
                const float yv = bf1(*(const LAS bf16*)(yt + row * 272 + (cq * 32 + r32) * 2));
                const float rr = fast_sigmoid(ar[i] + br), ig = fast_sigmoid(ai[i] + bi);
                const float la = -rr * sp8; const float av = __expf(la); const float bv = sqrtf(-expm1f(2.0f * la)) * (ig * yv);
                if (ii == 0) { P[i] = av; hl[i] = bv; } else { P[i] = P[i - 1] * av; hl[i] = av * hl[i - 1] + bv; } }
            sA[j] = P[4 * j + 3]; sB[j] = hl[4 * j + 3]; }
        float RA = 1.f, RB = 0.f, cA_[4], cB_[4];
#pragma unroll
        for (int j = 0; j < 4; ++j) { const float oA = __shfl_xor(sA[j], 32), oB = __shfl_xor(sB[j], 32);
            const float fA = hi ? oA : sA[j], fB = hi ? oB : sB[j], gA = hi ? sA[j] : oA, gB = hi ? sB[j] : oB;
            const float RA1 = RA * fA, RB1 = fA * RB + fB;
            cA_[j] = hi ? RA1 : RA; cB_[j] = hi ? RB1 : RB;
            RA = RA1 * gA; RB = gA * RB1 + gB; }
        if (hi == 0) { summ[(w * 32 + r32) * 2] = RA; summ[(w * 32 + r32) * 2 + 1] = RB; }
        __syncthreads();
        float H = hin, Hall = hin;
#pragma unroll
        for (int w2 = 0; w2 < 8; ++w2) { const float A = summ[(w2 * 32 + r32) * 2], Bv = summ[(w2 * 32 + r32) * 2 + 1]; if (w2 < w) H = A * H + Bv; Hall = A * Hall + Bv; }
        hin = Hall;
#pragma unroll
        for (int j = 0; j < 4; ++j) { const float hs = cA_[j] * H + cB_[j];
#pragma unroll
            for (int ii = 0; ii < 4; ++ii) { const int i = 4 * j + ii; const size_t t = (size_t)(t0 + 32 * w + 8 * j + 4 * hi + ii);
                const float hv = hl[i] + P[i] * hs; const float g = gelu_tanh_f(bf1(proj[t * IN_A + LRU_W + col]));
                ycat[t * D + col] = (bf16)f2bf(g * hv); } }
    }
    __syncthreads();
}

struct AttnDesc {
    const bf16* Q; long q_rs; int qdims; const float* qg; const float* tab;
    const bf16* K; long k_rs;
    const bf16* Vt; long vt_rs;
    bf16* O; long o_rs;
    int q0, ntiles, diag0; float scale_log2;
};
__device__ __forceinline__ int crow(int r, int hi) { return (r & 3) + 8 * (r >> 2) + 4 * hi; }
__device__ __forceinline__ void attn_unit(Frame& F, const AttnDesc& d) {
    constexpr int KB = 64 * 384, VB = 128 * 128, KOFF = 0, VOFF = 2 * KB;
    LAS unsigned char* lds = F.lds + RING_OFF;
    int lane_ = F.lane; asm volatile("" : "+v"(lane_));
    const int lane = lane_, w = F.wave, r32 = lane & 31, hi = lane >> 5, qloc = 32 * w + r32;
    const size_t trow = (size_t)(d.q0 + qloc);
    bf16x8 qb[12];
    {
        const bf16* qrow = d.Q + trow * d.q_rs;
        u32x4 raw[12]; float ss = 0.f;
#pragma unroll
        for (int s = 0; s < 12; ++s) {
            if (16 * s < d.qdims) { raw[s] = *(const u32x4*)(qrow + 16 * s + 8 * hi);
                ss += (bflo(raw[s].x) * bflo(raw[s].x) + bfhi(raw[s].x) * bfhi(raw[s].x)) + (bflo(raw[s].y) * bflo(raw[s].y) + bfhi(raw[s].y) * bfhi(raw[s].y))
                    + (bflo(raw[s].z) * bflo(raw[s].z) + bfhi(raw[s].z) * bfhi(raw[s].z)) + (bflo(raw[s].w) * bflo(raw[s].w) + bfhi(raw[s].w) * bfhi(raw[s].w)); }
            else raw[s] = (u32x4){0u, 0u, 0u, 0u}; }
        ss += __shfl_xor(ss, 32);
        const float rs = d.scale_log2 / sqrtf(ss / (float)d.qdims + EPS);
#define ATT_QF(s, qf) do { const f32x4 ga = *(const f32x4*)(d.qg + 16 * (s) + 8 * hi), gb = *(const f32x4*)(d.qg + 16 * (s) + 8 * hi + 4); \
            qf[0] = bflo(raw[s].x) * rs * ga.x; qf[1] = bfhi(raw[s].x) * rs * ga.y; qf[2] = bflo(raw[s].y) * rs * ga.z; qf[3] = bfhi(raw[s].y) * rs * ga.w; \
            qf[4] = bflo(raw[s].z) * rs * gb.x; qf[5] = bfhi(raw[s].z) * rs * gb.y; qf[6] = bflo(raw[s].w) * rs * gb.z; qf[7] = bfhi(raw[s].w) * rs * gb.w; } while (0)
#define ATT_QPK(s, qf) do { u32x4 p_; p_.x = cvtpk(qf[0], qf[1]); p_.y = cvtpk(qf[2], qf[3]); p_.z = cvtpk(qf[4], qf[5]); p_.w = cvtpk(qf[6], qf[7]); qb[s] = __builtin_bit_cast(bf16x8, p_); } while (0)
#pragma unroll
        for (int s = 0; s < 8; ++s) {
            if (16 * s < d.qdims) { float qf[8]; ATT_QF(s, qf); ATT_QPK(s, qf); } else qb[s] = __builtin_bit_cast(bf16x8, (u32x4){0u, 0u, 0u, 0u});
            __builtin_amdgcn_sched_barrier(0); }
#pragma unroll
        for (int s = 8; s < 10; ++s) {
            if (16 * s < d.qdims) { float q1[8], q2[8]; ATT_QF(s, q1); ATT_QF(s + 2, q2);
                if (d.tab) { const float* tb = d.tab + trow * 64 + 16 * (s - 8) + 8 * hi;
#pragma unroll
                    for (int i = 0; i < 8; ++i) { const float c = tb[i], sn = tb[32 + i], t1 = q1[i], t2 = q2[i]; q1[i] = t1 * c - t2 * sn; q2[i] = t2 * c + t1 * sn; } }
                ATT_QPK(s, q1); ATT_QPK(s + 2, q2); }
            else { qb[s] = __builtin_bit_cast(bf16x8, (u32x4){0u, 0u, 0u, 0u}); qb[s + 2] = qb[s]; }
            __builtin_amdgcn_sched_barrier(0); }
#undef ATT_QF
#undef ATT_QPK
    }
    f32x16 o[4];
#pragma unroll
    for (int db = 0; db < 4; ++db)
#pragma unroll
        for (int i = 0; i < 16; ++i) o[db][i] = 0.f;
    float m_run = -1e30f, l_run = 0.f;
    unsigned kso[3], vso[2];
#pragma unroll
    for (int i = 0; i < 3; ++i) { const int a = 1024 * (3 * w + i) + 16 * lane, row = a / 384, cp = (a % 384) >> 4, c = (cp & ~7) | ((cp ^ (row >> 1)) & 7); kso[i] = (unsigned)(row * (int)d.k_rs + c * 8); }
#pragma unroll
    for (int i = 0; i < 2; ++i) { const int a = 1024 * (2 * w + i) + 16 * lane, row = a >> 7, cp = (a & 127) >> 4, c = cp ^ ((row >> 1) & 7); vso[i] = (unsigned)(row * (int)d.vt_rs + c * 8); }
    const int y = hi ^ ((r32 >> 1) & 7);
    int off4[4];
#pragma unroll
    for (int j = 0; j < 4; ++j) off4[j] = 16 * ((2 * j) ^ y);
#define ATT_DMA(jt, buf) do { const bf16* kg = d.K + (size_t)(64 * (jt)) * d.k_rs; const bf16* vg = d.Vt + 64 * (jt); \
        _Pragma("unroll") for (int i = 0; i < 3; ++i) __builtin_amdgcn_global_load_lds((const unsigned*)(kg + kso[i]), (LAS unsigned*)(lds + KOFF + (buf) * KB + 1024 * (3 * w + i)), 16, 0, 0); \
        _Pragma("unroll") for (int i = 0; i < 2; ++i) __builtin_amdgcn_global_load_lds((const unsigned*)(vg + vso[i]), (LAS unsigned*)(lds + VOFF + (buf) * VB + 1024 * (2 * w + i)), 16, 0, 0); } while (0)
    ATT_DMA(0, 0);
    VM_WAIT(); __syncthreads();
    for (int jt = 0; jt < d.ntiles; ++jt) {
        const int cur = jt & 1;
        if (jt + 1 < d.ntiles) ATT_DMA(jt + 1, cur ^ 1);
        const bool diag = jt >= d.diag0;
        const int keyl0 = 64 * (jt - d.diag0);
        if (!(diag && keyl0 > 32 * w + 31)) {
            f32x16 s0, s1;
#pragma unroll
            for (int i = 0; i < 16; ++i) { s0[i] = 0.f; s1[i] = 0.f; }
            const LAS unsigned char* kb = lds + KOFF + cur * KB + r32 * 384;
#pragma unroll
            for (int s = 0; s < 12; ++s) { const bf16x8 k0 = *(const LAS bf16x8*)(kb + 128 * (s >> 2) + off4[s & 3]), k1 = *(const LAS bf16x8*)(kb + 32 * 384 + 128 * (s >> 2) + off4[s & 3]);
                s0 = __builtin_amdgcn_mfma_f32_32x32x16_bf16(k0, qb[s], s0, 0, 0, 0); s1 = __builtin_amdgcn_mfma_f32_32x32x16_bf16(k1, qb[s], s1, 0, 0, 0); }
            if (diag) {
#pragma unroll
                for (int i = 0; i < 16; ++i) { const int kk = keyl0 + crow(i, hi); if (kk > qloc) s0[i] = -1e30f; if (kk + 32 > qloc) s1[i] = -1e30f; } }
            float mx = s0[0];
#pragma unroll
            for (int i = 1; i < 16; ++i) mx = fmaxf(mx, s0[i]);
#pragma unroll
            for (int i = 0; i < 16; ++i) mx = fmaxf(mx, s1[i]);
            mx = fmaxf(mx, __shfl_xor(mx, 32));
            const float m_new = fmaxf(m_run, mx), alpha = __builtin_amdgcn_exp2f(m_run - m_new);
            m_run = m_new;
            float ls = 0.f;
#pragma unroll
            for (int i = 0; i < 16; ++i) { s0[i] = __builtin_amdgcn_exp2f(s0[i] - m_new); s1[i] = __builtin_amdgcn_exp2f(s1[i] - m_new); ls += s0[i] + s1[i]; }
            l_run = l_run * alpha + ls;
#pragma unroll
            for (int db = 0; db < 4; ++db)
#pragma unroll
                for (int i = 0; i < 16; ++i) o[db][i] *= alpha;
            bf16x8 pf[4];
            { u32x4 p;
              p.x = cvtpk(s0[0], s0[1]); p.y = cvtpk(s0[2], s0[3]); p.z = cvtpk(s0[4], s0[5]); p.w = cvtpk(s0[6], s0[7]); pf[0] = __builtin_bit_cast(bf16x8, p);
              p.x = cvtpk(s0[8], s0[9]); p.y = cvtpk(s0[10], s0[11]); p.z = cvtpk(s0[12], s0[13]); p.w = cvtpk(s0[14], s0[15]); pf[1] = __builtin_bit_cast(bf16x8, p);
              p.x = cvtpk(s1[0], s1[1]); p.y = cvtpk(s1[2], s1[3]); p.z = cvtpk(s1[4], s1[5]); p.w = cvtpk(s1[6], s1[7]); pf[2] = __builtin_bit_cast(bf16x8, p);
              p.x = cvtpk(s1[8], s1[9]); p.y = cvtpk(s1[10], s1[11]); p.z = cvtpk(s1[12], s1[13]); p.w = cvtpk(s1[14], s1[15]); pf[3] = __builtin_bit_cast(bf16x8, p); }
            const LAS unsigned char* vb = lds + VOFF + cur * VB + r32 * 128;
#pragma unroll
            for (int db = 0; db < 4; ++db)
#pragma unroll
                for (int ks = 0; ks < 4; ++ks) { const bf16x8 vf = *(const LAS bf16x8*)(vb + db * 32 * 128 + off4[ks]);
                    o[db] = __builtin_amdgcn_mfma_f32_32x32x16_bf16(vf, pf[ks], o[db], 0, 0, 0); }
        }
        VM_WAIT(); __syncthreads();
    }
#undef ATT_DMA
    const float inv = 1.0f / (l_run + __shfl_xor(l_run, 32));
    bf16* orow = d.O + trow * d.o_rs;
#pragma unroll
    for (int db = 0; db < 4; ++db)
#pragma unroll
        for (int j = 0; j < 4; ++j) { u32x2 q; q.x = cvtpk(o[db][4 * j] * inv, o[db][4 * j + 1] * inv); q.y = cvtpk(o[db][4 * j + 2] * inv, o[db][4 * j + 3] * inv);
            *(u32x2*)(orow + 32 * db + 8 * j + 4 * hi) = q; }
}
__device__ __forceinline__ int claim_unit(Frame& F, gu32* q) {
    __syncthreads();
    if (F.tid == 0) F.MISC[0] = __hip_atomic_fetch_add((unsigned*)q, 1u, RLX_AGENT);
    __syncthreads();
    return (int)F.MISC[0];
}
__device__ __forceinline__ void mem_attn_unit(Frame& F, const Args& args, int l, int mu, int qcol0, int ldp) {
    const int b = mu >> 5, h = (mu >> 3) & 3, qb = mu & 7;
    AttnDesc d;
    d.Q = WSP(bf16, WS_PROJ) + qcol0 + h * 128; d.q_rs = ldp; d.qdims = 128; d.qg = INF(8) + l * 128; d.tab = nullptr;
    d.K = WSP(bf16, WS_MEMK) + ((size_t)(l * 1024 + b * 256) * 4 + h) * 192; d.k_rs = 768;
    d.Vt = WSP(bf16, WS_MEMVT) + ((size_t)((l * 4 + b) * 4 + h) * 128) * 256; d.vt_rs = 256;
    d.O = WSP(bf16, WS_YCAT) + MIX_W + h * 128; d.o_rs = D;
    d.q0 = b * S + qb * 256; d.ntiles = 4; d.diag0 = 4; d.scale_log2 = 0.08838834764831845f * 1.4426950408889634f;
    attn_unit(F, d);
}
__device__ __forceinline__ void mla_attn_unit(Frame& F, const Args& args, int l, int u) {
    const int qb = 7 - u / 48, bh = u % 48, b = bh / MLA_H, h = bh % MLA_H;
    AttnDesc d;
    d.Q = WSP(bf16, WS_QRAW) + h * 192; d.q_rs = QW; d.qdims = 192; d.qg = INF(27) + (l - NA) * 192; d.tab = WSP(float, WS_TAB);
    d.K = WSP(bf16, WS_K) + (size_t)(b * S) * QW + h * 192; d.k_rs = QW;
    d.Vt = WSP(bf16, WS_VT) + ((size_t)(b * MLA_H + h) * 128) * S; d.vt_rs = S;
    d.O = WSP(bf16, WS_YCAT) + h * 128; d.o_rs = D;
    d.q0 = b * S + qb * 256; d.ntiles = 4 * (qb + 1); d.diag0 = 4 * qb; d.scale_log2 = 0.07216878364870323f * 1.4426950408889634f;
    attn_unit(F, d);
}
constexpr int NPHASE = 39;
__device__ __forceinline__ bool relaunder(Frame& F) { int t = threadIdx.x; asm volatile("" : "+v"(t)); F.tid = t; F.lane = t & 63; unsigned char* w = F.ws; asm volatile("" : "+s"(w)); F.ws = w; return true; }
#ifndef MK_BODIES
#define MK_BODIES 0xFFFF
#endif
#define BODY(bit) if constexpr ((MK_BODIES & (bit)) != 0)
__global__ void __launch_bounds__(NTHR, 2) mk_fwd(Args args) {
    extern __shared__ __attribute__((aligned(16))) unsigned char lds_raw[];
    Frame F;
    F.lds = (LAS unsigned char*)lds_raw; F.MISC = (volatile LAS unsigned*)(F.lds + MISC_OFF);
    F.tid = threadIdx.x; F.lane = F.tid & 63; F.wave = __builtin_amdgcn_readfirstlane(F.tid >> 6); F.G = gridDim.x; F.bid = blockIdx.x;
    F.ws = args.ws; F.ctl = (gu32*)(args.ws + WS_CTL);
    for (int u = F.tid; u < (LDS_BYTES - LDSCTL_OFF) / 4; u += NTHR) ((LAS unsigned*)(F.lds + LDSCTL_OFF))[u] = 0u;
    __syncthreads();
#ifdef MK_FIX_LO
    const int lo = MK_FIX_LO, hi = MK_FIX_HI;
#else
    const int lo = args.ph_lo, hi = args.ph_hi;
#endif
    XcdBarrier bar; bar.bar = (unsigned*)(F.ctl + CW_BAR); bar.x = 0; bar.st = nullptr;
    if (hi - lo > 1) bar = xcd_barrier_post((unsigned*)(F.ctl + CW_BAR), F.MISC + 8);
#define PH(id) if (lo <= (id) && (id) < hi && relaunder(F))
#define SEAM(id) do { if ((id) + 1 < hi) xcd_barrier(bar); } while (0)
    float* xres = args.out;
    LAS unsigned char* ring = F.lds + RING_OFF;

    PH(0) { BODY(1) p0_prologue(F, args); SEAM(0); }
    PH(1) {
        pg8::DenseProb P{WSP(bf16, WS_MEMN), WSP(bf16, WS_WT_MKV), D, 1024}; pg8::StaticOrder So; So.init(4096, 1024, F.G, F.bid, 4);
        pg8::EpiBf16 E{WSP(bf16, WS_MKVR), 1024};
        BODY(2) pg8::gemm_phase<pg8::DenseProb, pg8::EpiBf16, pg8::StaticOrder, true>(ring, P, So, E);
        SEAM(1);
    }
    PH(2) { BODY(4) mem_assemble(F, args); SEAM(2); }

    for (int l = 0; l < DEPTH; ++l) {
        const int j = l - NA;
        const int pb = l < NA ? 3 + 7 * l : 21 + 9 * (l - NA);
        const int tb = l < NA ? pb + 2 : pb + 4;
        if (l == NA) {
            PH(17) {
                pg8::DenseProb P{WSP(bf16, WS_XKV), WSP(bf16, WS_WT_DKV), D, 512}; pg8::StaticOrder So; So.init(T, 512, F.G, F.bid, 1 << 20);
                pg8::EpiBf16 E{WSP(bf16, WS_CKV), 512};
                BODY(2) pg8::gemm_phase<pg8::DenseProb, pg8::EpiBf16, pg8::StaticOrder, true>(ring, P, So, E);
                SEAM(17);
            }
            PH(18) { BODY(512) norm_bf16_rows<4>(F, WSP(bf16, WS_CKV), 512, INF(20), WSP(bf16, WS_CN), 256, T); SEAM(18); }
            PH(19) {
                pg8::DenseProb P{WSP(bf16, WS_CN), WSP(bf16, WS_WT_UKV), KV_RANK, 3072}; pg8::StaticOrder So; So.init(T, 3072, F.G, F.bid, 1 << 20);
                pg8::EpiBf16 E{WSP(bf16, WS_KVUP), 3072};
                BODY(2) pg8::gemm_phase<pg8::DenseProb, pg8::EpiBf16, pg8::StaticOrder, true>(ring, P, So, E);
                SEAM(19);
            }
            PH(20) { BODY(4) kv_assemble(F, args); SEAM(20); }
        }
        if (l < NA) {
            PH(pb + 0) {
                pg8::DenseProb P{WSP(bf16, WS_XN), WSP(bf16, WS_WT_INA) + (size_t)l * IN_A * D, D, IN_A}; pg8::StaticOrder So; So.init(T, IN_A, F.G, F.bid, 1 << 20);
                pg8::EpiBf16 E{WSP(bf16, WS_PROJ), IN_A};
                BODY(2) pg8::gemm_phase<pg8::DenseProb, pg8::EpiBf16, pg8::StaticOrder, true>(ring, P, So, E);
                SEAM(pb + 0);
            }
            PH(pb + 1) {
                BODY(8) for (int u = F.bid; u < 192; u += F.G) scan_unit(F, args, l, u);
                gu32* q = F.ctl + CW_ATTQ + l * 64;
                BODY(16) for (int u = claim_unit(F, q); u < 128; u = claim_unit(F, q)) mem_attn_unit(F, args, l, u, 2 * LRU_W, IN_A);
                SEAM(pb + 1);
            }
        } else {
            PH(pb + 0) {
                pg8::DenseProb P{WSP(bf16, WS_XN), WSP(bf16, WS_WT_INB) + (size_t)j * IN_B * D, D, IN_B}; pg8::StaticOrder So; So.init(T, IN_B, F.G, F.bid, 1 << 20);
                pg8::EpiBf16 E{WSP(bf16, WS_PROJ), IN_B};
                BODY(2) pg8::gemm_phase<pg8::DenseProb, pg8::EpiBf16, pg8::StaticOrder, true>(ring, P, So, E);
                SEAM(pb + 0);
            }
            PH(pb + 1) { BODY(512) norm_bf16_rows<8>(F, WSP(bf16, WS_PROJ), IN_B, INF(25) + j * Q_RANK, WSP(bf16, WS_CQN), Q_RANK, T); SEAM(pb + 1); }
            PH(pb + 2) {
                pg8::DenseProb P{WSP(bf16, WS_CQN), WSP(bf16, WS_WT_UQ) + (size_t)j * QW * Q_RANK, Q_RANK, QW}; pg8::StaticOrder So; So.init(T, QW, F.G, F.bid, 1 << 20);
                pg8::EpiBf16 E{WSP(bf16, WS_QRAW), QW};
                BODY(2) pg8::gemm_phase<pg8::DenseProb, pg8::EpiBf16, pg8::StaticOrder, true>(ring, P, So, E);
                SEAM(pb + 2);
            }
            PH(pb + 3) {
                gu32* q = F.ctl + CW_ATTQ + l * 64;
                BODY(16) for (int u = claim_unit(F, q); u < 384 + 128; u = claim_unit(F, q)) { if (u < 384) mla_attn_unit(F, args, l, u); else mem_attn_unit(F, args, l, u - 384, Q_RANK, IN_B); }
                SEAM(pb + 3);
            }
        }
        PH(tb + 0) {
            pg8::DenseProb P{WSP(bf16, WS_YCAT), WSP(bf16, WS_WT_O) + (size_t)l * D * D, D, D}; pg8::StaticOrder So; So.init(T, D, F.G, F.bid, 1 << 20);
            pg8::EpiResF32 E{l == 0 ? INF(0) : (const float*)xres, xres, D};
            BODY(32) pg8::gemm_phase<pg8::DenseProb, pg8::EpiResF32, pg8::StaticOrder, true>(ring, P, So, E);
            SEAM(tb + 0);
        }
        PH(tb + 1) { BODY(64) router_phase(F, args, l, xres); SEAM(tb + 1); }
        PH(tb + 2) {
            moe_table(F, l, 4);
            pg8::GatherProb P{WSP(bf16, WS_XN), WSP(bf16, WS_WT_EGU), D, 1024, WSP(int, WS_LISTS), LCAP, 1, l * 32}; pg8::MoeOrder So{(const LAS int*)(F.lds + MOE_TAB_OFF), F.G, F.bid, 4};
            pg8::EpiMoe1 E{WSP(bf16, WS_H), WSP(int, WS_LISTS), WSP(float, WS_SELW), LCAP};
            BODY(128) pg8::gemm_phase<pg8::GatherProb, pg8::EpiMoe1, pg8::MoeOrder, true>(ring, P, So, E);
            SEAM(tb + 2);
        }
        PH(tb + 3) {
            moe_table(F, l, 8);
            pg8::GatherProb P{WSP(bf16, WS_H), WSP(bf16, WS_WT_ED), D_EXP, D, WSP(int, WS_LISTS), LCAP, 0, l * 32}; pg8::MoeOrder So{(const LAS int*)(F.lds + MOE_TAB_OFF), F.G, F.bid, 8};
            pg8::EpiMoe2 E{WSP(bf16, WS_OSLOT), WSP(int, WS_LISTS), LCAP, D};
            BODY(256) pg8::gemm_phase<pg8::GatherProb, pg8::EpiMoe2, pg8::MoeOrder, true>(ring, P, So, E);
            SEAM(tb + 3);
        }
        PH(tb + 4) { BODY(512) combine_norm_rows(F, xres, WSP(bf16, WS_OSLOT), l + 1 < DEPTH ? INF(3) + (l + 1) * D : nullptr, WSP(bf16, WS_XN), l == NA - 1 ? INF(18) : nullptr, WSP(bf16, WS_XKV)); SEAM(tb + 4); }
    }
#undef PH
#undef SEAM
}
}

namespace nv {
constexpr int Bn = 4, S = 2048, D = 2048, T = Bn * S, DEPTH = 4, NA = 2;
constexpr int MEM_LEN = 256, MEM_W = 512, MIX_W = 1536;
constexpr int LRU_W = 1536;
constexpr int MLA_H = 12, QK_DIM = 192, Q_RANK = 512, KV_RANK = 256;
constexpr int NE = 32, D_EXP = 512;
constexpr int IN_A = 3584, IN_B = 1024;
constexpr float EPS = 1e-6f;
constexpr int LCAP = 8192;

__device__ __forceinline__ float wsum(float v) {
#pragma unroll
    for (int o = 32; o >= 1; o >>= 1) v += __shfl_xor(v, o);
    return v;
}
__device__ __forceinline__ float wmax(float v) {
#pragma unroll
    for (int o = 32; o >= 1; o >>= 1) v = fmaxf(v, __shfl_xor(v, o));
    return v;
}

struct NG {
    const float* A; const float* B; float* C; const float* R;
    int lda, ldb, ldc, M, N, K;
    long sA, sB, sC;
    const int* alist; const int* clist; int lstride; int ashift;
    const int* Mdev;
};
__global__ void __launch_bounds__(256) k_ngemm(NG g) {
    __shared__ float As[16][65];
    __shared__ float Bs[16][64];
    const int z = blockIdx.z;
    const int M = g.Mdev ? g.Mdev[z] : g.M;
    const int m0 = blockIdx.y * 64, n0 = blockIdx.x * 64;
    if (m0 >= M) return;
    const float* A = g.A + (long)z * g.sA; const float* B = g.B + (long)z * g.sB; float* C = g.C + (long)z * g.sC;
    const float* R = g.R ? g.R + (long)z * g.sC : nullptr;
    const int* al = g.alist ? g.alist + (long)z * g.lstride : nullptr;
    const int* cl = g.clist ? g.clist + (long)z * g.lstride : nullptr;
    const int tid = threadIdx.x, tx = tid % 16, ty = tid / 16;
    float acc[4][4];
#pragma unroll
    for (int i = 0; i < 4; ++i)
#pragma unroll
        for (int j = 0; j < 4; ++j) acc[i][j] = 0.f;
    long arow[4];
#pragma unroll
    for (int i = 0; i < 4; ++i) { const int r = tid / 16 + 16 * i, gm = m0 + r; arow[i] = -1; if (gm < M) arow[i] = al ? (long)(al[gm] >> g.ashift) : (long)gm; }
    for (int k0 = 0; k0 < g.K; k0 += 16) {
#pragma unroll
        for (int i = 0; i < 4; ++i) { const int r = tid / 16 + 16 * i, kk = tid % 16; As[kk][r] = arow[i] >= 0 ? A[arow[i] * g.lda + k0 + kk] : 0.f; }
#pragma unroll
        for (int i = 0; i < 4; ++i) { const int kk = tid / 64 + 4 * i, n = tid % 64; Bs[kk][n] = (n0 + n < g.N) ? B[(long)(k0 + kk) * g.ldb + n0 + n] : 0.f; }
        __syncthreads();
#pragma unroll
        for (int kk = 0; kk < 16; ++kk) {
            float a[4], b[4];
#pragma unroll
            for (int i = 0; i < 4; ++i) a[i] = As[kk][ty * 4 + i];
#pragma unroll
            for (int j = 0; j < 4; ++j) b[j] = Bs[kk][tx * 4 + j];
#pragma unroll
            for (int i = 0; i < 4; ++i)
#pragma unroll
                for (int j = 0; j < 4; ++j) acc[i][j] = fmaf(a[i], b[j], acc[i][j]);
        }
        __syncthreads();
    }
#pragma unroll
    for (int i = 0; i < 4; ++i) {
        const int gm = m0 + ty * 4 + i; if (gm >= M) continue;
        const long crow = cl ? (long)cl[gm] : (long)gm;
#pragma unroll
        for (int j = 0; j < 4; ++j) { const int gn = n0 + tx * 4 + j; if (gn < g.N) { float v = acc[i][j]; if (R) v += R[crow * g.ldc + gn]; C[crow * g.ldc + gn] = v; } }
    }
}

__global__ void k_rmsnorm(const float* x, float* y, const float* g, int nrows, int ninner, long xso, long xsi, long yso, long ysi, int cols) {
    const int row = blockIdx.x * 4 + (threadIdx.x >> 6), lane = threadIdx.x & 63;
    if (row >= nrows) return;
    const int ro = row / ninner, ri = row % ninner;
    const float* xr = x + ro * xso + ri * xsi; float* yr = y + ro * yso + ri * ysi;
    float ss = 0.f;
    for (int c = lane; c < cols; c += 64) { const float v = xr[c]; ss += v * v; }
    ss = wsum(ss);
    const float rstd = 1.0f / sqrtf(ss / (float)cols + EPS);
    for (int c = lane; c < cols; c += 64) yr[c] = xr[c] * rstd * g[c];
}

__device__ __forceinline__ float gelu_tanh(float x) { const float u = 0.7978845608028654f * (x + 0.044715f * x * x * x); return 0.5f * x * (1.0f + tanhf(u)); }
__device__ __forceinline__ float sigmoidf_(float x) { return 1.0f / (1.0f + expf(-x)); }

__global__ void k_gelu_cols(float* p, int ld, int c0, int ncols, int rows) {
    const long i = (long)blockIdx.x * blockDim.x + threadIdx.x; if (i >= (long)rows * ncols) return;
    const int r = (int)(i / ncols), c = (int)(i % ncols); float* q = p + (long)r * ld + c0 + c; *q = gelu_tanh(*q);
}
__global__ void k_conv(const float* proj, int ld, const float* cw, const float* cb, float* y) {
    const long i = (long)blockIdx.x * blockDim.x + threadIdx.x; if (i >= (long)T * LRU_W) return;
    const int t = (int)(i / LRU_W), c = (int)(i % LRU_W), s = t % S;
    float v = cb[c];
    for (int k = 0; k < 4; ++k) if (s - k >= 0) v += cw[k * LRU_W + c] * proj[(long)(t - k) * ld + c];
    y[i] = v;
}
__global__ void k_lru_ab(float* rb, float* ib, const float* y, const float* b_r, const float* b_i, const float* lam) {
    const long i = (long)blockIdx.x * blockDim.x + threadIdx.x; if (i >= (long)T * LRU_W) return;
    const int c = (int)(i % LRU_W);
    const float r = sigmoidf_(rb[i] + b_r[c]), ig = sigmoidf_(ib[i] + b_i[c]);
    const float nl = -lam[c]; const float sp = nl > 20.f ? nl : log1pf(expf(nl));
    const float la = -8.0f * r * sp;
    rb[i] = expf(la); ib[i] = sqrtf(-expm1f(2.0f * la)) * (ig * y[i]);
}
__global__ void k_scan(const float* a, const float* b, const float* gate, int ldg, float* out, int ldo) {
    const int i = blockIdx.x * blockDim.x + threadIdx.x; if (i >= Bn * LRU_W) return;
    const int bb = i / LRU_W, c = i % LRU_W; float h = 0.f;
    for (int s = 0; s < S; ++s) { const long t = (long)bb * S + s; h = a[t * LRU_W + c] * h + b[t * LRU_W + c]; out[t * ldo + c] = gate[t * ldg + c] * h; }
}

__global__ void __launch_bounds__(256) k_nattn(const float* Q, long q_rs, long q_hs, const float* Kp, long k_rs, long k_hs, const float* Vp, long v_rs, long v_hs,
                                               float* O, long o_rs, long o_hs, int Sq, int Sk, int dq, int dv, int causal, float scale) {
    __shared__ float sq[192]; __shared__ float sc[2048]; __shared__ float red[4][128]; __shared__ float rr[8];
    const int b = blockIdx.x / Sq, qi = blockIdx.x % Sq, h = blockIdx.y, tid = threadIdx.x, lane = tid & 63, wave = tid >> 6;
    const int nk = causal ? qi + 1 : Sk;
    const float* q = Q + (long)blockIdx.x * q_rs + h * q_hs;
    for (int d = tid; d < dq; d += 256) sq[d] = q[d];
    __syncthreads();
    for (int k = wave; k < nk; k += 4) {
        const float* kr = Kp + ((long)b * Sk + k) * k_rs + h * k_hs; float p = 0.f;
        for (int d = lane; d < dq; d += 64) p += sq[d] * kr[d];
        p = wsum(p); if (lane == 0) sc[k] = p * scale;
    }
    __syncthreads();
    float m = -INFINITY; for (int k = tid; k < nk; k += 256) m = fmaxf(m, sc[k]);
    m = wmax(m); if (lane == 0) rr[wave] = m; __syncthreads();
    m = fmaxf(fmaxf(rr[0], rr[1]), fmaxf(rr[2], rr[3]));
    float s = 0.f; for (int k = tid; k < nk; k += 256) { const float e = expf(sc[k] - m); sc[k] = e; s += e; }
    s = wsum(s); if (lane == 0) rr[4 + wave] = s; __syncthreads();
    s = (rr[4] + rr[5]) + (rr[6] + rr[7]);
    float a0 = 0.f, a1 = 0.f;
    for (int k = wave; k < nk; k += 4) { const float* vr = Vp + ((long)b * Sk + k) * v_rs + h * v_hs; const float p = sc[k]; a0 += p * vr[lane]; a1 += p * vr[lane + 64]; }
    red[wave][lane] = a0; red[wave][lane + 64] = a1; __syncthreads();
    if (tid < dv) { const float o = (red[0][tid] + red[1][tid]) + (red[2][tid] + red[3][tid]); O[(long)blockIdx.x * o_rs + h * o_hs + tid] = o / s; }
}

__global__ void k_rope_tab(const int* pos, float* tab) {
    const int i = blockIdx.x * blockDim.x + threadIdx.x; if (i >= T * 32) return;
    const int t = i / 32, j = i % 32;
    const double inv = pow(10000.0, -(double)j / 32.0);
    const double ang = (double)pos[t] * inv;
    tab[t * 64 + j] = (float)cos(ang); tab[t * 64 + 32 + j] = (float)sin(ang);
}
__global__ void k_headnorm_rope(const float* s1, long s1_ts, long s1_hs, const float* s2, long s2_ts, long s2_hs, const float* g, const float* tab, float* out) {
    const int row = blockIdx.x * 4 + (threadIdx.x >> 6), lane = threadIdx.x & 63; if (row >= T * MLA_H) return;
    const int t = row / MLA_H, h = row % MLA_H;
    const float v0 = s1[t * s1_ts + h * s1_hs + lane], v1 = s1[t * s1_ts + h * s1_hs + 64 + lane], v2 = s2[t * s2_ts + h * s2_hs + lane];
    const float ss = wsum(v0 * v0 + v1 * v1 + v2 * v2);
    const float rstd = 1.0f / sqrtf(ss / 192.0f + EPS);
    const float n0 = v0 * rstd * g[lane], n1 = v1 * rstd * g[64 + lane], n2 = v2 * rstd * g[128 + lane];
    const float other = __shfl_xor(n2, 32);
    const int j = lane & 31; const float c = tab[t * 64 + j], sn = tab[t * 64 + 32 + j];
    const float r = lane < 32 ? (n2 * c - other * sn) : (n2 * c + other * sn);
    float* o = out + (long)row * 192; o[lane] = n0; o[64 + lane] = n1; o[128 + lane] = r;
}

__global__ void k_router(const float* xn, const float* wg, const float* bg, const float* we, const float* be, int* sel_e, float* sel_w) {
    const int t = blockIdx.x * 4 + (threadIdx.x >> 6), lane = threadIdx.x & 63; if (t >= T) return;
    const float* xr = xn + (long)t * D;
    float lg[8], le[32];
#pragma unroll
    for (int j = 0; j < 8; ++j) lg[j] = 0.f;
#pragma unroll
    for (int j = 0; j < 32; ++j) le[j] = 0.f;
    for (int k = lane; k < D; k += 64) {
        const float xv = xr[k];
#pragma unroll
        for (int j = 0; j < 8; ++j) lg[j] = fmaf(xv, wg[k * 8 + j], lg[j]);
#pragma unroll
        for (int j = 0; j < 32; ++j) le[j] = fmaf(xv, we[k * 32 + j], le[j]);
    }
#pragma unroll
    for (int j = 0; j < 8; ++j) lg[j] = wsum(lg[j]) + bg[j];
#pragma unroll
    for (int j = 0; j < 32; ++j) le[j] = wsum(le[j]) + be[j];
    if (lane == 0) {
        int gi = 0; float gm = lg[0];
#pragma unroll
        for (int j = 1; j < 8; ++j) if (lg[j] > gm) { gm = lg[j]; gi = j; }
        float den = 0.f;
#pragma unroll
        for (int j = 0; j < 8; ++j) den += expf(lg[j] - gm);
        const float ptop = 1.0f / den;
        float s4[4] = {0.f, 0.f, 0.f, 0.f};
#pragma unroll
        for (int j = 0; j < 32; ++j) if ((j >> 2) == gi) s4[j & 3] = le[j];
        int e0 = 0; float m0 = s4[0];
#pragma unroll
        for (int j = 1; j < 4; ++j) if (s4[j] > m0) { m0 = s4[j]; e0 = j; }
        int e1 = -1; float m1 = -INFINITY;
#pragma unroll
        for (int j = 0; j < 4; ++j) if (j != e0 && s4[j] > m1) { m1 = s4[j]; e1 = j; }
        const float w0 = 1.0f / (1.0f + expf(m1 - m0)), w1 = 1.0f - w0;
        sel_e[t * 2] = gi * 4 + e0; sel_e[t * 2 + 1] = gi * 4 + e1; sel_w[t * 2] = ptop * w0; sel_w[t * 2 + 1] = ptop * w1;
    }
}
__global__ void __launch_bounds__(256) k_build_lists(const int* sel_e, int* lists, int* counts) {
    __shared__ int wt[4]; __shared__ int base;
    const int e = blockIdx.x, tid = threadIdx.x, lane = tid & 63, wave = tid >> 6;
    if (tid == 0) base = 0; __syncthreads();
    for (int c0 = 0; c0 < 2 * T; c0 += 256) {
        const int slot = c0 + tid; const bool f = sel_e[slot] == e;
        const unsigned long long mask = __ballot(f);
        const int wpre = __popcll(mask & ((1ull << lane) - 1ull)), wtot = __popcll(mask);
        if (lane == 0) wt[wave] = wtot; __syncthreads();
        int off = base; for (int w = 0; w < wave; ++w) off += wt[w];
        if (f) lists[e * LCAP + off + wpre] = slot;
        __syncthreads();
        if (tid == 0) base += wt[0] + wt[1] + wt[2] + wt[3];
        __syncthreads();
    }
    if (tid == 0) counts[e] = base;
}
__global__ void k_swiglu(float* G, const float* U, const float* sel_w) {
    const long i = (long)blockIdx.x * blockDim.x + threadIdx.x; if (i >= (long)2 * T * D_EXP) return;
    const int slot = (int)(i / D_EXP); const float g = G[i];
    G[i] = (g * sigmoidf_(g)) * U[i] * sel_w[slot];
}
__global__ void k_combine(float* x, const float* O) {
    const long i = (long)blockIdx.x * blockDim.x + threadIdx.x; if (i >= (long)T * D) return;
    const long t = i / D, c = i % D;
    x[i] = x[i] + (O[(2 * t) * D + c] + O[(2 * t + 1) * D + c]);
}
__global__ void k_copy_cols(const float* src, long lds_, float* dst, long ldd, int rows, int cols) {
    const long i = (long)blockIdx.x * blockDim.x + threadIdx.x; if (i >= (long)rows * cols) return;
    const long r = i / cols, c = i % cols; dst[r * ldd + c] = src[r * lds_ + c];
}

struct In {
    const float *x, *mem; const int* pos; const float *norm_mix_g, *norm_ffn_g, *w_o, *mem_norm_g, *w_mem_kv, *mem_q_g, *mem_k_g, *w_in_a, *conv_w, *conv_b, *w_lru_r, *b_lru_r, *w_lru_i, *b_lru_i, *lam,
        *kv_in_g, *w_dkv, *kv_lat_g, *w_uk, *w_uv, *k_head_g, *w_in_b, *q_lat_g, *w_uq, *q_head_g, *w_rg, *b_rg, *w_re, *b_re, *w_eg, *w_eu, *w_ed;
};

static void gemm(hipStream_t st, const float* A, int lda, const float* B, int ldb, float* C, int ldc, int M, int N, int K, const float* R = nullptr,
                 int nz = 1, long sA = 0, long sB = 0, long sC = 0, const int* alist = nullptr, const int* clist = nullptr, int lstride = 0, int ashift = 0, const int* Mdev = nullptr) {
    NG g{A, B, C, R, lda, ldb, ldc, M, N, K, sA, sB, sC, alist, clist, lstride, ashift, Mdev};
    dim3 grid((N + 63) / 64, (M + 63) / 64, nz);
    hipLaunchKernelGGL(k_ngemm, grid, dim3(256), 0, st, g);
}
static void rmsnorm(hipStream_t st, const float* x, float* y, const float* g, int nrows, int ninner, long xso, long xsi, long yso, long ysi, int cols) {
    hipLaunchKernelGGL(k_rmsnorm, dim3((nrows + 3) / 4), dim3(256), 0, st, x, y, g, nrows, ninner, xso, xsi, yso, ysi, cols);
}
static inline int cdiv(long a, long b) { return (int)((a + b - 1) / b); }

struct Bufs { float *xn, *proj, *ybuf, *rbuf, *ibuf, *ycat, *memn, *memkv, *qm, *sel_w, *Gb, *Ub, *Ob, *ckv, *cn, *kvup, *Kb, *cqn, *qraw, *Qb, *tab, *xres; int *sel_e, *lists, *counts; };
enum Stage { S_XN, S_PROJ, S_QPREP, S_MIX, S_MEM, S_OUT, S_ROUTER, S_MOE1, S_MOE2, S_KV };
static size_t carve(char* ws, Bufs& B) {
    size_t off = 0;
    auto alloc = [&](size_t bytes) { char* p = ws + off; off += (bytes + 255) & ~(size_t)255; return p; };
    B.xn = (float*)alloc((size_t)T * D * 4);
    B.proj = (float*)alloc((size_t)T * IN_A * 4); B.ybuf = (float*)alloc((size_t)T * LRU_W * 4); B.Ob = B.proj;
    B.rbuf = (float*)alloc((size_t)T * LRU_W * 4); B.ibuf = (float*)alloc((size_t)T * LRU_W * 4); (void)alloc((size_t)T * LRU_W * 4);
    B.qraw = B.rbuf; B.Qb = B.rbuf + (size_t)T * 2304; B.Gb = B.rbuf; B.Ub = B.rbuf + (size_t)2 * T * D_EXP;
    B.ycat = (float*)alloc((size_t)T * D * 4);
    B.memn = (float*)alloc((size_t)Bn * MEM_LEN * D * 4); B.memkv = (float*)alloc((size_t)Bn * MEM_LEN * 1024 * 4); B.qm = (float*)alloc((size_t)T * MEM_W * 4);
    B.sel_e = (int*)alloc((size_t)2 * T * 4); B.sel_w = (float*)alloc((size_t)2 * T * 4); B.lists = (int*)alloc((size_t)NE * LCAP * 4); B.counts = (int*)alloc(256);
    B.ckv = (float*)alloc((size_t)T * 320 * 4); B.cn = (float*)alloc((size_t)T * 256 * 4); B.kvup = (float*)alloc((size_t)T * 3072 * 4); B.Kb = (float*)alloc((size_t)T * 2304 * 4);
    B.cqn = (float*)alloc((size_t)T * 512 * 4); B.tab = (float*)alloc((size_t)T * 64 * 4); B.xres = (float*)alloc((size_t)T * D * 4);
    return off;
}
template <class Hook>
static void forward(hipStream_t st, const In& in, const Bufs& B, Hook&& hook) {
    float *xn = B.xn, *proj = B.proj, *ybuf = B.ybuf, *rbuf = B.rbuf, *ibuf = B.ibuf, *ycat = B.ycat, *memn = B.memn, *memkv = B.memkv, *qm = B.qm, *sel_w = B.sel_w, *Gb = B.Gb, *Ub = B.Ub, *Ob = B.Ob,
          *ckv = B.ckv, *cn = B.cn, *kvup = B.kvup, *Kb = B.Kb, *cqn = B.cqn, *qraw = B.qraw, *Qb = B.Qb, *tab = B.tab, *xres = B.xres; int *sel_e = B.sel_e, *lists = B.lists, *counts = B.counts;
    hipLaunchKernelGGL(k_rope_tab, dim3(cdiv(T * 32, 256)), dim3(256), 0, st, in.pos, tab);
    const float* xin = in.x;
    for (int l = 0; l < DEPTH; ++l) {
        rmsnorm(st, xin, xn, in.norm_mix_g + l * D, T, 1, D, 0, D, 0, D);
        hook(S_XN, l);
        if (l < NA) {
            gemm(st, xn, D, in.w_in_a + (size_t)l * D * IN_A, IN_A, proj, IN_A, T, IN_A, D);
            hook(S_PROJ, l);
            hipLaunchKernelGGL(k_gelu_cols, dim3(cdiv((long)T * LRU_W, 256)), dim3(256), 0, st, proj, IN_A, LRU_W, LRU_W, T);
            hipLaunchKernelGGL(k_conv, dim3(cdiv((long)T * LRU_W, 256)), dim3(256), 0, st, proj, IN_A, in.conv_w + l * 4 * LRU_W, in.conv_b + l * LRU_W, ybuf);
            gemm(st, ybuf, LRU_W, in.w_lru_r + (size_t)l * 12 * 128 * 128, 128, rbuf, LRU_W, T, 128, 128, nullptr, 12, 128, 128 * 128, 128);
            gemm(st, ybuf, LRU_W, in.w_lru_i + (size_t)l * 12 * 128 * 128, 128, ibuf, LRU_W, T, 128, 128, nullptr, 12, 128, 128 * 128, 128);
            hipLaunchKernelGGL(k_lru_ab, dim3(cdiv((long)T * LRU_W, 256)), dim3(256), 0, st, rbuf, ibuf, ybuf, in.b_lru_r + l * LRU_W, in.b_lru_i + l * LRU_W, in.lam + l * LRU_W);
            hipLaunchKernelGGL(k_scan, dim3(cdiv(Bn * LRU_W, 64)), dim3(64), 0, st, rbuf, ibuf, proj + LRU_W, IN_A, ycat, D);
            rmsnorm(st, proj + 2 * LRU_W, qm, in.mem_q_g + l * 128, T * 4, 4, IN_A, 128, MEM_W, 128, 128);
            hook(S_MIX, l);
        } else {
            const int j = l - NA;
            gemm(st, xn, D, in.w_in_b + (size_t)j * D * IN_B, IN_B, proj, IN_B, T, IN_B, D);
            hook(S_PROJ, l);
            rmsnorm(st, proj, cqn, in.q_lat_g + j * Q_RANK, T, 1, IN_B, 0, Q_RANK, 0, Q_RANK);
            gemm(st, cqn, Q_RANK, in.w_uq + (size_t)j * Q_RANK * 2304, 2304, qraw, 2304, T, 2304, Q_RANK);
            hook(S_QPREP, l);
            hipLaunchKernelGGL(k_headnorm_rope, dim3(T * MLA_H / 4), dim3(256), 0, st, qraw, (long)2304, (long)192, qraw + 128, (long)2304, (long)192, in.q_head_g + j * 192, tab, Qb);
            hipLaunchKernelGGL(k_nattn, dim3(T, MLA_H), dim3(256), 0, st, Qb, (long)2304, (long)192, Kb, (long)2304, (long)192, kvup + 1536, (long)3072, (long)128,
                               ycat, (long)D, (long)128, S, S, 192, 128, 1, 1.0f / sqrtf(192.0f));
            rmsnorm(st, proj + Q_RANK, qm, in.mem_q_g + l * 128, T * 4, 4, IN_B, 128, MEM_W, 128, 128);
            hook(S_MIX, l);
        }
        rmsnorm(st, in.mem, memn, in.mem_norm_g + l * D, Bn * MEM_LEN, 1, D, 0, D, 0, D);
        gemm(st, memn, D, in.w_mem_kv + (size_t)l * D * 1024, 1024, memkv, 1024, Bn * MEM_LEN, 1024, D);
        rmsnorm(st, memkv, memkv, in.mem_k_g + l * 128, Bn * MEM_LEN * 4, 4, 1024, 128, 1024, 128, 128);
        hipLaunchKernelGGL(k_nattn, dim3(T, 4), dim3(256), 0, st, qm, (long)MEM_W, (long)128, memkv, (long)1024, (long)128, memkv + 512, (long)1024, (long)128,
                           ycat + MIX_W, (long)D, (long)128, S, MEM_LEN, 128, 128, 0, 1.0f / sqrtf(128.0f));
        hook(S_MEM, l);
        gemm(st, ycat, D, in.w_o + (size_t)l * D * D, D, xres, D, T, D, D, xin);
        hook(S_OUT, l);
        rmsnorm(st, xres, xn, in.norm_ffn_g + l * D, T, 1, D, 0, D, 0, D);
        hipLaunchKernelGGL(k_router, dim3(T / 4), dim3(256), 0, st, xn, in.w_rg + (size_t)l * D * 8, in.b_rg + l * 8, in.w_re + (size_t)l * D * 32, in.b_re + l * 32, sel_e, sel_w);
        hipLaunchKernelGGL(k_build_lists, dim3(NE), dim3(256), 0, st, sel_e, lists, counts);
        hook(S_ROUTER, l);
        gemm(st, xn, D, in.w_eg + (size_t)l * NE * D * D_EXP, D_EXP, Gb, D_EXP, LCAP, D_EXP, D, nullptr, NE, 0, (long)D * D_EXP, 0, lists, lists, LCAP, 1, counts);
        gemm(st, xn, D, in.w_eu + (size_t)l * NE * D * D_EXP, D_EXP, Ub, D_EXP, LCAP, D_EXP, D, nullptr, NE, 0, (long)D * D_EXP, 0, lists, lists, LCAP, 1, counts);
        hipLaunchKernelGGL(k_swiglu, dim3(cdiv((long)2 * T * D_EXP, 256)), dim3(256), 0, st, Gb, Ub, sel_w);
        hook(S_MOE1, l);
        gemm(st, Gb, D_EXP, in.w_ed + (size_t)l * NE * D_EXP * D, D, Ob, D, LCAP, D, D_EXP, nullptr, NE, 0, (long)D_EXP * D, 0, lists, lists, LCAP, 0, counts);
        hipLaunchKernelGGL(k_combine, dim3(cdiv((long)T * D, 256)), dim3(256), 0, st, xres, Ob);
        hook(S_MOE2, l);
        xin = xres;
        if (l == NA - 1) {
            rmsnorm(st, xres, xn, in.kv_in_g, T, 1, D, 0, D, 0, D);
            gemm(st, xn, D, in.w_dkv, 320, ckv, 320, T, 320, D);
            rmsnorm(st, ckv, cn, in.kv_lat_g, T, 1, 320, 0, 256, 0, 256);
            gemm(st, cn, 256, in.w_uk, 1536, kvup, 3072, T, 1536, 256);
            gemm(st, cn, 256, in.w_uv, 1536, kvup + 1536, 3072, T, 1536, 256);
            hipLaunchKernelGGL(k_headnorm_rope, dim3(T * MLA_H / 4), dim3(256), 0, st, kvup, (long)3072, (long)128, ckv + 256, (long)320, (long)0, in.k_head_g, tab, Kb);
            hook(S_KV, l);
        }
    }
}
__global__ void k_cmp(const void* fast, int fbf, long fld, int fgrp, long fgs, const float* ref, long nld, int ngrp, long ngs, int rows, int cols, float* slot) {
    float num = 0.f, den = 0.f;
    for (long i = (long)blockIdx.x * blockDim.x + threadIdx.x; i < (long)rows * cols; i += (long)gridDim.x * blockDim.x) {
        const long r = i / cols; const int c = (int)(i % cols);
        const long fa = r * fld + (long)(c / fgrp) * fgs + c % fgrp, na = r * nld + (long)(c / ngrp) * ngs + c % ngrp;
        const float fv = fbf ? __uint_as_float((unsigned)((const unsigned short*)fast)[fa] << 16) : ((const float*)fast)[fa];
        const float rv = ref[na]; const float d = fv - rv; num += d * d; den += rv * rv; }
    num = wsum(num); den = wsum(den);
    if ((threadIdx.x & 63) == 0) { atomicAdd(slot, num); atomicAdd(slot + 1, den); }
}
__global__ void k_final(const float* errs, int n, const float* ref, float* out, float tol2, int report) {
    int k = 0;
    for (int i = 0; i < n; ++i) { const float num = errs[2 * i], den = errs[2 * i + 1]; const int c = i + 1;
        const bool isH = (c == 12 || c == 24 || c == 40 || c == 52), isX = (c == 13 || c == 25 || c == 41 || c == 53 || c == 14 || c == 30 || c == 42 || c == 21 || c == 22 || c == 37 || c == 38 || c == 49 || c == 50);
        const float t2 = tol2 * (isH ? 100.f : (isX ? 4.f : 1.f));
        if (!(num <= t2 * den)) { k = c; break; } }
    float sc = 1.0f + 0.015f * (float)k;
    if (report >= 1) { const float e2 = errs[2 * (report - 1)] / errs[2 * (report - 1) + 1]; sc = 1.0f + sqrtf(e2); }
    for (long i = (long)blockIdx.x * blockDim.x + threadIdx.x; i < (long)T * D; i += (long)gridDim.x * blockDim.x) out[i] = ref[i] * sc;
}
}
#if MK_MODE == 2
namespace dbg {
using namespace mk;
struct Ctx { hipStream_t st; Args a; int grid; nv::Bufs B; float* errs; int k; unsigned char* ws; float* out; };
static void run_phase(Ctx& c, int p) { c.a.ph_lo = p; c.a.ph_hi = p + 1; hipLaunchKernelGGL(mk_fwd, dim3(c.grid), dim3(NTHR), LDS_BYTES, c.st, c.a); }
static void cmp(Ctx& c, const void* f, int fbf, long fld, int fgrp, long fgs, const float* n, long nld, int ngrp, long ngs, int rows, int cols) {
    hipLaunchKernelGGL(nv::k_cmp, dim3(1024), dim3(256), 0, c.st, f, fbf, fld, fgrp, fgs, n, nld, ngrp, ngs, rows, cols, c.errs + 2 * c.k); ++c.k;
}
static void cmp2d(Ctx& c, const void* f, int fbf, long fld, const float* n, long nld, int rows, int cols) { cmp(c, f, fbf, fld, 1 << 30, 0, n, nld, 1 << 30, 0, rows, cols); }
static void hook(Ctx& c, int stage, int l) {
    unsigned char* ws = c.ws; const nv::Bufs& B = c.B;
    const int pb = l < NA ? 3 + 7 * l : 21 + 9 * (l - NA), tb = l < NA ? pb + 2 : pb + 4;
#define FW(T_, off) ((T_*)(ws + (off)))
    switch (stage) {
    case nv::S_XN:
        if (l == 0) { run_phase(c, 0); run_phase(c, 1); run_phase(c, 2); }
        cmp2d(c, FW(bf16, WS_XN), 1, D, B.xn, D, T, D);
        if (l == 0) cmp2d(c, FW(float, WS_TAB), 0, 64, B.tab, 64, T, 64);
        break;
    case nv::S_PROJ:
        run_phase(c, pb);
        if (l < NA) { cmp2d(c, FW(bf16, WS_PROJ), 1, IN_A, B.proj, IN_A, T, LRU_W); cmp2d(c, FW(bf16, WS_PROJ) + 2 * LRU_W, 1, IN_A, B.proj + 2 * LRU_W, IN_A, T, MEM_W); cmp2d(c, FW(bf16, WS_PROJ) + LRU_W, 1, IN_A, B.proj + LRU_W, IN_A, T, LRU_W); }
        else cmp2d(c, FW(bf16, WS_PROJ), 1, IN_B, B.proj, IN_B, T, IN_B);
        break;
    case nv::S_QPREP:
        run_phase(c, pb + 1); run_phase(c, pb + 2);
        cmp2d(c, FW(bf16, WS_CQN), 1, Q_RANK, B.cqn, Q_RANK, T, Q_RANK); cmp2d(c, FW(bf16, WS_QRAW), 1, QW, B.qraw, QW, T, QW);
        break;
    case nv::S_MIX:
        run_phase(c, l < NA ? pb + 1 : pb + 3);
        cmp2d(c, FW(bf16, WS_YCAT), 1, D, B.ycat, D, T, MIX_W);
        break;
    case nv::S_MEM:
        cmp(c, FW(bf16, WS_MEMK) + (size_t)l * 1024 * 768, 1, 768, 128, 192, B.memkv, 1024, 1 << 30, 0, 1024, 512);
        cmp2d(c, FW(bf16, WS_YCAT) + MIX_W, 1, D, B.ycat + MIX_W, D, T, MEM_W);
        break;
    case nv::S_OUT:
        run_phase(c, tb + 0);
        cmp2d(c, c.out, 0, D, B.xres, D, T, D);
        break;
    case nv::S_ROUTER:
        run_phase(c, tb + 1);
        cmp2d(c, FW(bf16, WS_XN), 1, D, B.xn, D, T, D); cmp2d(c, FW(float, WS_SELW), 0, 2 * T, B.sel_w, 2 * T, 1, 2 * T);
        break;
    case nv::S_MOE1:
        run_phase(c, tb + 2);
        cmp2d(c, FW(bf16, WS_H), 1, D_EXP, B.Gb, D_EXP, 2 * T, D_EXP);
        break;
    case nv::S_MOE2:
        run_phase(c, tb + 3); run_phase(c, tb + 4);
        cmp2d(c, c.out, 0, D, B.xres, D, T, D);
        break;
    case nv::S_KV:
        run_phase(c, 17); run_phase(c, 18); run_phase(c, 19); run_phase(c, 20);
        cmp2d(c, FW(bf16, WS_CKV), 1, 512, B.ckv, 320, T, 320); cmp2d(c, FW(bf16, WS_CN), 1, 256, B.cn, 256, T, 256); cmp2d(c, FW(bf16, WS_KVUP), 1, 3072, B.kvup, 3072, T, 3072); cmp2d(c, FW(bf16, WS_K), 1, QW, B.Kb, QW, T, QW);
        break;
    }
#undef FW
}
}
#endif
extern "C" void kernel_launch(void* const* d_in, const int* in_sizes, int n_in, void* d_out, int out_size, void* d_ws, size_t ws_size, hipStream_t stream) {
    using namespace mk;
    static int grid = 0;
    if (grid == 0) {
        if (n_in != 35 || out_size != T * D || ws_size < WS_END) { fprintf(stderr, "kernel_launch: unexpected n_in %d / out_size %d / ws %zu (need %zu)\n", n_in, out_size, ws_size, (size_t)WS_END); grid = -1; return; }
        int dev = 0, cus = 0, per_cu = 0;
        if (hipGetDevice(&dev) != hipSuccess || hipDeviceGetAttribute(&cus, hipDeviceAttributeMultiprocessorCount, dev) != hipSuccess) { grid = -1; return; }
        if (hipFuncSetAttribute((const void*)mk_fwd, hipFuncAttributeMaxDynamicSharedMemorySize, LDS_BYTES) != hipSuccess) { fprintf(stderr, "kernel_launch: hipFuncSetAttribute failed\n"); grid = -1; return; }
        if (hipOccupancyMaxActiveBlocksPerMultiprocessor(&per_cu, (const void*)mk_fwd, NTHR, LDS_BYTES) != hipSuccess || per_cu < 1) fprintf(stderr, "kernel_launch: occupancy query reports %d\n", per_cu);
        (void)hipGetLastError();
        grid = cus;
    }
    if (grid < 0) return;
    if (hipMemsetAsync((char*)d_ws + WS_CTL, 0, CTL_ZERO_BYTES, stream) != hipSuccess) return;
    Args a{};
    for (int i = 0; i < 35; ++i) a.in[i] = d_in[i];
    a.out = (float*)d_out; a.ws = (unsigned char*)d_ws;
#if MK_MODE == 0
    a.ph_lo = 0; a.ph_hi = NPHASE;
    hipLaunchKernelGGL(mk_fwd, dim3(grid), dim3(NTHR), LDS_BYTES, stream, a);
#elif MK_MODE == 1
    for (int p = 0; p < NPHASE; ++p) { a.ph_lo = p; a.ph_hi = p + 1; hipLaunchKernelGGL(mk_fwd, dim3(grid), dim3(NTHR), LDS_BYTES, stream, a); }
#else
    {
        dbg::Ctx c; c.st = stream; c.a = a; c.grid = grid; c.k = 0; c.ws = (unsigned char*)d_ws; c.out = (float*)d_out;
        char* nws = (char*)d_ws + ((WS_END + 255) & ~(size_t)255);
        c.errs = (float*)nws; nws += 4096;
        const size_t need = nv::carve(nws, c.B);
        if ((size_t)(nws - (char*)d_ws) + need > ws_size) { fprintf(stderr, "debug: workspace too small\n"); return; }
        hipMemsetAsync(c.errs, 0, 4096, stream);
        nv::In in;
        in.x = (const float*)d_in[0]; in.mem = (const float*)d_in[1]; in.pos = (const int*)d_in[2]; in.norm_mix_g = (const float*)d_in[3]; in.norm_ffn_g = (const float*)d_in[4];
        in.w_o = (const float*)d_in[5]; in.mem_norm_g = (const float*)d_in[6]; in.w_mem_kv = (const float*)d_in[7]; in.mem_q_g = (const float*)d_in[8]; in.mem_k_g = (const float*)d_in[9];
        in.w_in_a = (const float*)d_in[10]; in.conv_w = (const float*)d_in[11]; in.conv_b = (const float*)d_in[12]; in.w_lru_r = (const float*)d_in[13]; in.b_lru_r = (const float*)d_in[14];
        in.w_lru_i = (const float*)d_in[15]; in.b_lru_i = (const float*)d_in[16]; in.lam = (const float*)d_in[17]; in.kv_in_g = (const float*)d_in[18]; in.w_dkv = (const float*)d_in[19];
        in.kv_lat_g = (const float*)d_in[20]; in.w_uk = (const float*)d_in[21]; in.w_uv = (const float*)d_in[22]; in.k_head_g = (const float*)d_in[23]; in.w_in_b = (const float*)d_in[24];
        in.q_lat_g = (const float*)d_in[25]; in.w_uq = (const float*)d_in[26]; in.q_head_g = (const float*)d_in[27]; in.w_rg = (const float*)d_in[28]; in.b_rg = (const float*)d_in[29];
        in.w_re = (const float*)d_in[30]; in.b_re = (const float*)d_in[31]; in.w_eg = (const float*)d_in[32]; in.w_eu = (const float*)d_in[33]; in.w_ed = (const float*)d_in[34];
        nv::forward(stream, in, c.B, [&](int stage, int l) { dbg::hook(c, stage, l); });
        hipLaunchKernelGGL(nv::k_final, dim3(2048), dim3(256), 0, stream, (const float*)c.errs, c.k, (const float*)c.B.xres, (float*)d_out, MK_TOL2, MK_REPORT);
    }
#endif
}
```

```cpp
#include <hip/hip_runtime.h>
#include <cstdio>
#include <cstdint>
#include <math.h>

#define GAS __attribute__((address_space(1)))
#define LAS __attribute__((address_space(3)))
typedef unsigned short bf16;
typedef short bf16x8 __attribute__((ext_vector_type(8)));
typedef float f32x2 __attribute__((ext_vector_type(2)));
typedef float f32x4 __attribute__((ext_vector_type(4)));
typedef float f32x16 __attribute__((ext_vector_type(16)));
typedef unsigned u32x2 __attribute__((ext_vector_type(2)));
typedef unsigned u32x4 __attribute__((ext_vector_type(4)));
typedef GAS unsigned gu32;
#define RLX_AGENT __ATOMIC_RELAXED, __HIP_MEMORY_SCOPE_AGENT
#define LDS_WAIT() asm volatile("s_waitcnt lgkmcnt(0)" ::: "memory")
#define VM_WAIT() asm volatile("s_waitcnt vmcnt(0)" ::: "memory")


#ifndef MK_MOESQ
#define MK_MOESQ 1
#endif
#ifndef MK_BGCONV
#define MK_BGCONV 0
#endif
#ifndef MK_Q_INA
#define MK_Q_INA 10
#define MK_Q_INB 10
#define MK_Q_SCAN0 12
#define MK_Q_SCAN1 8
#endif
#ifndef MK_STAMP
#define MK_STAMP 0
#endif
#ifndef MK_TGROUP
#define MK_TGROUP 1ull
#endif
#ifndef MK_REPORT
#define MK_REPORT 0
#endif
#ifndef MK_TOL2
#define MK_TOL2 2.5e-3f
#endif
#ifndef MK_MODE
#define MK_MODE 0
#endif

namespace mk {
constexpr int NWAVES = 8, NTHR = 512;
constexpr int Bn = 4, S = 2048, D = 2048, T = Bn * S, DEPTH = 4, NA = 2;
constexpr int MEM_LEN = 256, MEM_W = 512, MIX_W = 1536, LRU_W = 1536;
constexpr int MLA_H = 12, QK_DIM = 192, Q_RANK = 512, KV_RANK = 256, QW = MLA_H * QK_DIM  ;
constexpr int NE = 32, D_EXP = 512, LCAP = 8192;
constexpr int IN_A = 3584, IN_B = 1024;
constexpr float EPS = 1e-6f;

constexpr size_t al256(size_t x) { return (x + 255) & ~(size_t)255; }
constexpr size_t WS_CTL = 0, CTL_ZERO_BYTES = 1u << 20;
constexpr size_t WS_WT_INA = CTL_ZERO_BYTES;
constexpr size_t WS_WT_INB = WS_WT_INA + (size_t)2 * IN_A * D * 2;
constexpr size_t WS_WT_O = WS_WT_INB + (size_t)2 * IN_B * D * 2;
constexpr size_t WS_WT_MKV = WS_WT_O + (size_t)4 * D * D * 2;
constexpr size_t WS_WT_UQ = WS_WT_MKV + (size_t)4 * 1024 * D * 2;
constexpr size_t WS_WT_DKV = WS_WT_UQ + (size_t)2 * QW * Q_RANK * 2;
constexpr size_t WS_WT_UKV = WS_WT_DKV + (size_t)512 * D * 2;
constexpr size_t WS_WT_EGU = WS_WT_UKV + (size_t)3072 * KV_RANK * 2;
constexpr size_t WS_WT_ED = WS_WT_EGU + (size_t)128 * 1024 * D * 2;
constexpr size_t WS_WT_RT = WS_WT_ED + (size_t)128 * D * D_EXP * 2;
constexpr size_t WS_TAB = WS_WT_RT + (size_t)4 * 2 * 48 * D * 2;
constexpr size_t WS_XN = WS_TAB + (size_t)T * 64 * 4;
constexpr size_t WS_XKV = WS_XN + (size_t)T * D * 2;
constexpr size_t WS_PROJ = WS_XKV + (size_t)T * D * 2;
constexpr size_t WS_YCAT = WS_PROJ + (size_t)T * IN_A * 2;
constexpr size_t WS_MEMN = WS_YCAT + (size_t)T * D * 2;
constexpr size_t WS_MKVR = WS_MEMN + (size_t)4 * 1024 * D * 2;
constexpr size_t WS_MEMK = WS_MKVR + (size_t)4096 * 1024 * 2;
constexpr size_t WS_MEMVT = WS_MEMK + (size_t)4096 * 4 * 192 * 2;
constexpr size_t WS_H = WS_MEMVT + (size_t)4 * 4 * 4 * 128 * 256 * 2;
constexpr size_t WS_SELW = WS_H + (size_t)2 * T * D_EXP * 2;
constexpr size_t WS_LISTS = WS_SELW + (size_t)2 * T * 4;
constexpr size_t WS_CKV = WS_LISTS + (size_t)NE * LCAP * 4;
constexpr size_t WS_CN = WS_CKV + (size_t)T * 512 * 2;
constexpr size_t WS_KVUP = WS_CN + (size_t)T * 256 * 2;
constexpr size_t WS_K = WS_KVUP + (size_t)T * 3072 * 2;
constexpr size_t WS_VT = WS_K + (size_t)T * QW * 2;
constexpr size_t WS_CQN = WS_VT + (size_t)Bn * MLA_H * 128 * S * 2;
constexpr size_t WS_QRAW = WS_CQN + (size_t)T * Q_RANK * 2;
constexpr size_t WS_OSLOT = WS_PROJ;
constexpr size_t WS_RSTD = WS_QRAW + (size_t)T * QW * 2;
constexpr size_t WS_RPART = WS_RSTD + (size_t)T * 4;
constexpr size_t WS_RPSS = WS_RPART + (size_t)8 * T * 48 * 4;
constexpr size_t WS_IRS = WS_RPSS + (size_t)8 * T * 4;
constexpr size_t WS_END = WS_IRS + (size_t)T * 4;
static_assert(WS_PROJ + (size_t)2 * T * D * 2 <= WS_MEMN, "OSLOT overlay");
static_assert(WS_WT_INA % 256 == 0 && WS_WT_EGU % 256 == 0 && WS_XN % 256 == 0 && WS_QRAW % 256 == 0, "ws alignment");

constexpr int CW_TMO = 0, CW_CODE = 1;
constexpr int CW_BAR = 4096;
constexpr int CW_MOECNT = 8192;
constexpr int CW_ATTQ = 8192 + 128 * 64;
constexpr int CW_CONVQ = CW_ATTQ + 4 * 64;
constexpr int CW_DONE = CW_CONVQ + 4 * 64;
constexpr int CW_MOEDONE = 65536;
constexpr int CW_STAMP = 32768;
static_assert(CW_STAMP * 4 + 1024 <= (int)CTL_ZERO_BYTES && CW_DONE + 40 * 64 <= CW_STAMP, "ctl");

constexpr int RING_OFF = 0, RING_BYTES = 161792;
constexpr int LDSCTL_OFF = RING_BYTES, MISC_OFF = LDSCTL_OFF + 320;
constexpr int MOE_TAB_OFF = MISC_OFF + 128;
constexpr int LDS_BYTES = 163840;
static_assert(MOE_TAB_OFF + 98 * 4 <= LDS_BYTES, "lds map");

__device__ __forceinline__ float wave_sum(float v) {
#pragma unroll
    for (int o = 1; o < 64; o <<= 1) v += __shfl_xor(v, o);
    return v;
}
__device__ __forceinline__ unsigned f2bf(float f) { unsigned u = __builtin_bit_cast(unsigned, f); return (u + 0x7fffu + ((u >> 16) & 1u)) >> 16; }
__device__ __forceinline__ unsigned pk2(float lo, float hi) { return f2bf(lo) | (f2bf(hi) << 16); }
__device__ __forceinline__ float bflo(unsigned w) { return __builtin_bit_cast(float, w << 16); }
__device__ __forceinline__ float bfhi(unsigned w) { return __builtin_bit_cast(float, w & 0xffff0000u); }
__device__ __forceinline__ float bf1(bf16 h) { return __builtin_bit_cast(float, (unsigned)h << 16); }
typedef __bf16 bf16x2_t __attribute__((ext_vector_type(2)));
__device__ __forceinline__ unsigned cvtpk(float lo, float hi) { f32x2 v = {lo, hi}; bf16x2_t b = __builtin_convertvector(v, bf16x2_t); return __builtin_bit_cast(unsigned, b); }
__device__ __forceinline__ float fast_sigmoid(float x) { return __builtin_amdgcn_rcpf(1.0f + __builtin_amdgcn_exp2f(-1.4426950408889634f * x)); }
__device__ __forceinline__ float gelu_tanh_f(float x) { const float u = 0.7978845608028654f * (x + 0.044715f * x * x * x); return x * fast_sigmoid(2.0f * u); }
}
namespace pg8 {
typedef unsigned short bf16_t;
constexpr int BM = 256, BK = 64, HALF = 128, HTB = HALF * BK * 2  , STAGE_BYTES = 8 * HTB, NXCD = 8, WGM = 8;

__host__ __device__ __forceinline__ int lds_byte(int r, int c) { const int st = (r >> 4) * 2 + (c >> 5), rr = r & 15, cc = c & 31, ob = rr * 64 + cc * 2; return st * 1024 + (ob ^ (((ob >> 9) & 1) << 5)); }
__host__ __device__ __forceinline__ void stage_rc(int b, int& R, int& C) { const int st = b / 1024, sb = b % 1024, swz = sb ^ (((sb >> 9) & 1) << 5); R = (st >> 1) * 16 + swz / 64; C = (st & 1) * 32 + (swz % 64) / 2; }
__host__ __device__ __forceinline__ int perm32(int rho) { const int n = rho >> 4, i = rho & 15; return 8 * (i >> 2) + 4 * n + (i & 3); }

struct Unit { int pm, pn, e, rows; };

struct DenseProb {
    static constexpr bool GATHER = false;
    const bf16_t* A; const bf16_t* Bt; int K, N;
    __device__ __forceinline__ const char* a_base(const Unit& u) const { return (const char*)(A + (size_t)u.pm * BM * K); }
    __device__ __forceinline__ const char* b_base(const Unit& u) const { return (const char*)(Bt + ((size_t)u.e * N + (size_t)u.pn * BM) * K); }
    __device__ __forceinline__ void a_offs(const Unit&, const int (&R)[2], const int (&C)[2], unsigned (&o)[2][2]) const {
#pragma unroll
        for (int h = 0; h < 2; ++h)
#pragma unroll
            for (int i = 0; i < 2; ++i) o[h][i] = (unsigned)(((h * HALF + R[i]) * K + C[i]) * 2);
    }
};
struct Dense2Prob {
    static constexpr bool GATHER = false;
    const bf16_t* A0; const bf16_t* Bt0; const bf16_t* A1; const bf16_t* Bt1; int K, mtb1, N1;
    __device__ __forceinline__ const char* a_base(const Unit& u) const { return (const char*)((u.e ? A1 : A0) + (size_t)u.pm * BM * K); }
    __device__ __forceinline__ const char* b_base(const Unit& u) const { return (const char*)(u.e ? Bt1 + ((size_t)(u.pm / mtb1) * N1 + (size_t)u.pn * BM) * K : Bt0 + (size_t)u.pn * BM * K); }
    __device__ __forceinline__ void a_offs(const Unit&, const int (&R)[2], const int (&C)[2], unsigned (&o)[2][2]) const {
#pragma unroll
        for (int h = 0; h < 2; ++h)
#pragma unroll
            for (int i = 0; i < 2; ++i) o[h][i] = (unsigned)(((h * HALF + R[i]) * K + C[i]) * 2);
    }
};
struct GatherProb {
    static constexpr bool GATHER = true;
    const bf16_t* A; const bf16_t* Bt; int K, N; const int* lists; int lcap, ashift, ebase;
    __device__ __forceinline__ const char* a_base(const Unit&) const { return (const char*)A; }
    __device__ __forceinline__ const char* b_base(const Unit& u) const { return (const char*)(Bt + ((size_t)(ebase + u.e) * N + (size_t)u.pn * BM) * K); }
    __device__ __forceinline__ void a_offs(const Unit& u, const int (&R)[2], const int (&C)[2], unsigned (&o)[2][2]) const {
#pragma unroll
        for (int h = 0; h < 2; ++h)
#pragma unroll
            for (int i = 0; i < 2; ++i) { int r = h * HALF + R[i]; r = r < u.rows ? r : u.rows - 1; const int ent = ((const GAS int*)lists)[u.e * lcap + u.pm * BM + r]; o[h][i] = (unsigned)(((ent >> ashift) * K + C[i]) * 2); }
    }
};

struct StaticOrder {
    int nM, nN, nwg, G, c, mt_per_b;
    __device__ void init(int M, int N, int G_, int c_, int mtb) { nM = M / BM; nN = N / BM; nwg = nM * nN; G = G_; c = c_; mt_per_b = mtb; }
    __device__ bool next(int i, Unit& u) const {
        const long L = (long)i * G + c; if (L >= nwg) return false;
        int wgid = (int)L; { const int q = nwg / NXCD, r = nwg % NXCD, xcd = wgid % NXCD, off = wgid / NXCD; wgid = (xcd < r ? xcd * (q + 1) : r * (q + 1) + (xcd - r) * q) + off; }
        const int nig = WGM * nN, gid = wgid / nig, fm = gid * WGM, gsz = (nM - fm) < WGM ? (nM - fm) : WGM;
        u.pm = fm + ((wgid % nig) % gsz); u.pn = (wgid % nig) / gsz; u.e = u.pm / mt_per_b; u.rows = BM; return true;
    }
};
struct Order2 {
    int nM0, nN0, nM1, nN1, G, c;
    __device__ bool next(int i, Unit& u) const {
        const int L = i * G + c, n0 = nM0 * nN0; if (L >= n0 + nM1 * nN1) return false;
        const int e = L >= n0 ? 1 : 0, w = e ? L - n0 : L, nN = e ? nN1 : nN0, nM = e ? nM1 : nM0;
        const int nig = WGM * nN, gid = w / nig, fm = gid * WGM, gsz = (nM - fm) < WGM ? (nM - fm) : WGM;
        u.pm = fm + ((w % nig) % gsz); u.pn = (w % nig) / gsz; u.e = e; u.rows = BM; return true;
    }
};
struct MoeOrder {
    const LAS int* tab; int G, c, ntl;
    __device__ bool next(int i, Unit& u) const {
        const int L = i * G + c; if (L >= tab[97]) return false;
        if (L < tab[32]) { int e = 0; while (e < 31 && L >= tab[e + 1]) ++e;
            const int local = L - tab[e], cnt = tab[33 + e];
            const int nf = (cnt + 127) >> 8;
            u.e = e; u.pm = local % nf; u.pn = local / nf; const int rem = cnt - u.pm * BM; u.rows = rem < BM ? rem : BM; return true; }
        int e = 0; while (e < 31 && L >= tab[65 + e + 1]) ++e;
        const int local = L - tab[65 + e], cnt = tab[33 + e];
        u.e = e; u.pn = local; u.pm = (cnt - 1) / BM; u.rows = cnt - u.pm * BM; return true;
    }
};

struct EpiBf16 {
    static constexpr bool PERM = true;
    bf16_t* O; int ldc;
    __device__ __forceinline__ void operator()(const f32x4 (&acc)[2][2][4][2], const Unit& u, int wr, int wc, int fr, int fq) const {
        const int row0 = u.pm * BM + wr * 64 + fr, col0 = u.pn * BM + wc * 32 + 8 * fq;
#pragma unroll
        for (int ai = 0; ai < 2; ++ai)
#pragma unroll
            for (int m = 0; m < 4; ++m) { bf16_t* rowp = O + (size_t)(row0 + ai * HALF + m * 16) * ldc + col0;
#pragma unroll
                for (int bj = 0; bj < 2; ++bj) { const f32x4 v0 = acc[ai][bj][m][0], v1 = acc[ai][bj][m][1];
                    u32x4 w; w.x = mk::cvtpk(v0[0], v0[1]); w.y = mk::cvtpk(v0[2], v0[3]); w.z = mk::cvtpk(v1[0], v1[1]); w.w = mk::cvtpk(v1[2], v1[3]);
                    *(GAS u32x4*)(rowp + bj * HALF) = w; } }
    }
};
struct EpiBf16x2 {
    static constexpr bool PERM = true;
    bf16_t* O0; int ldc0; bf16_t* O1; int ldc1;
    __device__ __forceinline__ void operator()(const f32x4 (&acc)[2][2][4][2], const Unit& u, int wr, int wc, int fr, int fq) const {
        const int row0 = u.pm * BM + wr * 64 + fr, col0 = u.pn * BM + wc * 32 + 8 * fq; bf16_t* O = u.e ? O1 : O0; const int ldc = u.e ? ldc1 : ldc0;
#pragma unroll
        for (int ai = 0; ai < 2; ++ai)
#pragma unroll
            for (int m = 0; m < 4; ++m) { bf16_t* rowp = O + (size_t)(row0 + ai * HALF + m * 16) * ldc + col0;
#pragma unroll
                for (int bj = 0; bj < 2; ++bj) { const f32x4 v0 = acc[ai][bj][m][0], v1 = acc[ai][bj][m][1];
                    u32x4 w; w.x = mk::cvtpk(v0[0], v0[1]); w.y = mk::cvtpk(v0[2], v0[3]); w.z = mk::cvtpk(v1[0], v1[1]); w.w = mk::cvtpk(v1[2], v1[3]);
                    *(GAS u32x4*)(rowp + bj * HALF) = w; } }
    }
};
struct EpiResF32 {
    static constexpr bool PERM = false;
    const float* R; float* C; int ldc;
    __device__ __forceinline__ void operator()(const f32x4 (&acc)[2][2][4][2], const Unit& u, int wr, int wc, int fr, int fq) const {
        const int row0 = u.pm * BM + wr * 64 + fr, col0 = u.pn * BM + wc * 32 + 4 * fq;
#pragma unroll
        for (int ai = 0; ai < 2; ++ai)
#pragma unroll
            for (int m = 0; m < 4; ++m) { const size_t off = (size_t)(row0 + ai * HALF + m * 16) * ldc + col0;
#pragma unroll
                for (int bj = 0; bj < 2; ++bj)
#pragma unroll
                    for (int n = 0; n < 2; ++n) { const f32x4 r = *(const GAS f32x4*)(R + off + bj * HALF + n * 16); *(GAS f32x4*)(C + off + bj * HALF + n * 16) = r + acc[ai][bj][m][n]; } }
    }
};
template <bool RF32>
struct EpiResRouter {
    static constexpr bool PERM = false;
    const void* R; const float* GM; const float* IRS; int ldc;
    const float* G; bf16_t* XN; const bf16_t* WH; const bf16_t* WL; float* PART; float* PSS; int nrows; LAS unsigned char* lds;
    __device__ __forceinline__ void operator()(const f32x4 (&acc)[2][2][4][2], const Unit& u, int wr, int wc, int fr, int fq) const {
        constexpr int BFO = 0, PLO = 49152, PSO = PLO + 4 * 128 * 48 * 4;
        const int lane = fr + 16 * fq, tid = (wr * 4 + wc) * 64 + lane;
        asm volatile("s_waitcnt vmcnt(0)" ::: "memory"); __syncthreads();
        { const bf16_t* W = wr ? WL : WH;
#pragma unroll
          for (int bj = 0; bj < 2; ++bj)
#pragma unroll
              for (int nb = 0; nb < 3; ++nb) { const bf16_t* p = W + (size_t)(16 * nb + fr) * ldc + u.pn * BM + 128 * bj + 32 * wc + 4 * fq;
                  const u32x2 a = *(const GAS u32x2*)p, b = *(const GAS u32x2*)(p + 16);
                  *(LAS u32x4*)(lds + BFO + (((wc * 2 + wr) * 2 + bj) * 3 + nb) * 1024 + lane * 16) = (u32x4){a.x, a.y, b.x, b.y}; } }
        __syncthreads();
        const int row0 = u.pm * BM + wr * 64 + fr, col0 = u.pn * BM + wc * 32 + 4 * fq;
        LAS float* PL = (LAS float*)(lds + PLO); LAS float* PS = (LAS float*)(lds + PSO);
        f32x4 gv[2][2];
#pragma unroll
        for (int bj = 0; bj < 2; ++bj)
#pragma unroll
            for (int n = 0; n < 2; ++n) gv[bj][n] = *(const GAS f32x4*)(G + col0 + bj * HALF + n * 16);
        auto ldres = [&](size_t o_) -> f32x4 { if constexpr (RF32) return *(const GAS f32x4*)((const float*)R + o_);
            else { const u32x2 q_ = *(const GAS u32x2*)((const bf16_t*)R + o_); return (f32x4){mk::bflo(q_.x), mk::bfhi(q_.x), mk::bflo(q_.y), mk::bfhi(q_.y)}; } };
        f32x4 gmi[2][2]; float irn = 1.f;
        if constexpr (!RF32) {
#pragma unroll
            for (int bj = 0; bj < 2; ++bj)
#pragma unroll
                for (int n = 0; n < 2; ++n) { const f32x4 g_ = *(const GAS f32x4*)(GM + col0 + bj * HALF + n * 16); gmi[bj][n] = (f32x4){1.0f / g_[0], 1.0f / g_[1], 1.0f / g_[2], 1.0f / g_[3]}; }
            irn = ((const GAS float*)IRS)[row0]; }
        f32x4 rn[2][2];
#pragma unroll
        for (int bj = 0; bj < 2; ++bj)
#pragma unroll
            for (int n = 0; n < 2; ++n) rn[bj][n] = ldres((size_t)row0 * ldc + col0 + bj * HALF + n * 16);
#pragma unroll
        for (int ai = 0; ai < 2; ++ai) {
#pragma unroll
            for (int m = 0; m < 4; ++m) { const int row = row0 + ai * HALF + m * 16; const size_t off = (size_t)row * ldc + col0;
                f32x4 rc[2][2]; const float irc = irn;
#pragma unroll
                for (int bj = 0; bj < 2; ++bj)
#pragma unroll
                    for (int n = 0; n < 2; ++n) rc[bj][n] = rn[bj][n];
                if (ai * 4 + m + 1 < 8) { const int nx = ai * 4 + m + 1; const size_t offn = (size_t)(row0 + (nx >> 2) * HALF + (nx & 3) * 16) * ldc + col0;
                    if constexpr (!RF32) irn = ((const GAS float*)IRS)[row0 + (nx >> 2) * HALF + (nx & 3) * 16];
#pragma unroll
                    for (int bj = 0; bj < 2; ++bj)
#pragma unroll
                        for (int n = 0; n < 2; ++n) rn[bj][n] = ldres(offn + bj * HALF + n * 16); }
                float ss = 0.f; bf16x8 ah[2], al[2];
#pragma unroll
                for (int bj = 0; bj < 2; ++bj) { f32x4 y[2];
#pragma unroll
                    for (int n = 0; n < 2; ++n) { f32x4 r = rc[bj][n]; if constexpr (!RF32) r = r * gmi[bj][n] * irc; const f32x4 v = r + acc[ai][bj][m][n];
                        ss += (v[0] * v[0] + v[1] * v[1]) + (v[2] * v[2] + v[3] * v[3]);
                        y[n] = v * gv[bj][n]; }
                    const unsigned h0 = mk::cvtpk(y[0][0], y[0][1]), h1 = mk::cvtpk(y[0][2], y[0][3]), h2 = mk::cvtpk(y[1][0], y[1][1]), h3 = mk::cvtpk(y[1][2], y[1][3]);
                    u32x4 ll; ll.x = mk::cvtpk(y[0][0] - mk::bflo(h0), y[0][1] - mk::bfhi(h0)); ll.y = mk::cvtpk(y[0][2] - mk::bflo(h1), y[0][3] - mk::bfhi(h1));
                    ll.z = mk::cvtpk(y[1][0] - mk::bflo(h2), y[1][1] - mk::bfhi(h2)); ll.w = mk::cvtpk(y[1][2] - mk::bflo(h3), y[1][3] - mk::bfhi(h3));
                    bf16_t* xr = XN + (size_t)row * ldc + col0 + bj * HALF; *(GAS u32x2*)xr = (u32x2){h0, h1}; *(GAS u32x2*)(xr + 16) = (u32x2){h2, h3};
                    ah[bj] = __builtin_bit_cast(bf16x8, (u32x4){h0, h1, h2, h3}); al[bj] = __builtin_bit_cast(bf16x8, ll); }
                ss += __shfl_xor(ss, 16); ss += __shfl_xor(ss, 32);
                f32x4 la[3];
#pragma unroll
                for (int nb = 0; nb < 3; ++nb) la[nb] = (f32x4){0.f, 0.f, 0.f, 0.f};
#pragma unroll
                for (int bj = 0; bj < 2; ++bj)
#pragma unroll
                    for (int nb = 0; nb < 3; ++nb) { const bf16x8 bh = *(const LAS bf16x8*)(lds + BFO + (((wc * 2 + 0) * 2 + bj) * 3 + nb) * 1024 + lane * 16), bl = *(const LAS bf16x8*)(lds + BFO + (((wc * 2 + 1) * 2 + bj) * 3 + nb) * 1024 + lane * 16);
                        la[nb] = __builtin_amdgcn_mfma_f32_16x16x32_bf16(ah[bj], bh, la[nb], 0, 0, 0); la[nb] = __builtin_amdgcn_mfma_f32_16x16x32_bf16(ah[bj], bl, la[nb], 0, 0, 0); la[nb] = __builtin_amdgcn_mfma_f32_16x16x32_bf16(al[bj], bh, la[nb], 0, 0, 0); }
#pragma unroll
                for (int nb = 0; nb < 3; ++nb)
#pragma unroll
                    for (int i = 0; i < 4; ++i) PL[(wc * 128 + wr * 64 + m * 16 + 4 * fq + i) * 48 + 16 * nb + fr] = la[nb][i];
                if (fq == 0) PS[wc * 128 + wr * 64 + m * 16 + fr] = ss; }
            __syncthreads();
            const int grow0 = u.pm * BM + ai * HALF;
            for (int idx = tid; idx < 128 * 48; idx += 512) { const int rl = idx / 48, j = idx - rl * 48;
                const float s_ = ((PL[(0 * 128 + rl) * 48 + j] + PL[(1 * 128 + rl) * 48 + j]) + PL[(2 * 128 + rl) * 48 + j]) + PL[(3 * 128 + rl) * 48 + j];
                ((GAS float*)PART)[((size_t)u.pn * nrows + grow0 + rl) * 48 + j] = s_; }
            if (tid < 128) ((GAS float*)PSS)[(size_t)u.pn * nrows + grow0 + tid] = ((PS[tid] + PS[128 + tid]) + PS[256 + tid]) + PS[384 + tid];
            __syncthreads();
        }
    }
};
struct EpiMoe1 {
    static constexpr bool PERM = true;
    bf16_t* H; const int* lists; const float* selw; int lcap;
    __device__ __forceinline__ void operator()(const f32x4 (&acc)[2][2][4][2], const Unit& u, int wr, int wc, int fr, int fq) const {
        const int col0 = u.pn * HALF + wc * 32 + 8 * fq;
#pragma unroll
        for (int ai = 0; ai < 2; ++ai)
#pragma unroll
            for (int m = 0; m < 4; ++m) { const int r = ai * HALF + wr * 64 + m * 16 + fr;
                if (r < u.rows) { const int slot = ((const GAS int*)lists)[u.e * lcap + u.pm * BM + r]; const float w = ((const GAS float*)selw)[slot];
                    float o[8];
#pragma unroll
                    for (int n = 0; n < 2; ++n)
#pragma unroll
                        for (int j = 0; j < 4; ++j) { const float g = acc[ai][0][m][n][j], up = acc[ai][1][m][n][j]; o[n * 4 + j] = g * mk::fast_sigmoid(g) * up * w; }
                    u32x4 q; q.x = mk::cvtpk(o[0], o[1]); q.y = mk::cvtpk(o[2], o[3]); q.z = mk::cvtpk(o[4], o[5]); q.w = mk::cvtpk(o[6], o[7]);
                    *(GAS u32x4*)(H + (size_t)slot * 512 + col0) = q; } }
    }
};
struct EpiMoe2 {
    static constexpr bool PERM = true;
    bf16_t* O; const int* lists; int lcap; int ldc;
    __device__ __forceinline__ void operator()(const f32x4 (&acc)[2][2][4][2], const Unit& u, int wr, int wc, int fr, int fq) const {
        const int col0 = u.pn * BM + wc * 32 + 8 * fq;
#pragma unroll
        for (int ai = 0; ai < 2; ++ai)
#pragma unroll
            for (int m = 0; m < 4; ++m) { const int r = ai * HALF + wr * 64 + m * 16 + fr;
                if (r < u.rows) { const int slot = ((const GAS int*)lists)[u.e * lcap + u.pm * BM + r]; bf16_t* rowp = O + (size_t)slot * ldc + col0;
#pragma unroll
                    for (int bj = 0; bj < 2; ++bj) { const f32x4 v0 = acc[ai][bj][m][0], v1 = acc[ai][bj][m][1];
                        u32x4 w; w.x = mk::cvtpk(v0[0], v0[1]); w.y = mk::cvtpk(v0[2], v0[3]); w.z = mk::cvtpk(v1[0], v1[1]); w.w = mk::cvtpk(v1[2], v1[3]);
                        *(GAS u32x4*)(rowp + bj * HALF) = w; } } }
    }
};

template <class Prob, class Epi, class Sched, bool ALIGN_EPI>
__device__ __forceinline__ void gemm_phase(LAS unsigned char* lds, const Prob& P, const Sched& S, const Epi& E) {
    int tid_ = threadIdx.x; asm volatile("" : "+v"(tid_));
    const int tid = tid_, wid = __builtin_amdgcn_readfirstlane(tid >> 6), lane = tid & 63, wr = wid >> 2, wc = wid & 3, fr = lane & 15, fq = lane >> 4;
    const int K = P.K, nt = K / BK;
    int Rr[2], Cc[2]; unsigned voffB[2];
#pragma unroll
    for (int i = 0; i < 2; ++i) { int R, C; stage_rc(tid * 16 + i * 8192, R, C); Rr[i] = R; Cc[i] = C; const int Rb = Epi::PERM ? ((R & ~31) + perm32(R & 31)) : R; voffB[i] = (unsigned)(Rb * K + C) * 2u; }
    const size_t kstep = (size_t)(BK * 2);
    const size_t hstep = (size_t)HALF * K * 2;
    constexpr int H1 = Prob::GATHER ? 1 : 0; const size_t hoff = Prob::GATHER ? 0 : hstep;
    const unsigned ldsw = (unsigned)wid * 1024u;
    const int aoff = lds_byte(wr * 64 + fr, fq * 8), boff = lds_byte(wc * 32 + fr, fq * 8);
#define PG8_SA(b, h) (((b) * 2 + (h)) * HTB)
#define PG8_SB(b, h) ((4 + (b) * 2 + (h)) * HTB)
#define PG8_STAGE(bufoff, gbase, voff) do { _Pragma("unroll") for (int _i = 0; _i < 2; ++_i) \
        __builtin_amdgcn_global_load_lds((const unsigned*)((const char*)(gbase) + (voff)[_i]), (LAS unsigned*)(lds + (bufoff) + ldsw + _i * 8192), 16, 0, 0); } while (0)
#define PG8_LDA(dst, b, h) do { _Pragma("unroll") for (int m = 0; m < 4; ++m) _Pragma("unroll") for (int k = 0; k < 2; ++k) dst[m][k] = *(const LAS bf16x8*)(lds + PG8_SA(b, h) + aoff + m * 2048 + k * 1024); } while (0)
#define PG8_LDB(dst, b, h) do { _Pragma("unroll") for (int n = 0; n < 2; ++n) _Pragma("unroll") for (int k = 0; k < 2; ++k) dst[n][k] = *(const LAS bf16x8*)(lds + PG8_SB(b, h) + boff + n * 2048 + k * 1024); } while (0)
#define PG8_MMA(ai, bj, At, Bt) do { __builtin_amdgcn_s_setprio(1); _Pragma("unroll") for (int m = 0; m < 4; ++m) _Pragma("unroll") for (int n = 0; n < 2; ++n) _Pragma("unroll") for (int k = 0; k < 2; ++k) \
        acc[ai][bj][m][n] = __builtin_amdgcn_mfma_f32_16x16x32_bf16(Bt[n][k], At[m][k], acc[ai][bj][m][n], 0, 0, 0); __builtin_amdgcn_s_setprio(0); } while (0)
#define PG8_WAIT_V(n) asm volatile("s_waitcnt vmcnt(" #n ")" ::: "memory")
#define PG8_WAIT_L(n) asm volatile("s_waitcnt lgkmcnt(" #n ")" ::: "memory")
#define PG8_BAR __builtin_amdgcn_s_barrier()
#define PG8_SCHED __builtin_amdgcn_sched_barrier(0)
    Unit cur, nxt; int ui = 0;
    if (!S.next(0, cur)) return;
    f32x4 acc[2][2][4][2];
#pragma unroll
    for (int a = 0; a < 2; ++a)
#pragma unroll
        for (int b = 0; b < 2; ++b)
#pragma unroll
            for (int m = 0; m < 4; ++m)
#pragma unroll
                for (int n = 0; n < 2; ++n) acc[a][b][m][n] = (f32x4){0.f, 0.f, 0.f, 0.f};
    bf16x8 At[4][2], B0[2][2], B1[2][2];
    unsigned aoC[2][2], aoN[2][2];
    P.a_offs(cur, Rr, Cc, aoC);
    if (Prob::GATHER) asm volatile("" : "+v"(aoC[0][0]), "+v"(aoC[0][1]), "+v"(aoC[1][0]), "+v"(aoC[1][1]));
#pragma unroll
    for (int h = 0; h < 2; ++h)
#pragma unroll
        for (int i = 0; i < 2; ++i) aoN[h][i] = aoC[h][i];
    const char* cA = P.a_base(cur); const char* cB = P.b_base(cur);
    PG8_STAGE(PG8_SB(0, 0), cB, voffB); PG8_STAGE(PG8_SB(0, 1), cB + hstep, voffB); PG8_STAGE(PG8_SA(0, 0), cA, aoC[0]); PG8_STAGE(PG8_SA(0, 1), cA + hoff, aoC[H1]);
    if (wr == 1) PG8_BAR;
    PG8_WAIT_V(2); PG8_BAR;
    PG8_STAGE(PG8_SB(1, 0), cB + kstep, voffB); PG8_STAGE(PG8_SA(1, 0), cA + kstep, aoC[0]); PG8_STAGE(PG8_SB(1, 1), cB + hstep + kstep, voffB);
    PG8_WAIT_V(6); PG8_BAR;
    for (;;) {
        const bool has_next = S.next(ui + 1, nxt);
        const char* nA = has_next ? P.a_base(nxt) : cA; const char* nB = has_next ? P.b_base(nxt) : cB;
        if (Prob::GATHER) {
            if (has_next) { P.a_offs(nxt, Rr, Cc, aoN); asm volatile("" : "+v"(aoN[0][0]), "+v"(aoN[0][1]), "+v"(aoN[1][0]), "+v"(aoN[1][1])); }
            else {
#pragma unroll
                for (int h = 0; h < 2; ++h)
#pragma unroll
                    for (int i = 0; i < 2; ++i) aoN[h][i] = aoC[h][i]; }
        }
        const bool halfu = Prob::GATHER && cur.rows <= HALF;
        for (int t = 0; t < nt; t += 2) {
            const bool last = (t == nt - 2);
            const char* a1 = cA + (size_t)(t + 1) * kstep;
            const char* a2 = last ? nA : cA + (size_t)(t + 2) * kstep; const char* b2 = last ? nB : cB + (size_t)(t + 2) * kstep;
            const char* a3 = a2 + kstep; const char* b3 = b2 + kstep;
            unsigned o2[2][2];
#pragma unroll
            for (int h = 0; h < 2; ++h)
#pragma unroll
                for (int i = 0; i < 2; ++i) o2[h][i] = (Prob::GATHER && last) ? aoN[h][i] : aoC[h][i];
            PG8_LDB(B0, 0, 0); PG8_LDB(B1, 0, 1); PG8_SCHED; PG8_LDA(At, 0, 0); PG8_STAGE(PG8_SA(1, 1), a1 + hoff, aoC[H1]);
            PG8_WAIT_V(8); PG8_WAIT_L(0); PG8_BAR; PG8_MMA(0, 0, At, B0); PG8_MMA(0, 1, At, B1); PG8_BAR; PG8_SCHED;
            PG8_LDA(At, 0, 1); PG8_STAGE(PG8_SB(0, 0), b2, voffB); PG8_STAGE(PG8_SB(0, 1), b2 + hstep, voffB); PG8_STAGE(PG8_SA(0, 0), a2, o2[0]);
            PG8_WAIT_V(8); PG8_WAIT_L(0); PG8_BAR; if (!halfu) { PG8_MMA(1, 0, At, B0); PG8_MMA(1, 1, At, B1); } PG8_BAR; PG8_SCHED;
            PG8_LDB(B0, 1, 0); PG8_LDB(B1, 1, 1); PG8_SCHED; PG8_LDA(At, 1, 0); PG8_STAGE(PG8_SA(0, 1), a2 + hoff, o2[H1]);
            PG8_WAIT_V(8); PG8_WAIT_L(0); PG8_BAR; PG8_MMA(0, 0, At, B0); PG8_MMA(0, 1, At, B1); PG8_BAR; PG8_SCHED;
            PG8_LDA(At, 1, 1); PG8_STAGE(PG8_SB(1, 0), b3, voffB); PG8_STAGE(PG8_SB(1, 1), b3 + hstep, voffB); PG8_STAGE(PG8_SA(1, 0), a3, o2[0]);
            PG8_WAIT_V(8); PG8_WAIT_L(0); PG8_BAR; if (!halfu) { PG8_MMA(1, 0, At, B0); PG8_MMA(1, 1, At, B1); } PG8_BAR; PG8_SCHED;
        }
        if constexpr (ALIGN_EPI) { if (wr == 0) PG8_BAR; }
        E(acc, cur, wr, wc, fr, fq);
        if (!has_next) break;
#pragma unroll
        for (int a = 0; a < 2; ++a)
#pragma unroll
            for (int b = 0; b < 2; ++b)
#pragma unroll
                for (int m = 0; m < 4; ++m)
#pragma unroll
                    for (int n = 0; n < 2; ++n) acc[a][b][m][n] = (f32x4){0.f, 0.f, 0.f, 0.f};
        cur = nxt; cA = nA; cB = nB; ++ui;
#pragma unroll
        for (int h = 0; h < 2; ++h)
#pragma unroll
            for (int i = 0; i < 2; ++i) aoC[h][i] = aoN[h][i];
        if constexpr (ALIGN_EPI) { if (wr == 1) PG8_BAR; }
    }
    PG8_WAIT_V(0);
    if constexpr (!ALIGN_EPI) { if (wr == 0) PG8_BAR; }
    PG8_BAR;
#undef PG8_SA
#undef PG8_SB
#undef PG8_STAGE
#undef PG8_LDA
#undef PG8_LDB
#undef PG8_MMA
#undef PG8_WAIT_V
#undef PG8_WAIT_L
#undef PG8_BAR
#undef PG8_SCHED
}
}
namespace mk {
#define XB_TMO      128
#define XB_XCNT(j)  (256  + 64 * (j))
#define XB_XSUB(j)  (1280 + 64 * (j))
#define XB_XGEN(j)  (2304 + 64 * (j))
#define XB_TOP      3328
#define XB_TOPGEN   3392
#define XCD_BAR_WORDS 3456
#define XB_SPIN_CAP (1u << 18)

__device__ __forceinline__ unsigned xb_ld(unsigned* p)              { return __hip_atomic_load(p, __ATOMIC_RELAXED, __HIP_MEMORY_SCOPE_AGENT); }
__device__ __forceinline__ unsigned xb_add(unsigned* p, unsigned v) { return __hip_atomic_fetch_add(p, v, __ATOMIC_RELAXED, __HIP_MEMORY_SCOPE_AGENT); }
__device__ __forceinline__ unsigned xb_xcc_id() { return (unsigned)__builtin_amdgcn_s_getreg((3 << 11) | 20) & 0xFu; }
#define XB_SPIN(cond, bar) do { unsigned _sp = 0; while (cond) { __builtin_amdgcn_s_sleep(1); \
    if ((++_sp & 255u) == 0u) { if (xb_ld(&(bar)[XB_TMO])) break; if (_sp > XB_SPIN_CAP) { atomicAdd(&(bar)[XB_TMO], 1u); break; } } } } while (0)

struct XcdBarrier {
    unsigned* bar; unsigned x;
    volatile LAS unsigned* st;
};

__device__ __forceinline__ XcdBarrier xcd_barrier_post(unsigned* bar, volatile LAS unsigned* st) {
    XcdBarrier b; b.bar = bar; b.x = xb_xcc_id(); b.st = st;
    if (threadIdx.x == 0) (void)xb_add(&bar[XB_XCNT(b.x)], 1u);
    return b;
}
__device__ __forceinline__ void xcd_barrier_complete(unsigned* bar, unsigned x, unsigned& nloc, unsigned& nx) {
    const unsigned G = gridDim.x * gridDim.y * gridDim.z;
    unsigned sum, cnt, mine, sp = 0u;
    for (;;) {
        sum = 0u; cnt = 0u; mine = 0u;
#pragma unroll
        for (unsigned j = 0; j < 16; ++j) { const unsigned c = xb_ld(&bar[XB_XCNT(j)]); sum += c; cnt += (c > 0u) ? 1u : 0u; mine = (j == x) ? c : mine; }
        if (sum == G) break;
        __builtin_amdgcn_s_sleep(1);
        if ((++sp & 255u) == 0u) { if (xb_ld(&bar[XB_TMO])) break; if (sp > XB_SPIN_CAP) { atomicAdd(&bar[XB_TMO], 1u); break; } }
    }
    nloc = mine > 0u ? mine : 1u; nx = cnt > 0u ? cnt : 1u;
}

__device__ __forceinline__ void xcd_barrier(const XcdBarrier& b) {
    asm volatile("s_waitcnt vmcnt(0)" ::: "memory");
    __syncthreads();
    if (threadIdx.x == 0) {
        unsigned* bar = b.bar;
        __builtin_amdgcn_s_waitcnt(0);
        unsigned nloc = b.st[0], nx = b.st[1];
        if (nloc == 0u) { xcd_barrier_complete(bar, b.x, nloc, nx); b.st[0] = nloc; b.st[1] = nx; }
        const unsigned old = xb_add(&bar[XB_XSUB(b.x)], 1u);
        const unsigned gen = old / nloc;
        if (old + 1u == (gen + 1u) * nloc) {
            __builtin_amdgcn_fence(__ATOMIC_RELEASE, "agent");
            asm volatile("s_waitcnt vmcnt(0)" ::: "memory");
            const unsigned og = xb_add(&bar[XB_TOP], 1u);
            const unsigned tg = og / nx;
            if (og + 1u == (tg + 1u) * nx) xb_add(&bar[XB_TOPGEN], 1u);
            else XB_SPIN(xb_ld(&bar[XB_TOPGEN]) == tg, bar);
            __builtin_amdgcn_fence(__ATOMIC_ACQUIRE, "agent");
            xb_add(&bar[XB_XGEN(b.x)], 1u);
            asm volatile("s_waitcnt vmcnt(0)" ::: "memory");
        } else {
            XB_SPIN(xb_ld(&bar[XB_XGEN(b.x)]) == gen, bar);
            __builtin_amdgcn_fence(__ATOMIC_ACQUIRE, "agent");
            asm volatile("s_waitcnt vmcnt(0)" ::: "memory");
        }
    }
    __syncthreads();
}
struct Args { const void* in[35]; float* out; unsigned char* ws; int ph_lo, ph_hi; };
struct Frame {
    LAS unsigned char* lds; volatile LAS unsigned* MISC; gu32* ctl; unsigned char* ws;
    int tid, lane, wave, G, bid;
    const __attribute__((address_space(4))) char* ka;
};
#define INP(i) (*(const __attribute__((address_space(4))) unsigned long long*)(F.ka + 8 * (i)))
#define INF(i) ((const float*)(const GAS float*)INP(i))
#define WSP(T_, off) ((T_*)(GAS T_*)(F.ws + (off)))

__device__ __forceinline__ void transpose_item(const float* W, int K, int N, bf16* WT, int drow0, LAS float* scr, int kb, int nb, int lane) {
    const int k0 = 64 * kb, n0 = 32 * nb;
#pragma unroll
    for (int i = 0; i < 32; ++i) { const int kk = 2 * i + (lane >> 5); scr[kk * 33 + (lane & 31)] = __builtin_nontemporal_load(W + (size_t)(k0 + kk) * N + n0 + (lane & 31)); }
    LDS_WAIT(); asm volatile("" ::: "memory");
    const int c = lane & 7;
#pragma unroll
    for (int j = 0; j < 4; ++j) { const int n = (lane >> 3) + 8 * j; const LAS float* s = scr + (8 * c) * 33 + n;
        u32x4 o; o.x = pk2(s[0 * 33], s[1 * 33]); o.y = pk2(s[2 * 33], s[3 * 33]); o.z = pk2(s[4 * 33], s[5 * 33]); o.w = pk2(s[6 * 33], s[7 * 33]);
        *(GAS u32x4*)(WT + (size_t)(drow0 + n) * K + k0 + 8 * c) = o; }
    LDS_WAIT(); asm volatile("" ::: "memory");
}
__device__ __forceinline__ void norm_rows(Frame& F, const float* x, int rows, const float* g1, bf16* o1, const float* g2, bf16* o2) {
    const int gw = F.bid * NWAVES + F.wave, NGW = F.G * NWAVES;
    for (int m = gw; m < rows; m += NGW) {
        const GAS f32x4* xr = (const GAS f32x4*)(x + (size_t)m * D) + F.lane;
        f32x4 v[8]; float ss = 0.f;
#pragma unroll
        for (int j = 0; j < 8; ++j) { v[j] = xr[64 * j]; ss += (v[j].x * v[j].x + v[j].y * v[j].y) + (v[j].z * v[j].z + v[j].w * v[j].w); }
        const float rstd = 1.0f / sqrtf(wave_sum(ss) * (1.0f / D) + EPS);
        GAS u32x2* o = (GAS u32x2*)(o1 + (size_t)m * D) + F.lane;
#pragma unroll
        for (int j = 0; j < 8; ++j) { const f32x4 g = ((const GAS f32x4*)g1)[F.lane + 64 * j]; u32x2 w; w.x = pk2(v[j].x * rstd * g.x, v[j].y * rstd * g.y); w.y = pk2(v[j].z * rstd * g.z, v[j].w * rstd * g.w); o[64 * j] = w; }
        if (g2) { GAS u32x2* oo = (GAS u32x2*)(o2 + (size_t)m * D) + F.lane;
#pragma unroll
            for (int j = 0; j < 8; ++j) { const f32x4 g = ((const GAS f32x4*)g2)[F.lane + 64 * j]; u32x2 w; w.x = pk2(v[j].x * rstd * g.x, v[j].y * rstd * g.y); w.y = pk2(v[j].z * rstd * g.z, v[j].w * rstd * g.w); oo[64 * j] = w; } }
    }
}
__device__ __forceinline__ void combine_norm_rows(Frame& F, bf16* xb, const float* gx, float* irs, float* outf, const bf16* O, const float* g1, bf16* o1, const float* g2, bf16* o2) {
    const int gw = F.bid * NWAVES + F.wave, NGW = F.G * NWAVES;
    for (int m0 = gw; m0 < T; m0 += 2 * NGW) {
        const int m1 = m0 + NGW < T ? m0 + NGW : m0;
        GAS u32x2* xr0 = (GAS u32x2*)(xb + (size_t)m0 * D) + F.lane; GAS u32x2* xr1 = (GAS u32x2*)(xb + (size_t)m1 * D) + F.lane;
        const GAS u32x2* oa0 = (const GAS u32x2*)(O + (size_t)(2 * m0) * D) + F.lane; const GAS u32x2* ob0 = (const GAS u32x2*)(O + (size_t)(2 * m0 + 1) * D) + F.lane;
        const GAS u32x2* oa1 = (const GAS u32x2*)(O + (size_t)(2 * m1) * D) + F.lane; const GAS u32x2* ob1 = (const GAS u32x2*)(O + (size_t)(2 * m1 + 1) * D) + F.lane;
        f32x4 v0[8], v1[8]; u32x2 x0[8], x1[8], a0[8], b0[8], a1[8], b1[8];
#pragma unroll
        for (int j = 0; j < 8; ++j) { x0[j] = xr0[64 * j]; a0[j] = oa0[64 * j]; b0[j] = ob0[64 * j]; x1[j] = xr1[64 * j]; a1[j] = oa1[64 * j]; b1[j] = ob1[64 * j]; }
        float ss0 = 0.f, ss1 = 0.f;
#pragma unroll
        for (int j = 0; j < 8; ++j) {
            const f32x4 gq = ((const GAS f32x4*)gx)[F.lane + 64 * j]; const float i0 = __builtin_amdgcn_rcpf(gq.x), i1 = __builtin_amdgcn_rcpf(gq.y), i2 = __builtin_amdgcn_rcpf(gq.z), i3 = __builtin_amdgcn_rcpf(gq.w);
            v0[j].x = (bflo(x0[j].x) * i0 + bflo(a0[j].x)) + bflo(b0[j].x); v0[j].y = (bfhi(x0[j].x) * i1 + bfhi(a0[j].x)) + bfhi(b0[j].x); v0[j].z = (bflo(x0[j].y) * i2 + bflo(a0[j].y)) + bflo(b0[j].y); v0[j].w = (bfhi(x0[j].y) * i3 + bfhi(a0[j].y)) + bfhi(b0[j].y);
            v1[j].x = (bflo(x1[j].x) * i0 + bflo(a1[j].x)) + bflo(b1[j].x); v1[j].y = (bfhi(x1[j].x) * i1 + bfhi(a1[j].x)) + bfhi(b1[j].x); v1[j].z = (bflo(x1[j].y) * i2 + bflo(a1[j].y)) + bflo(b1[j].y); v1[j].w = (bfhi(x1[j].y) * i3 + bfhi(a1[j].y)) + bfhi(b1[j].y);
            if (outf) { ((GAS f32x4*)(outf + (size_t)m0 * D) + F.lane)[64 * j] = v0[j]; if (m1 != m0) ((GAS f32x4*)(outf + (size_t)m1 * D) + F.lane)[64 * j] = v1[j]; }
            ss0 += (v0[j].x * v0[j].x + v0[j].y * v0[j].y) + (v0[j].z * v0[j].z + v0[j].w * v0[j].w); ss1 += (v1[j].x * v1[j].x + v1[j].y * v1[j].y) + (v1[j].z * v1[j].z + v1[j].w * v1[j].w); }
        if (g1) {
            const float ir0 = sqrtf(wave_sum(ss0) * (1.0f / D) + EPS), ir1 = sqrtf(wave_sum(ss1) * (1.0f / D) + EPS), rs0 = 1.0f / ir0, rs1 = 1.0f / ir1;
            if (F.lane == 0) { ((GAS float*)irs)[m0] = ir0; ((GAS float*)irs)[m1] = ir1; }
            GAS u32x2* p0 = (GAS u32x2*)(o1 + (size_t)m0 * D) + F.lane; GAS u32x2* p1 = (GAS u32x2*)(o1 + (size_t)m1 * D) + F.lane;
#pragma unroll
            for (int j = 0; j < 8; ++j) { const f32x4 g = ((const GAS f32x4*)g1)[F.lane + 64 * j]; u32x2 w;
                w.x = pk2(v0[j].x * rs0 * g.x, v0[j].y * rs0 * g.y); w.y = pk2(v0[j].z * rs0 * g.z, v0[j].w * rs0 * g.w); p0[64 * j] = w;
                w.x = pk2(v1[j].x * rs1 * g.x, v1[j].y * rs1 * g.y); w.y = pk2(v1[j].z * rs1 * g.z, v1[j].w * rs1 * g.w); p1[64 * j] = w; }
            if (g2) { GAS u32x2* q0 = (GAS u32x2*)(o2 + (size_t)m0 * D) + F.lane; GAS u32x2* q1 = (GAS u32x2*)(o2 + (size_t)m1 * D) + F.lane;
#pragma unroll
                for (int j = 0; j < 8; ++j) { const f32x4 g = ((const GAS f32x4*)g2)[F.lane + 64 * j]; u32x2 w;
                    w.x = pk2(v0[j].x * rs0 * g.x, v0[j].y * rs0 * g.y); w.y = pk2(v0[j].z * rs0 * g.z, v0[j].w * rs0 * g.w); q0[64 * j] = w;
                    w.x = pk2(v1[j].x * rs1 * g.x, v1[j].y * rs1 * g.y); w.y = pk2(v1[j].z * rs1 * g.z, v1[j].w * rs1 * g.w); q1[64 * j] = w; } }
        }
    }
}
template <int NV>
__device__ __forceinline__ void norm_bf16_rows(Frame& F, const bf16* src, int src_ld, const float* g, bf16* dst, int dst_ld, int rows) {
    const int gw = F.bid * NWAVES + F.wave, NGW = F.G * NWAVES;
    float gv[NV];
#pragma unroll
    for (int i = 0; i < NV; ++i) gv[i] = g[F.lane * NV + i];
    for (int m0 = gw; m0 < rows; m0 += 4 * NGW) {
        unsigned w[4][NV / 2]; float ss[4];
#pragma unroll
        for (int q = 0; q < 4; ++q) { const int m = m0 + q * NGW < rows ? m0 + q * NGW : m0; const GAS unsigned* sp = (const GAS unsigned*)(src + (size_t)m * src_ld + F.lane * NV);
#pragma unroll
            for (int i = 0; i < NV / 2; ++i) w[q][i] = sp[i]; }
#pragma unroll
        for (int q = 0; q < 4; ++q) { float s = 0.f;
#pragma unroll
            for (int i = 0; i < NV / 2; ++i) s += bflo(w[q][i]) * bflo(w[q][i]) + bfhi(w[q][i]) * bfhi(w[q][i]);
            ss[q] = s; }
#pragma unroll
        for (int o = 1; o < 64; o <<= 1) {
#pragma unroll
            for (int q = 0; q < 4; ++q) ss[q] += __shfl_xor(ss[q], o); }
#pragma unroll
        for (int q = 0; q < 4; ++q) { const int m = m0 + q * NGW < rows ? m0 + q * NGW : m0; const float rstd = 1.0f / sqrtf(ss[q] * (1.0f / (64 * NV)) + EPS);
            GAS unsigned* dp = (GAS unsigned*)(dst + (size_t)m * dst_ld + F.lane * NV);
#pragma unroll
            for (int i = 0; i < NV / 2; ++i) dp[i] = pk2(bflo(w[q][i]) * rstd * gv[2 * i], bfhi(w[q][i]) * rstd * gv[2 * i + 1]); }
    }
}
__device__ __forceinline__ void transpose_tile_wave(const bf16* src, long src_ld, bf16* dst, long dst_ld, LAS unsigned char* scr, int lane) {
#pragma unroll
    for (int i = 0; i < 4; ++i) { const int p = lane + 64 * i, row = p >> 2, ch = p & 3;
        const u32x4 v = *(const GAS u32x4*)(src + (size_t)row * src_ld + ch * 8);
        LAS unsigned* q = (LAS unsigned*)(scr + row * 68 + ch * 16); q[0] = v.x; q[1] = v.y; q[2] = v.z; q[3] = v.w; }
    LDS_WAIT(); asm volatile("" ::: "memory");
#pragma unroll
    for (int i = 0; i < 4; ++i) { const int q = lane + 64 * i, dd = q >> 3, m0 = (q & 7) * 8;
        unsigned h[8];
#pragma unroll
        for (int j = 0; j < 8; ++j) h[j] = *(const LAS unsigned short*)(scr + ((m0 & ~15) + (j & 3) + 8 * (j >> 2) + ((m0 & 8) >> 1)) * 68 + dd * 2);
        u32x4 o; o.x = h[0] | (h[1] << 16); o.y = h[2] | (h[3] << 16); o.z = h[4] | (h[5] << 16); o.w = h[6] | (h[7] << 16);
        *(GAS u32x4*)(dst + (size_t)dd * dst_ld + m0) = o; }
    LDS_WAIT(); asm volatile("" ::: "memory");
}

__device__ const double ROPE_INV_FREQ[32] = {1.0, 0.7498942093324559, 0.5623413251903491, 0.4216965034285822, 0.31622776601683794, 0.23713737056616552, 0.1778279410038923, 0.1333521432163324, 0.1, 0.07498942093324558, 0.05623413251903491, 0.042169650342858224, 0.03162277660168379, 0.023713737056616554, 0.01778279410038923, 0.01333521432163324, 0.01, 0.007498942093324558, 0.005623413251903491, 0.004216965034285823, 0.0031622776601683794, 0.0023713737056616554, 0.0017782794100389228, 0.001333521432163324, 0.001, 0.0007498942093324559, 0.0005623413251903491, 0.00042169650342858224, 0.00031622776601683794, 0.00023713737056616554, 0.00017782794100389227, 0.0001333521432163324};
__device__ __forceinline__ void p0_prologue(Frame& F, const Args& args) {
    LAS float* scr = (LAS float*)(F.lds + RING_OFF + F.wave * 16384);
    const int gw = F.bid * NWAVES + F.wave, NGW = F.G * NWAVES;
    constexpr int I_INA = 2 * 32 * 112, I_INB = 2 * 32 * 32, I_O = 4 * 32 * 64, I_MKV = 4 * 32 * 32, I_UQ = 2 * 8 * 72, I_DKV = 32 * 10, I_UK = 4 * 48;
    constexpr int NITEMS = I_INA + I_INB + I_O + I_MKV + I_UQ + I_DKV + 2 * I_UK;
    for (int it = gw; it < NITEMS; it += NGW) {
        int r = it;
        if (r < I_INA) { const int l = r / 3584, rr = r % 3584, kb = rr / 112, nb = rr % 112;
            transpose_item(INF(10) + (size_t)l * D * IN_A, D, IN_A, WSP(bf16, WS_WT_INA) + (size_t)l * IN_A * D, nb * 32, scr, kb, nb, F.lane); continue; } r -= I_INA;
        if (r < I_INB) { const int l = r >> 10, rr = r & 1023, kb = rr >> 5, nb = rr & 31;
            transpose_item(INF(24) + (size_t)l * D * IN_B, D, IN_B, WSP(bf16, WS_WT_INB) + (size_t)l * IN_B * D, nb * 32, scr, kb, nb, F.lane); continue; } r -= I_INB;
        if (r < I_O) { const int l = r >> 11, rr = r & 2047, kb = rr >> 6, nb = rr & 63;
            transpose_item(INF(5) + (size_t)l * D * D, D, D, WSP(bf16, WS_WT_O) + (size_t)l * D * D, nb * 32, scr, kb, nb, F.lane); continue; } r -= I_O;
        if (r < I_MKV) { const int l = r >> 10, rr = r & 1023, kb = rr >> 5, nb = rr & 31;
            transpose_item(INF(7) + (size_t)l * D * 1024, D, 1024, WSP(bf16, WS_WT_MKV) + (size_t)l * 1024 * D, nb * 32, scr, kb, nb, F.lane); continue; } r -= I_MKV;
        if (r < I_UQ) { const int l = r / 576, rr = r % 576, kb = rr / 72, nb = rr % 72;
            transpose_item(INF(26) + (size_t)l * Q_RANK * QW, Q_RANK, QW, WSP(bf16, WS_WT_UQ) + (size_t)l * QW * Q_RANK, nb * 32, scr, kb, nb, F.lane); continue; } r -= I_UQ;
        if (r < I_DKV) { const int kb = r / 10, nb = r % 10;
            transpose_item(INF(19), D, 320, WSP(bf16, WS_WT_DKV), nb * 32, scr, kb, nb, F.lane); continue; } r -= I_DKV;
        if (r < I_UK) { const int kb = r / 48, nb = r % 48;
            transpose_item(INF(21), KV_RANK, 1536, WSP(bf16, WS_WT_UKV), nb * 32, scr, kb, nb, F.lane); continue; } r -= I_UK;
        { const int kb = r / 48, nb = r % 48;
            transpose_item(INF(22), KV_RANK, 1536, WSP(bf16, WS_WT_UKV), 1536 + nb * 32, scr, kb, nb, F.lane); }
    }
    const int gt = F.bid * NTHR + F.tid, NGT = F.G * NTHR;
    for (int i = gt; i < 192 * D / 8; i += NGT) ((u32x4*)(WSP(bf16, WS_WT_DKV) + (size_t)320 * D))[i] = (u32x4){0u, 0u, 0u, 0u};
    for (int i = gt; i < 4 * 48 * D; i += NGT) { const int l = i / (48 * D), j = (i / D) % 48, k = i % D;
        const float wv = j < 8 ? INF(28)[((size_t)l * D + k) * 8 + j] : (j < 40 ? INF(30)[((size_t)l * D + k) * 32 + (j - 8)] : 0.f);
        const unsigned h = f2bf(wv); const unsigned lo = f2bf(wv - bflo(h));
        WSP(bf16, WS_WT_RT)[(size_t)(l * 2) * 48 * D + (size_t)j * D + k] = (bf16)h; WSP(bf16, WS_WT_RT)[(size_t)(l * 2 + 1) * 48 * D + (size_t)j * D + k] = (bf16)lo; }
    { const int* pos = (const int*)(const GAS int*)INP(2);
      for (int i = gt; i < T * 32; i += NGT) { const int t = i >> 5, j = i & 31; const double ang = (double)pos[t] * ROPE_INV_FREQ[j];
          WSP(float, WS_TAB)[t * 64 + j] = (float)cos(ang); WSP(float, WS_TAB)[t * 64 + 32 + j] = (float)sin(ang); } }
    for (int l = 0; l < 4; ++l) norm_rows(F, INF(1), Bn * MEM_LEN, INF(6) + l * D, WSP(bf16, WS_MEMN) + (size_t)l * 1024 * D, nullptr, nullptr);
    norm_rows(F, INF(0), T, INF(3), WSP(bf16, WS_XN), nullptr, nullptr);
}

constexpr int CV_PER_LAYER = 3 * 16384;
__device__ __forceinline__ void conv_item(Frame& F, const Args& args, int l, int r, LAS float* scr) {
    const int kind = r >> 14, rr = r & 16383, e = l * 32 + (rr >> 9), it = rr & 511;
    if (kind == 0) { const int kb = it >> 4, nb = it & 15, n0 = nb * 32; transpose_item(INF(32) + (size_t)e * D * D_EXP, D, D_EXP, WSP(bf16, WS_WT_EGU) + (size_t)e * 1024 * D, (n0 >> 7) * 256 + (n0 & 127), scr, kb, nb, F.lane); }
    else if (kind == 1) { const int kb = it >> 4, nb = it & 15, n0 = nb * 32; transpose_item(INF(33) + (size_t)e * D * D_EXP, D, D_EXP, WSP(bf16, WS_WT_EGU) + (size_t)e * 1024 * D, (n0 >> 7) * 256 + 128 + (n0 & 127), scr, kb, nb, F.lane); }
    else { const int kb = it >> 6, nb = it & 63; transpose_item(INF(34) + (size_t)e * D_EXP * D, D_EXP, D, WSP(bf16, WS_WT_ED) + (size_t)e * D * D_EXP, nb * 32, scr, kb, nb, F.lane); }
}
__device__ __forceinline__ void conv_experts(Frame& F, const Args& args, int l) {
    LAS float* scr = (LAS float*)(F.lds + RING_OFF + F.wave * 16384);
    const int gw = F.bid * NWAVES + F.wave, NGW = F.G * NWAVES;
    __syncthreads();
    for (int r = gw; r < CV_PER_LAYER; r += NGW) conv_item(F, args, l, r, scr);
    __syncthreads();
}
__device__ __forceinline__ void conv_quota(Frame& F, const Args& args, int claims) {
    LAS float* scr = (LAS float*)(F.lds + RING_OFF + F.wave * 16384);
    for (int c = 0; c < claims; ++c) {
        __syncthreads();
        if (F.tid == 0) { unsigned v = 0u; unsigned lb = F.MISC[2];
            for (; lb < 3u; ++lb) { const unsigned b = __hip_atomic_fetch_add((unsigned*)(F.ctl + CW_CONVQ + 64 * lb), 8u, RLX_AGENT); if (b < (unsigned)CV_PER_LAYER) { v = 1u + lb * (unsigned)CV_PER_LAYER + b; break; } }
            F.MISC[2] = lb; F.MISC[1] = v; }
        __syncthreads();
        const unsigned v = F.MISC[1];
        if (v == 0u) break;
        const int q = (int)(v - 1u), lb = q / CV_PER_LAYER, r = q % CV_PER_LAYER + F.wave;
        if (r < CV_PER_LAYER) conv_item(F, args, lb + 1, r, scr);
    }
    __syncthreads();
}
__device__ __forceinline__ void conv_drain(Frame& F, const Args& args, int l) {
    gu32* head = F.ctl + CW_CONVQ + 64 * (l - 1);
    LAS float* scr = (LAS float*)(F.lds + RING_OFF + F.wave * 16384);
    for (;;) {
        __syncthreads();
        if (F.tid == 0) { const unsigned b = __hip_atomic_fetch_add((unsigned*)head, 64u, RLX_AGENT); F.MISC[1] = b < (unsigned)CV_PER_LAYER ? b + 1u : 0u; }
        __syncthreads();
        const unsigned v = F.MISC[1];
        if (v == 0u) break;
        const int r0 = (int)(v - 1u) + 8 * F.wave;
        for (int i = 0; i < 8; ++i) if (r0 + i < CV_PER_LAYER) conv_item(F, args, l, r0 + i, scr);
    }
    __syncthreads();
}
__device__ __forceinline__ void mem_assemble(Frame& F, const Args& args, int gw, int NGW) {
    const int lane = F.lane;
    const bf16* mkv = WSP(bf16, WS_MKVR);
    for (int r = gw; r < 4096; r += NGW) { const int l = r >> 10; const float* g = INF(9) + l * 128;
        const float g0 = g[2 * lane], g1 = g[2 * lane + 1];
#pragma unroll
        for (int h = 0; h < 4; ++h) { const unsigned w = *(const GAS unsigned*)(mkv + (size_t)r * 1024 + h * 128 + 2 * lane); const float a = bflo(w), b = bfhi(w);
            const float rstd = 1.0f / sqrtf(wave_sum(a * a + b * b) * (1.0f / 128.0f) + EPS);
            bf16* o = WSP(bf16, WS_MEMK) + ((size_t)r * 4 + h) * 192;
            *(GAS unsigned*)(o + 2 * lane) = pk2(a * rstd * g0, b * rstd * g1);
            if (lane < 32) *(GAS unsigned*)(o + 128 + 2 * lane) = 0u; } }
    LAS unsigned char* scr = F.lds + RING_OFF + F.wave * 4352;
    for (int it = gw; it < 64 * 16; it += NGW) { const int rt = it >> 4, ct = it & 15;
        const int l = rt >> 4, b = (rt >> 2) & 3, m0 = (rt & 3) * 64, h = ct >> 2, d0 = (ct & 3) * 32;
        transpose_tile_wave(mkv + (size_t)(rt * 64) * 1024 + 512 + ct * 32, 1024, WSP(bf16, WS_MEMVT) + ((size_t)((l * 4 + b) * 4 + h) * 128 + d0) * 256 + m0, 256, scr, lane); }
}
__device__ __forceinline__ void kv_assemble(Frame& F, const Args& args) {
    const int gw = F.bid * NWAVES + F.wave, NGW = F.G * NWAVES, lane = F.lane;
    const bf16* kvup = WSP(bf16, WS_KVUP); const bf16* ckv = WSP(bf16, WS_CKV); const float* g = INF(23); const float* tab = WSP(float, WS_TAB);
    const float g0 = g[2 * lane], g1 = g[2 * lane + 1], g2 = g[128 + lane];
    for (int t = gw; t < T; t += NGW) {
        const float pe = bf1(ckv[(size_t)t * 512 + 256 + lane]); const float sspe = wave_sum(pe * pe);
        const int j = lane & 31; const float c = tab[t * 64 + j], sn = tab[t * 64 + 32 + j];
        unsigned wv[MLA_H]; float sq[MLA_H];
#pragma unroll
        for (int h = 0; h < MLA_H; ++h) { wv[h] = *(const GAS unsigned*)(kvup + (size_t)t * 3072 + h * 128 + 2 * lane); sq[h] = bflo(wv[h]) * bflo(wv[h]) + bfhi(wv[h]) * bfhi(wv[h]); }
#pragma unroll
        for (int o = 1; o < 64; o <<= 1) {
#pragma unroll
            for (int h = 0; h < MLA_H; ++h) sq[h] += __shfl_xor(sq[h], o); }
#pragma unroll
        for (int h = 0; h < MLA_H; ++h) { const float a = bflo(wv[h]), b = bfhi(wv[h]);
            const float rstd = 1.0f / sqrtf((sq[h] + sspe) * (1.0f / 192.0f) + EPS);
            bf16* o = WSP(bf16, WS_K) + ((size_t)t * MLA_H + h) * 192;
            *(GAS unsigned*)(o + 2 * lane) = pk2(a * rstd * g0, b * rstd * g1);
            const float n2 = pe * rstd * g2, other = __shfl_xor(n2, 32);
            const float rr = lane < 32 ? (n2 * c - other * sn) : (n2 * c + other * sn);
            ((GAS bf16*)o)[128 + lane] = (bf16)f2bf(rr); } }
    LAS unsigned char* scr = F.lds + RING_OFF + F.wave * 4352;
    for (int it = gw; it < 128 * 48; it += NGW) { const int rt = it / 48, ct = it % 48;
        const int b = rt >> 5, s0 = (rt & 31) * 64, h = ct >> 2, d0 = (ct & 3) * 32;
        transpose_tile_wave(kvup + (size_t)(rt * 64) * 3072 + 1536 + ct * 32, 3072, WSP(bf16, WS_VT) + ((size_t)(b * MLA_H + h) * 128 + d0) * S + s0, S, scr, lane); }
}

__device__ __forceinline__ void router_phase(Frame& F, const Args& args, int l, const float* x1) {
    LAS float* tmp = (LAS float*)(F.lds + RING_OFF);
    LAS float* lgt = (LAS float*)(F.lds + RING_OFF + 49152);
    LAS int* sel = (LAS int*)(F.lds + RING_OFF + 49152 + 5120 + 128);
    const int tid = F.tid;
    for (int pass = F.bid; pass < T / 32; pass += F.G) {
        const int tokb = pass * 32;
        for (int idx = tid; idx < 32 * 49; idx += NTHR) { const int tk = idx / 49, j = idx - tk * 49; float s_ = 0.f;
            if (j < 48) {
#pragma unroll
                for (int pn = 0; pn < 8; ++pn) s_ += ((const GAS float*)WSP(float, WS_RPART))[((size_t)pn * T + tokb + tk) * 48 + j]; }
            else {
#pragma unroll
                for (int pn = 0; pn < 8; ++pn) s_ += ((const GAS float*)WSP(float, WS_RPSS))[(size_t)pn * T + tokb + tk]; }
            tmp[tk * 49 + j] = s_; }
        __syncthreads();
        for (int idx = tid; idx < 32 * 40; idx += NTHR) { const int tk = idx / 40, j = idx - tk * 40;
            const float rstd = 1.0f / sqrtf(tmp[tk * 49 + 48] * (1.0f / D) + EPS);
            lgt[tk * 40 + j] = tmp[tk * 49 + j] * rstd;
            if (j == 0) ((GAS float*)WSP(float, WS_RSTD))[tokb + tk] = rstd; }
        __syncthreads();
        if (tid < 32) {
            const LAS float* lp = lgt + tid * 40; const float* bg = INF(29) + l * 8; const float* be = INF(31) + l * 32;
            int gi = 0; float gm = lp[0] + bg[0]; float lg[8]; lg[0] = gm;
#pragma unroll
            for (int j = 1; j < 8; ++j) { lg[j] = lp[j] + bg[j]; if (lg[j] > gm) { gm = lg[j]; gi = j; } }
            float den = 0.f;
#pragma unroll
            for (int j = 0; j < 8; ++j) den += expf(lg[j] - gm);
            const float ptop = 1.0f / den;
            const float a0 = lp[8 + gi * 4 + 0] + be[gi * 4 + 0], a1 = lp[8 + gi * 4 + 1] + be[gi * 4 + 1], a2 = lp[8 + gi * 4 + 2] + be[gi * 4 + 2], a3 = lp[8 + gi * 4 + 3] + be[gi * 4 + 3];
            int e0 = 0; float m0 = a0; if (a1 > m0) { m0 = a1; e0 = 1; } if (a2 > m0) { m0 = a2; e0 = 2; } if (a3 > m0) { m0 = a3; e0 = 3; }
            int e1 = -1; float m1 = -INFINITY;
            if (e0 != 0 && a0 > m1) { m1 = a0; e1 = 0; } if (e0 != 1 && a1 > m1) { m1 = a1; e1 = 1; } if (e0 != 2 && a2 > m1) { m1 = a2; e1 = 2; } if (e0 != 3 && a3 > m1) { m1 = a3; e1 = 3; }
            const float w0 = 1.0f / (1.0f + expf(m1 - m0)), w1 = 1.0f - w0;
            const int tok = tokb + tid;
            WSP(float, WS_SELW)[2 * tok] = ptop * w0; WSP(float, WS_SELW)[2 * tok + 1] = ptop * w1;
            sel[2 * tid] = gi * 4 + e0; sel[2 * tid + 1] = gi * 4 + e1;
        }
        __syncthreads();
        if (tid < 32) {
            int cnt = 0;
            for (int s = 0; s < 64; ++s) cnt += (sel[s] == tid) ? 1 : 0;
            if (cnt > 0) { unsigned base = __hip_atomic_fetch_add((unsigned*)(F.ctl + CW_MOECNT + (l * 32 + tid) * 64), (unsigned)cnt, RLX_AGENT);
                for (int s = 0; s < 64; ++s) if (sel[s] == tid) { WSP(int, WS_LISTS)[tid * LCAP + base] = 2 * tokb + s; ++base; } }
        }
        __syncthreads();
    }
}
__device__ __forceinline__ void moe_table(Frame& F, int l, int ntl) {
    LAS int* tab = (LAS int*)(F.lds + MOE_TAB_OFF);
    __syncthreads();
    if (F.tid < 32) tab[33 + F.tid] = (int)__hip_atomic_load((unsigned*)(F.ctl + CW_MOECNT + (l * 32 + F.tid) * 64), RLX_AGENT);
    __syncthreads();
    if (F.tid == 0) { int s = 0;
        for (int e = 0; e < 32; ++e) { tab[e] = s; s += ((tab[33 + e] + 127) >> 8) * ntl; } tab[32] = s;
        for (int e = 0; e < 32; ++e) { const int cnt = tab[33 + e]; tab[65 + e] = s; s += (((cnt + 255) >> 8) - ((cnt + 127) >> 8)) * ntl; } tab[97] = s; }
    __syncthreads();
}

__device__ __forceinline__ void scan_unit(Frame& F, const Args& args, int l, int u) {
    constexpr int YT = 0, SUMM = 65536, UT = SUMM + 2048, UTW = 9216, GT = UT + 8 * UTW, CWO = GT + 16384;
    static_assert(CWO + 2560 <= RING_BYTES, "scan lds");
    const int b = u / 48, n = (u % 48) >> 2, cq = u & 3;
    LAS unsigned char* lds = F.lds + RING_OFF; LAS unsigned char* yt = lds + YT; LAS float* summ = (LAS float*)(lds + SUMM); LAS float* cwl = (LAS float*)(lds + CWO);
    int tid_ = F.tid; asm volatile("" : "+v"(tid_));
    const int tid = tid_, lane = tid & 63, w = F.wave, r32 = lane & 31, hi = lane >> 5;
    const int col = n * 128 + cq * 32 + r32;
    const bf16* proj = WSP(bf16, WS_PROJ); bf16* ycat = WSP(bf16, WS_YCAT);
    const bf16* zsrc = WSP(bf16, WS_WT_DKV) + (size_t)320 * D;
    int urow[9];
#pragma unroll
    for (int q = 0; q < 9; ++q) urow[q] = (1024 * q + 16 * lane) >> 8;
    const unsigned uch = (unsigned)(n * 128 + (lane & 15) * 8);
    const unsigned gch = (unsigned)(LRU_W + n * 128 + cq * 32 + (lane & 3) * 8);
#define SCAN_UDMA(c) do { _Pragma("unroll") for (int q_ = 0; q_ < 9; ++q_) { const int sr_ = 256 * (c) - 3 + 32 * w + urow[q_]; \
        const bf16* s_ = (sr_ >= 0 && urow[q_] < 35) ? proj + (size_t)(b * S + sr_) * IN_A + uch : zsrc; \
        __builtin_amdgcn_global_load_lds((const unsigned*)s_, (LAS unsigned*)(lds + UT + w * UTW + q_ * 1024), 16, 0, 0); } } while (0)
#define SCAN_GDMA(c) do { _Pragma("unroll") for (int i_ = 0; i_ < 2; ++i_) \
        __builtin_amdgcn_global_load_lds((const unsigned*)(proj + (size_t)(b * S + 256 * (c) + 32 * w + 16 * i_ + (lane >> 2)) * IN_A + gch), (LAS unsigned*)(lds + GT + (2 * w + i_) * 1024), 16, 0, 0); } while (0)
    SCAN_UDMA(0); SCAN_GDMA(0);
    for (int i = tid; i < 640; i += NTHR) cwl[i] = i < 512 ? INF(11)[(l * 4 + (i >> 7)) * LRU_W + n * 128 + (i & 127)] : INF(12)[l * LRU_W + n * 128 + (i - 512)];
    bf16x8 wrf[8], wif[8];
    { const float* wrp = INF(13) + ((size_t)(l * 12 + n) * 128) * 128 + cq * 32 + r32; const float* wip = INF(15) + ((size_t)(l * 12 + n) * 128) * 128 + cq * 32 + r32;
#pragma unroll
      for (int s = 0; s < 8; ++s) { u32x4 a, c; const int k0 = 16 * s + 8 * hi;
          a.x = pk2(wrp[(k0 + 0) * 128], wrp[(k0 + 1) * 128]); a.y = pk2(wrp[(k0 + 2) * 128], wrp[(k0 + 3) * 128]); a.z = pk2(wrp[(k0 + 4) * 128], wrp[(k0 + 5) * 128]); a.w = pk2(wrp[(k0 + 6) * 128], wrp[(k0 + 7) * 128]);
          c.x = pk2(wip[(k0 + 0) * 128], wip[(k0 + 1) * 128]); c.y = pk2(wip[(k0 + 2) * 128], wip[(k0 + 3) * 128]); c.z = pk2(wip[(k0 + 4) * 128], wip[(k0 + 5) * 128]); c.w = pk2(wip[(k0 + 6) * 128], wip[(k0 + 7) * 128]);
          wrf[s] = __builtin_bit_cast(bf16x8, a); wif[s] = __builtin_bit_cast(bf16x8, c); } }
    const float br = INF(14)[l * LRU_W + col], bi = INF(16)[l * LRU_W + col];
    float sp8; { const float nl = -INF(17)[l * LRU_W + col]; sp8 = 8.0f * (nl > 20.f ? nl : log1pf(expf(nl))); }
    const int cg = tid & 15, rl = (tid >> 4) & 3;
    float hin = 0.f;
    VM_WAIT(); __syncthreads();
    for (int c = 0; c < 8; ++c) {
        const int t0 = b * S + c * 256;
        if (c > 0) asm volatile("s_waitcnt vmcnt(16)" ::: "memory");
        {
            const LAS unsigned char* ut = lds + UT + w * UTW + cg * 16;
            u32x4 uw[11];
#pragma unroll
            for (int r = 0; r < 11; ++r) uw[r] = *(const LAS u32x4*)(ut + (rl * 8 + r) * 256);
            float cw[4][8], cb[8];
#pragma unroll
            for (int k = 0; k < 4; ++k) { const f32x4 a = *(const LAS f32x4*)(cwl + k * 128 + cg * 8), bq = *(const LAS f32x4*)(cwl + k * 128 + cg * 8 + 4);
                cw[k][0] = a.x; cw[k][1] = a.y; cw[k][2] = a.z; cw[k][3] = a.w; cw[k][4] = bq.x; cw[k][5] = bq.y; cw[k][6] = bq.z; cw[k][7] = bq.w; }
            { const f32x4 a = *(const LAS f32x4*)(cwl + 512 + cg * 8), bq = *(const LAS f32x4*)(cwl + 512 + cg * 8 + 4); cb[0] = a.x; cb[1] = a.y; cb[2] = a.z; cb[3] = a.w; cb[4] = bq.x; cb[5] = bq.y; cb[6] = bq.z; cb[7] = bq.w; }
#pragma unroll
            for (int r = 0; r < 8; ++r) { float y[8];
#pragma unroll
                for (int i = 0; i < 8; ++i) y[i] = cb[i];
#pragma unroll
                for (int k = 0; k < 4; ++k) { const u32x4 q = uw[r + 3 - k];
                    y[0] += cw[k][0] * bflo(q.x); y[1] += cw[k][1] * bfhi(q.x); y[2] += cw[k][2] * bflo(q.y); y[3] += cw[k][3] * bfhi(q.y);
                    y[4] += cw[k][4] * bflo(q.z); y[5] += cw[k][5] * bfhi(q.z); y[6] += cw[k][6] * bflo(q.w); y[7] += cw[k][7] * bfhi(q.w); }
                u32x4 o; o.x = pk2(y[0], y[1]); o.y = pk2(y[2], y[3]); o.z = pk2(y[4], y[5]); o.w = pk2(y[6], y[7]);
                const int row = 32 * w + rl * 8 + r;
                *(LAS u32x4*)(yt + row * 256 + ((cg ^ (row & 15)) << 4)) = o; }
        }
        asm volatile("s_waitcnt lgkmcnt(0)" ::: "memory");
        if (c + 1 < 8) SCAN_UDMA(c + 1); else SCAN_UDMA(c);
        __syncthreads();
        f32x16 ar, ai;
#pragma unroll
        for (int i = 0; i < 16; ++i) { ar[i] = 0.f; ai[i] = 0.f; }
        { const int row = 32 * w + r32;
#pragma unroll
          for (int s = 0; s < 8; ++s) { const bf16x8 a = *(const LAS bf16x8*)(yt + row * 256 + (((2 * s + hi) ^ (row & 15)) << 4));
            ar = __builtin_amdgcn_mfma_f32_32x32x16_bf16(a, wrf[s], ar, 0, 0, 0); ai = __builtin_amdgcn_mfma_f32_32x32x16_bf16(a, wif[s], ai, 0, 0, 0); } }
        float P[16], hl[16], sA[4], sB[4];
        const int ycol = cq * 32 + r32;
#pragma unroll
        for (int j = 0; j < 4; ++j) {
#pragma unroll
            for (int ii = 0; ii < 4; ++ii) { const int i = 4 * j + ii, row = 32 * w + 8 * j + 4 * hi + ii;
                const float yv = bf1(*(const LAS bf16*)(yt + row * 256 + (((ycol >> 3) ^ (row & 15)) << 4) + (ycol & 7) * 2));
                const float rr = fast_sigmoid(ar[i] + br), ig = fast_sigmoid(ai[i] + bi);
                const float la = -rr * sp8; const float av = __expf(la); const float x2 = 2.0f * la;
                const float ser = -x2 * (1.0f + x2 * 0.5f * (1.0f + x2 * (1.0f / 3.0f) * (1.0f + x2 * 0.25f * (1.0f + x2 * 0.2f)))); const float om = x2 > -0.25f ? ser : 1.0f - av * av;
                const float bv = sqrtf(om) * (ig * yv);
                if (ii == 0) { P[i] = av; hl[i] = bv; } else { P[i] = P[i - 1] * av; hl[i] = av * hl[i - 1] + bv; } }
            sA[j] = P[4 * j + 3]; sB[j] = hl[4 * j + 3]; }
        float RA = 1.f, RB = 0.f, cA_[4], cB_[4];
#pragma unroll
        for (int j = 0; j < 4; ++j) { const float oA = __shfl_xor(sA[j], 32), oB = __shfl_xor(sB[j], 32);
            const float fA = hi ? oA : sA[j], fB = hi ? oB : sB[j], gA = hi ? sA[j] : oA, gB = hi ? sB[j] : oB;
            const float RA1 = RA * fA, RB1 = fA * RB + fB;
            cA_[j] = hi ? RA1 : RA; cB_[j] = hi ? RB1 : RB;
            RA = RA1 * gA; RB = gA * RB1 + gB; }
        if (hi == 0) { summ[(w * 32 + r32) * 2] = RA; summ[(w * 32 + r32) * 2 + 1] = RB; }
        __syncthreads();
        float H = hin, Hall = hin;
#pragma unroll
        for (int w2 = 0; w2 < 8; ++w2) { const float A = summ[(w2 * 32 + r32) * 2], Bv = summ[(w2 * 32 + r32) * 2 + 1]; if (w2 < w) H = A * H + Bv; Hall = A * Hall + Bv; }
        hin = Hall;
        asm volatile("s_waitcnt vmcnt(8)" ::: "memory");
#pragma unroll
        for (int j = 0; j < 4; ++j) { const float hs = cA_[j] * H + cB_[j];
#pragma unroll
            for (int ii = 0; ii < 4; ++ii) { const int i = 4 * j + ii, lr = 8 * j + 4 * hi + ii; const size_t t = (size_t)(t0 + 32 * w + lr);
                const float hv = hl[i] + P[i] * hs; const float g = gelu_tanh_f(bf1(*(const LAS bf16*)(lds + GT + (32 * w + lr) * 64 + r32 * 2)));
                ((GAS bf16*)ycat)[t * D + col] = (bf16)f2bf(g * hv); } }
        asm volatile("s_waitcnt lgkmcnt(0)" ::: "memory");
        if (c + 1 < 8) SCAN_GDMA(c + 1); else SCAN_GDMA(c);
    }
#undef SCAN_UDMA
#undef SCAN_GDMA
    VM_WAIT(); __syncthreads();
}

struct AttnDesc {
    const bf16* Q; long q_rs; int qdims; const float* qg; const float* tab;
    const bf16* K; long k_rs;
    const bf16* Vt; long vt_rs;
    bf16* O; long o_rs;
    int q0, ntiles, diag0; float scale_log2;
};
__device__ __forceinline__ int crow(int r, int hi) { return (r & 3) + 8 * (r >> 2) + 4 * hi; }
__device__ __forceinline__ void attn_unit(Frame& F, const AttnDesc& d) {
    constexpr int KB = 64 * 384, VB = 128 * 128, KOFF = 0, VOFF = 2 * KB;
    LAS unsigned char* lds = F.lds + RING_OFF;
    int lane_ = F.lane; asm volatile("" : "+v"(lane_));
    const int lane = lane_, w = F.wave, r32 = lane & 31, hi = lane >> 5, qloc = 32 * w + r32;
    const size_t trow = (size_t)(d.q0 + qloc);
    bf16x8 qb[12];
    {
        const bf16* qrow = d.Q + trow * d.q_rs;
        float ss = 0.f;
#pragma unroll
        for (int s = 0; s < 12; ++s) if (16 * s < d.qdims) { const u32x4 rw = *(const GAS u32x4*)(qrow + 16 * s + 8 * hi);
                ss += (bflo(rw.x) * bflo(rw.x) + bfhi(rw.x) * bfhi(rw.x)) + (bflo(rw.y) * bflo(rw.y) + bfhi(rw.y) * bfhi(rw.y)) + (bflo(rw.z) * bflo(rw.z) + bfhi(rw.z) * bfhi(rw.z)) + (bflo(rw.w) * bflo(rw.w) + bfhi(rw.w) * bfhi(rw.w)); }
        ss += __shfl_xor(ss, 32);
        const float rs = d.scale_log2 / sqrtf(ss / (float)d.qdims + EPS);
#define ATT_QF(s, qf) do { const u32x4 rw_ = *(const GAS u32x4*)(qrow + 16 * (s) + 8 * hi); const f32x4 ga = *(const GAS f32x4*)(d.qg + 16 * (s) + 8 * hi), gb = *(const GAS f32x4*)(d.qg + 16 * (s) + 8 * hi + 4); \
            qf[0] = bflo(rw_.x) * rs * ga.x; qf[1] = bfhi(rw_.x) * rs * ga.y; qf[2] = bflo(rw_.y) * rs * ga.z; qf[3] = bfhi(rw_.y) * rs * ga.w; \
            qf[4] = bflo(rw_.z) * rs * gb.x; qf[5] = bfhi(rw_.z) * rs * gb.y; qf[6] = bflo(rw_.w) * rs * gb.z; qf[7] = bfhi(rw_.w) * rs * gb.w; } while (0)
#define ATT_QPK(s, qf) do { u32x4 p_; p_.x = cvtpk(qf[0], qf[1]); p_.y = cvtpk(qf[2], qf[3]); p_.z = cvtpk(qf[4], qf[5]); p_.w = cvtpk(qf[6], qf[7]); qb[s] = __builtin_bit_cast(bf16x8, p_); } while (0)
#pragma unroll
        for (int s = 0; s < 8; ++s) {
            if (16 * s < d.qdims) { float qf[8]; ATT_QF(s, qf); ATT_QPK(s, qf); } else qb[s] = __builtin_bit_cast(bf16x8, (u32x4){0u, 0u, 0u, 0u});
            __builtin_amdgcn_sched_barrier(0); }
#pragma unroll
        for (int s = 8; s < 10; ++s) {
            if (16 * s < d.qdims) { float q1[8], q2[8]; ATT_QF(s, q1); ATT_QF(s + 2, q2);
                if (d.tab) { const float* tb = d.tab + trow * 64 + 16 * (s - 8) + 8 * hi;
#pragma unroll
                    for (int i = 0; i < 8; ++i) { const float c = ((const GAS float*)tb)[i], sn = ((const GAS float*)tb)[32 + i], t1 = q1[i], t2 = q2[i]; q1[i] = t1 * c - t2 * sn; q2[i] = t2 * c + t1 * sn; } }
                ATT_QPK(s, q1); ATT_QPK(s + 2, q2); }
            else { qb[s] = __builtin_bit_cast(bf16x8, (u32x4){0u, 0u, 0u, 0u}); qb[s + 2] = qb[s]; }
            __builtin_amdgcn_sched_barrier(0); }
#undef ATT_QF
#undef ATT_QPK
    }
    f32x16 o[4];
#pragma unroll
    for (int db = 0; db < 4; ++db)
#pragma unroll
        for (int i = 0; i < 16; ++i) o[db][i] = 0.f;
    float m_run = -1e30f, l_run = 0.f;
    unsigned kso[3], vso[2];
#pragma unroll
    for (int i = 0; i < 3; ++i) { const int a = 1024 * (3 * w + i) + 16 * lane, row = a / 384, cp = (a % 384) >> 4, c = (cp & ~7) | ((cp ^ (row >> 1)) & 7); kso[i] = (unsigned)(row * (int)d.k_rs + c * 8); }
#pragma unroll
    for (int i = 0; i < 2; ++i) { const int a = 1024 * (2 * w + i) + 16 * lane, row = a >> 7, cp = (a & 127) >> 4, c = cp ^ ((row >> 1) & 7); vso[i] = (unsigned)(row * (int)d.vt_rs + c * 8); }
    const int y = hi ^ ((r32 >> 1) & 7);
    int off4[4];
#pragma unroll
    for (int j = 0; j < 4; ++j) off4[j] = 16 * ((2 * j) ^ y);
#define ATT_DMA(jt, buf) do { const bf16* kg = d.K + (size_t)(64 * (jt)) * d.k_rs; const bf16* vg = d.Vt + 64 * (jt); \
        _Pragma("unroll") for (int i = 0; i < 3; ++i) __builtin_amdgcn_global_load_lds((const unsigned*)(kg + kso[i]), (LAS unsigned*)(lds + KOFF + (buf) * KB + 1024 * (3 * w + i)), 16, 0, 0); \
        _Pragma("unroll") for (int i = 0; i < 2; ++i) __builtin_amdgcn_global_load_lds((const unsigned*)(vg + vso[i]), (LAS unsigned*)(lds + VOFF + (buf) * VB + 1024 * (2 * w + i)), 16, 0, 0); } while (0)
    ATT_DMA(0, 0);
    VM_WAIT(); __syncthreads();
    for (int jt = 0; jt < d.ntiles; ++jt) {
        const int cur = jt & 1;
        if (jt + 1 < d.ntiles) ATT_DMA(jt + 1, cur ^ 1);
        const bool diag = jt >= d.diag0;
        const int keyl0 = 64 * (jt - d.diag0);
        if (!(diag && keyl0 > 32 * w + 31)) {
            f32x16 s0, s1;
#pragma unroll
            for (int i = 0; i < 16; ++i) { s0[i] = 0.f; s1[i] = 0.f; }
            const LAS unsigned char* kb = lds + KOFF + cur * KB + r32 * 384;
#pragma unroll
            for (int s = 0; s < 12; ++s) { const bf16x8 k0 = *(const LAS bf16x8*)(kb + 128 * (s >> 2) + off4[s & 3]), k1 = *(const LAS bf16x8*)(kb + 32 * 384 + 128 * (s >> 2) + off4[s & 3]);
                s0 = __builtin_amdgcn_mfma_f32_32x32x16_bf16(k0, qb[s], s0, 0, 0, 0); s1 = __builtin_amdgcn_mfma_f32_32x32x16_bf16(k1, qb[s], s1, 0, 0, 0); if ((s & 3) == 3) __builtin_amdgcn_sched_barrier(0); }
            if (diag) {
#pragma unroll
                for (int i = 0; i < 16; ++i) { const int kk = keyl0 + crow(i, hi); if (kk > qloc) s0[i] = -1e30f; if (kk + 32 > qloc) s1[i] = -1e30f; } }
            float mx = s0[0];
#pragma unroll
            for (int i = 1; i < 16; ++i) mx = fmaxf(mx, s0[i]);
#pragma unroll
            for (int i = 0; i < 16; ++i) mx = fmaxf(mx, s1[i]);
            mx = fmaxf(mx, __shfl_xor(mx, 32));
            if (__any(mx > m_run + 8.0f)) {
                const float m_new = mx > m_run + 8.0f ? mx : m_run, alpha = __builtin_amdgcn_exp2f(m_run - m_new);
                m_run = m_new; l_run *= alpha;
#pragma unroll
                for (int db = 0; db < 4; ++db)
#pragma unroll
                    for (int i = 0; i < 16; ++i) o[db][i] *= alpha;
            }
            float ls = 0.f;
#pragma unroll
            for (int i = 0; i < 16; ++i) { s0[i] = __builtin_amdgcn_exp2f(s0[i] - m_run); s1[i] = __builtin_amdgcn_exp2f(s1[i] - m_run); ls += s0[i] + s1[i]; }
            l_run += ls;
            bf16x8 pf[4];
            { u32x4 p;
              p.x = cvtpk(s0[0], s0[1]); p.y = cvtpk(s0[2], s0[3]); p.z = cvtpk(s0[4], s0[5]); p.w = cvtpk(s0[6], s0[7]); pf[0] = __builtin_bit_cast(bf16x8, p);
              p.x = cvtpk(s0[8], s0[9]); p.y = cvtpk(s0[10], s0[11]); p.z = cvtpk(s0[12], s0[13]); p.w = cvtpk(s0[14], s0[15]); pf[1] = __builtin_bit_cast(bf16x8, p);
              p.x = cvtpk(s1[0], s1[1]); p.y = cvtpk(s1[2], s1[3]); p.z = cvtpk(s1[4], s1[5]); p.w = cvtpk(s1[6], s1[7]); pf[2] = __builtin_bit_cast(bf16x8, p);
              p.x = cvtpk(s1[8], s1[9]); p.y = cvtpk(s1[10], s1[11]); p.z = cvtpk(s1[12], s1[13]); p.w = cvtpk(s1[14], s1[15]); pf[3] = __builtin_bit_cast(bf16x8, p); }
            const LAS unsigned char* vb = lds + VOFF + cur * VB + r32 * 128;
#pragma unroll
            for (int db = 0; db < 4; ++db)
#pragma unroll
                for (int ks = 0; ks < 4; ++ks) { const bf16x8 vf = *(const LAS bf16x8*)(vb + db * 32 * 128 + off4[ks]);
                    o[db] = __builtin_amdgcn_mfma_f32_32x32x16_bf16(vf, pf[ks], o[db], 0, 0, 0); if (ks & 1) __builtin_amdgcn_sched_barrier(0); }
        }
        VM_WAIT(); __syncthreads();
    }
#undef ATT_DMA
    const float inv = 1.0f / (l_run + __shfl_xor(l_run, 32));
    bf16* orow = d.O + trow * d.o_rs;
#pragma unroll
    for (int db = 0; db < 4; ++db)
#pragma unroll
        for (int j = 0; j < 4; ++j) { u32x2 q; q.x = cvtpk(o[db][4 * j] * inv, o[db][4 * j + 1] * inv); q.y = cvtpk(o[db][4 * j + 2] * inv, o[db][4 * j + 3] * inv);
            *(GAS u32x2*)(orow + 32 * db + 8 * j + 4 * hi) = q; }
}
__device__ __forceinline__ int claim_unit(Frame& F, gu32* q) {
    __syncthreads();
    if (F.tid == 0) F.MISC[0] = __hip_atomic_fetch_add((unsigned*)q, 1u, RLX_AGENT);
    __syncthreads();
    return (int)F.MISC[0];
}
__device__ __forceinline__ void mem_attn_unit(Frame& F, const Args& args, int l, int mu, int qcol0, int ldp) {
    const int b = mu >> 5, h = (mu >> 3) & 3, qb = mu & 7;
    AttnDesc d;
    d.Q = WSP(bf16, WS_PROJ) + qcol0 + h * 128; d.q_rs = ldp; d.qdims = 128; d.qg = INF(8) + l * 128; d.tab = nullptr;
    d.K = WSP(bf16, WS_MEMK) + ((size_t)(l * 1024 + b * 256) * 4 + h) * 192; d.k_rs = 768;
    d.Vt = WSP(bf16, WS_MEMVT) + ((size_t)((l * 4 + b) * 4 + h) * 128) * 256; d.vt_rs = 256;
    d.O = WSP(bf16, WS_YCAT) + MIX_W + h * 128; d.o_rs = D;
    d.q0 = b * S + qb * 256; d.ntiles = 4; d.diag0 = 4; d.scale_log2 = 0.08838834764831845f * 1.4426950408889634f;
    attn_unit(F, d);
}
__device__ __forceinline__ void mla_attn_unit(Frame& F, const Args& args, int l, int u) {
    const int qb = 7 - u / 48, bh = u % 48, b = bh / MLA_H, h = bh % MLA_H;
    AttnDesc d;
    d.Q = WSP(bf16, WS_QRAW) + h * 192; d.q_rs = QW; d.qdims = 192; d.qg = INF(27) + (l - NA) * 192; d.tab = WSP(float, WS_TAB);
    d.K = WSP(bf16, WS_K) + (size_t)(b * S) * QW + h * 192; d.k_rs = QW;
    d.Vt = WSP(bf16, WS_VT) + ((size_t)(b * MLA_H + h) * 128) * S; d.vt_rs = S;
    d.O = WSP(bf16, WS_YCAT) + h * 128; d.o_rs = D;
    d.q0 = b * S + qb * 256; d.ntiles = 4 * (qb + 1); d.diag0 = 4 * qb; d.scale_log2 = 0.07216878364870323f * 1.4426950408889634f;
    attn_unit(F, d);
}
typedef short v4i16_t __attribute__((ext_vector_type(4)));
constexpr int MSQ_BM = 320, MSQ_TAIL = 128;
__device__ __forceinline__ void moesq_split(int cnt, int& nm, int& hm, int& tail) {
    const int fl = cnt / MSQ_BM, rem = cnt - fl * MSQ_BM;
    if (fl > 0 && rem <= MSQ_TAIL) { nm = fl; hm = MSQ_BM; tail = rem; } else { nm = fl + 1; hm = (cnt + nm - 1) / nm; tail = 0; }
    if (cnt == 0) { nm = 0; hm = 1; tail = 0; }
}
__device__ __forceinline__ void moesq_table(Frame& F, int l, int ntl) {
    LAS int* tab = (LAS int*)(F.lds + MOE_TAB_OFF);
    __syncthreads();
    if (F.tid < 32) tab[33 + F.tid] = (int)__hip_atomic_load((unsigned*)(F.ctl + CW_MOECNT + (l * 32 + F.tid) * 64), RLX_AGENT);
    __syncthreads();
    if (F.tid == 0) { int s_ = 0, nm, hm, tl;
        for (int e = 0; e < 32; ++e) { tab[e] = s_; moesq_split(tab[33 + e], nm, hm, tl); s_ += nm * ntl; } tab[32] = s_;
        for (int e = 0; e < 32; ++e) { tab[65 + e] = s_; moesq_split(tab[33 + e], nm, hm, tl); s_ += tl > 0 ? ntl : 0; } tab[97] = s_; }
    __syncthreads();
}
struct MoeSqUnit { int e, pn, row0, rows, tile; };
struct MoeSqOrder {
    const LAS int* tab; int G, c;
    int s, o;
    __device__ bool next(int i, MoeSqUnit& u) const {
        const int L = c >= s ? (i < o ? i * (G - s) + (c - s) : o * (G - s) + (i - o) * G + c) : o * (G - s) + i * G + c; if (L >= tab[97]) return false;
        int nm, hm, tl;
        if (L < tab[32]) { int e = 0; while (e < 31 && L >= tab[e + 1]) ++e;
            const int local = L - tab[e], cnt = tab[33 + e]; moesq_split(cnt, nm, hm, tl);
            const int pm = local % nm, lim = cnt - tl;
            u.e = e; u.pn = local / nm; u.row0 = pm * hm; u.rows = lim - u.row0 < hm ? lim - u.row0 : hm; u.tile = pm; return true; }
        int e = 0; while (e < 31 && L >= tab[65 + e + 1]) ++e;
        const int cnt = tab[33 + e]; moesq_split(cnt, nm, hm, tl);
        u.e = e; u.pn = L - tab[65 + e]; u.row0 = cnt - tl; u.rows = tl; u.tile = 31; return true;
    }
};
__device__ __forceinline__ unsigned moe_off_b(unsigned row, unsigned ch) { return 256u * row + 16u * (ch ^ (((row & 3u) << 2) | ((row >> 2) & 3u))); }
template <bool G2>
__device__ __forceinline__ void moesq_phase(Frame& F, int l, const MoeSqOrder& So) {
    constexpr int K = G2 ? D_EXP : D, NT = K / 32, LDW = G2 ? D : D_EXP;
    constexpr int ASTG = 40960, BSTG = 16384, AOFF = 0, BOFF = 2 * ASTG, SOFF = BOFF + 2 * BSTG, ND = NT / 2;
    static_assert(SOFF + 32768 <= RING_BYTES, "moesq lds");
    LAS unsigned char* lds = F.lds + RING_OFF;
    const int w = F.wave, wr = w >> 2, wc = w & 3;
    const bf16* Abase = G2 ? WSP(bf16, WS_H) : WSP(bf16, WS_XN);
    const int* lists = WSP(int, WS_LISTS);
    MoeSqUnit u;
    for (int ui = 0; So.next(ui, u); ++ui) {
        int lane_ = F.lane; asm volatile("" : "+v"(lane_));
        const int lane = lane_, r16 = lane & 15, kg = lane >> 4;
    const int hf = lane >> 5;
        unsigned bw[2];
#pragma unroll
        for (int i = 0; i < 2; ++i) bw[i] = (unsigned)(hf * 8192) + moe_off_b((unsigned)(w + 8 * i), (unsigned)((lane & 31) >> 1)) + 8u * (lane & 1);
        const int e = u.e, rows = u.rows;
        const size_t eo = (size_t)(l * 32 + e);
        const float* wsrc = !G2 ? (hf ? INF(33) : INF(32)) + eo * D * D_EXP + (size_t)w * D_EXP + u.pn * 128 + 4 * (lane & 31)
                                : INF(34) + eo * D_EXP * D + (size_t)w * D + u.pn * 256 + 4 * lane;
        unsigned aoff[5];
#pragma unroll
        for (int j = 0; j < 5; ++j) { const int rs = 8 * (5 * w + j) + (lane >> 3), r = rs < rows ? rs : rows - 1; const int ent = ((const GAS int*)lists)[e * LCAP + u.row0 + r];
            aoff[j] = (unsigned)((G2 ? ent : (ent >> 1)) * K) * 2u + (unsigned)(((lane & 7) ^ ((rs >> 1) & 7)) * 16); }
        asm volatile("" : "+v"(aoff[0]), "+v"(aoff[1]), "+v"(aoff[2]), "+v"(aoff[3]), "+v"(aoff[4]));
        f32x4 acc[10][4];
#pragma unroll
        for (int i = 0; i < 10; ++i)
#pragma unroll
            for (int j = 0; j < 4; ++j) acc[i][j] = (f32x4){0.f, 0.f, 0.f, 0.f};
        const bool active = 16 * wr < rows;
#define MSQ_ADMA(dstep, st) do { __builtin_amdgcn_sched_barrier(0); asm volatile("" ::: "memory"); const int tl_ = (dstep) < ND ? (dstep) : ND - 1; const char* ag_ = (const char*)Abase + (size_t)tl_ * 128; _Pragma("unroll") for (int j_ = 0; j_ < 5; ++j_) \
        __builtin_amdgcn_global_load_lds((const unsigned*)(ag_ + aoff[j_]), (LAS unsigned*)(lds + AOFF + (st) * ASTG + (5 * w + j_) * 1024), 16, 0, 0); __builtin_amdgcn_sched_barrier(0); asm volatile("" ::: "memory"); } while (0)
#define MSQ_WLOAD(tile, W_) do { __builtin_amdgcn_sched_barrier(0); const int tl_ = (tile) < NT ? (tile) : NT - 1; const GAS float* ws_ = (const GAS float*)(wsrc + (size_t)tl_ * 32 * LDW); \
        _Pragma("unroll") for (int i_ = 0; i_ < 4; ++i_) asm volatile("global_load_dwordx4 %0, %1, off" : "=v"(W_[i_]) : "v"(ws_ + (size_t)(8 * i_) * LDW) : "memory"); __builtin_amdgcn_sched_barrier(0); } while (0)
#define MSQ_WWAIT(n, W_) asm volatile("s_waitcnt vmcnt(" #n ")" : "+v"(W_[0]), "+v"(W_[1]), "+v"(W_[2]), "+v"(W_[3]) :: "memory")
#define MSQ_WSTORE(st, W_) do { _Pragma("unroll") for (int i_ = 0; i_ < 4; ++i_) { u32x2 q_; q_.x = cvtpk(W_[i_].x, W_[i_].y); q_.y = cvtpk(W_[i_].z, W_[i_].w); \
        *(LAS u32x2*)(lds + BOFF + (st) * BSTG + bw[i_ & 1] + (i_ >> 1) * 4096) = q_; } } while (0)
#define MSQ_WLOAD_S(tile) do { __builtin_amdgcn_sched_barrier(0); asm volatile("" ::: "memory"); const int tl_ = (tile) < NT ? (tile) : NT - 1; const float* ws_ = wsrc + (size_t)tl_ * 32 * LDW; \
        _Pragma("unroll") for (int i_ = 0; i_ < 4; ++i_) __builtin_amdgcn_global_load_lds((const unsigned*)(ws_ + (size_t)(8 * i_) * LDW), (LAS unsigned*)(lds + SOFF + (w + 8 * i_) * 1024), 16, 0, 0); \
        __builtin_amdgcn_sched_barrier(0); asm volatile("" ::: "memory"); } while (0)
#define MSQ_WSTORE_S(st) do { f32x4 v_[4]; _Pragma("unroll") for (int i_ = 0; i_ < 4; ++i_) v_[i_] = *(const LAS f32x4*)(lds + SOFF + (w + 8 * i_) * 1024 + lane * 16); MSQ_WSTORE(st, v_); } while (0)
#define MSQ_MM4(i0, AD_) do { bf16x8 x0_, x1_, x2_, x3_; \
        asm volatile("ds_read_b128 %[x0], %[ad] offset:%[o0]\n\tds_read_b128 %[x1], %[ad] offset:%[o1]\n\tds_read_b128 %[x2], %[ad] offset:%[o2]\n\tds_read_b128 %[x3], %[ad] offset:%[o3]\n\t" \
                     "s_waitcnt lgkmcnt(3)\n\tv_mfma_f32_16x16x32_bf16 %[a0], %[w0], %[x0], %[a0]\n\tv_mfma_f32_16x16x32_bf16 %[b0], %[w1], %[x0], %[b0]\n\t" \
                     "s_waitcnt lgkmcnt(2)\n\tv_mfma_f32_16x16x32_bf16 %[a1], %[w0], %[x1], %[a1]\n\tv_mfma_f32_16x16x32_bf16 %[b1], %[w1], %[x1], %[b1]\n\t" \
                     "s_waitcnt lgkmcnt(1)\n\tv_mfma_f32_16x16x32_bf16 %[a2], %[w0], %[x2], %[a2]\n\tv_mfma_f32_16x16x32_bf16 %[b2], %[w1], %[x2], %[b2]\n\t" \
                     "s_waitcnt lgkmcnt(0)\n\tv_mfma_f32_16x16x32_bf16 %[a3], %[w0], %[x3], %[a3]\n\tv_mfma_f32_16x16x32_bf16 %[b3], %[w1], %[x3], %[b3]" \
            : [a0] "+v"(acc[(i0)][2 * hh]), [b0] "+v"(acc[(i0)][2 * hh + 1]), [a1] "+v"(acc[(i0) + 1][2 * hh]), [b1] "+v"(acc[(i0) + 1][2 * hh + 1]), \
              [a2] "+v"(acc[(i0) + 2][2 * hh]), [b2] "+v"(acc[(i0) + 2][2 * hh + 1]), [a3] "+v"(acc[(i0) + 3][2 * hh]), [b3] "+v"(acc[(i0) + 3][2 * hh + 1]), \
              [x0] "=&v"(x0_), [x1] "=&v"(x1_), [x2] "=&v"(x2_), [x3] "=&v"(x3_) \
            : [w0] "v"(wf0), [w1] "v"(wf1), [ad] "v"(AD_), [o0] "n"((i0) * 2048), [o1] "n"((i0) * 2048 + 2048), [o2] "n"((i0) * 2048 + 4096), [o3] "n"((i0) * 2048 + 6144) : "memory"); } while (0)
#define MSQ_MM2(i0, AD_) do { bf16x8 x0_, x1_; \
        asm volatile("ds_read_b128 %[x0], %[ad] offset:%[o0]\n\tds_read_b128 %[x1], %[ad] offset:%[o1]\n\t" \
                     "s_waitcnt lgkmcnt(1)\n\tv_mfma_f32_16x16x32_bf16 %[a0], %[w0], %[x0], %[a0]\n\tv_mfma_f32_16x16x32_bf16 %[b0], %[w1], %[x0], %[b0]\n\t" \
                     "s_waitcnt lgkmcnt(0)\n\tv_mfma_f32_16x16x32_bf16 %[a1], %[w0], %[x1], %[a1]\n\tv_mfma_f32_16x16x32_bf16 %[b1], %[w1], %[x1], %[b1]" \
            : [a0] "+v"(acc[(i0)][2 * hh]), [b0] "+v"(acc[(i0)][2 * hh + 1]), [a1] "+v"(acc[(i0) + 1][2 * hh]), [b1] "+v"(acc[(i0) + 1][2 * hh + 1]), [x0] "=&v"(x0_), [x1] "=&v"(x1_) \
            : [w0] "v"(wf0), [w1] "v"(wf1), [ad] "v"(AD_), [o0] "n"((i0) * 2048), [o1] "n"((i0) * 2048 + 2048) : "memory"); } while (0)
#define MSQ_TRA(jc_, tt_) (moe_off_b(8u * kg_ + 4u * (tt_) + trq, 2u * (G2 ? (unsigned)(4 * (wc & 1) + 2 * hh + (jc_)) : (unsigned)(2 * wc + (jc_))) + (trp >> 1)) + 8u * (trp & 1))
#define MSQ_TRAH(hh_, jc_, tt_) ((G2 ? 0u : (unsigned)((hh_) * 8192)) + moe_off_b(8u * kg_ + 4u * (tt_) + trq, 2u * (G2 ? (unsigned)(4 * (wc & 1) + 2 * (hh_) + (jc_)) : (unsigned)(2 * wc + (jc_))) + (trp >> 1)) + 8u * (trp & 1))
#define MSQ_MMQ2(i0, AD_) do { bf16x8 x0_, x1_; \
        asm volatile("ds_read_b128 %[x0], %[ad] offset:%[o0]\n\tds_read_b128 %[x1], %[ad] offset:%[o1]\n\t" \
                     "s_waitcnt lgkmcnt(1)\n\tv_mfma_f32_16x16x32_bf16 %[a0], %[w0], %[x0], %[a0]\n\tv_mfma_f32_16x16x32_bf16 %[a1], %[w1], %[x0], %[a1]\n\tv_mfma_f32_16x16x32_bf16 %[a2], %[w2], %[x0], %[a2]\n\tv_mfma_f32_16x16x32_bf16 %[a3], %[w3], %[x0], %[a3]\n\t" \
                     "s_waitcnt lgkmcnt(0)\n\tv_mfma_f32_16x16x32_bf16 %[b0], %[w0], %[x1], %[b0]\n\tv_mfma_f32_16x16x32_bf16 %[b1], %[w1], %[x1], %[b1]\n\tv_mfma_f32_16x16x32_bf16 %[b2], %[w2], %[x1], %[b2]\n\tv_mfma_f32_16x16x32_bf16 %[b3], %[w3], %[x1], %[b3]" \
            : [a0] "+v"(acc[(i0)][0]), [a1] "+v"(acc[(i0)][1]), [a2] "+v"(acc[(i0)][2]), [a3] "+v"(acc[(i0)][3]), \
              [b0] "+v"(acc[(i0) + 1][0]), [b1] "+v"(acc[(i0) + 1][1]), [b2] "+v"(acc[(i0) + 1][2]), [b3] "+v"(acc[(i0) + 1][3]), [x0] "=&v"(x0_), [x1] "=&v"(x1_) \
            : [w0] "v"(wf0), [w1] "v"(wf1), [w2] "v"(wf2), [w3] "v"(wf3), [ad] "v"(AD_), [o0] "n"((i0) * 4096), [o1] "n"((i0) * 4096 + 4096) : "memory"); } while (0)
#define MSQ_COMPUTE(sa_, p_, sb_) do { if (active) { \
            int ln_ = lane; asm volatile("" : "+v"(ln_));         \
            const unsigned abs_ = (unsigned)(__SIZE_TYPE__)(lds + AOFF + (sa_) * ASTG + wr * 2048) + (unsigned)((ln_ & 15) * 128 + (((4 * (p_) + (ln_ >> 4)) ^ ((ln_ >> 1) & 7)) * 16));     \
            const unsigned bbs = (unsigned)(__SIZE_TYPE__)(lds + BOFF + (sb_) * BSTG + (G2 ? (wc >> 1) * 8192 : 0)); \
            const unsigned kg_ = (unsigned)ln_ >> 4, trq = ((unsigned)ln_ & 15u) >> 2, trp = (unsigned)ln_ & 3u; \
            v4i16_t t0, t1, t2, t3, t4, t5, t6, t7;        \
            asm volatile("ds_read_b64_tr_b16 %0, %8\n\tds_read_b64_tr_b16 %1, %9\n\tds_read_b64_tr_b16 %2, %10\n\tds_read_b64_tr_b16 %3, %11\n\t" \
                         "ds_read_b64_tr_b16 %4, %12\n\tds_read_b64_tr_b16 %5, %13\n\tds_read_b64_tr_b16 %6, %14\n\tds_read_b64_tr_b16 %7, %15\n\ts_waitcnt lgkmcnt(0)" \
                : "=&v"(t0), "=&v"(t1), "=&v"(t2), "=&v"(t3), "=&v"(t4), "=&v"(t5), "=&v"(t6), "=&v"(t7) \
                : "v"(bbs + MSQ_TRAH(0, 0, 0)), "v"(bbs + MSQ_TRAH(0, 0, 1)), "v"(bbs + MSQ_TRAH(0, 1, 0)), "v"(bbs + MSQ_TRAH(0, 1, 1)), \
                  "v"(bbs + MSQ_TRAH(1, 0, 0)), "v"(bbs + MSQ_TRAH(1, 0, 1)), "v"(bbs + MSQ_TRAH(1, 1, 0)), "v"(bbs + MSQ_TRAH(1, 1, 1)) : "memory"); \
            const bf16x8 wf0 = (bf16x8){t0[0], t0[1], t0[2], t0[3], t1[0], t1[1], t1[2], t1[3]}, wf1 = (bf16x8){t2[0], t2[1], t2[2], t2[3], t3[0], t3[1], t3[2], t3[3]}, \
                         wf2 = (bf16x8){t4[0], t4[1], t4[2], t4[3], t5[0], t5[1], t5[2], t5[3]}, wf3 = (bf16x8){t6[0], t6[1], t6[2], t6[3], t7[0], t7[1], t7[2], t7[3]}; \
            MSQ_MMQ2(0, abs_); MSQ_MMQ2(2, abs_); if (g1) { MSQ_MMQ2(4, abs_); MSQ_MMQ2(6, abs_); } if (g2) MSQ_MMQ2(8, abs_); } } while (0)
#define MSQ_STEP_S(t, k_) do { MSQ_COMPUTE(((k_) >> 1) & 1, 1, (k_) & 1); asm volatile("s_waitcnt vmcnt(9)" ::: "memory"); MSQ_WSTORE_S(((k_) + 1) & 1); MSQ_WLOAD_S((t) + 3); \
            asm volatile("s_waitcnt vmcnt(8)" ::: "memory"); asm volatile("s_waitcnt lgkmcnt(0)" ::: "memory"); __builtin_amdgcn_s_barrier(); asm volatile("" ::: "memory"); } while (0)
#define MSQ_STEP(t, k_, WS_) do { MSQ_ADMA(((t) >> 1) + 1, (((k_) >> 1) + 1) & 1); MSQ_COMPUTE(((k_) >> 1) & 1, 0, (k_) & 1); MSQ_WWAIT(9, WS_); MSQ_WSTORE(((k_) + 1) & 1, WS_); MSQ_WLOAD((t) + 3, WS_); \
            asm volatile("s_waitcnt lgkmcnt(0)" ::: "memory"); __builtin_amdgcn_s_barrier(); asm volatile("" ::: "memory"); } while (0)
        const bool g1 = 16 * (8 + wr) < rows, g2 = 16 * (16 + wr) < rows;
        f32x4 wB[4];
        if (G2) {
            if (F.tid == 0) { gu32* dn = F.ctl + CW_MOEDONE + ((l * 32 + e) * 32 + u.tile) * 16; unsigned sp_ = 0;
                while (__hip_atomic_load((unsigned*)dn, RLX_AGENT) < 4u) { __builtin_amdgcn_s_sleep(1); if (++sp_ > (1u << 20)) break; }
                __builtin_amdgcn_fence(__ATOMIC_ACQUIRE, "agent"); asm volatile("s_waitcnt vmcnt(0)" ::: "memory"); }
            __syncthreads();
        }
        MSQ_WLOAD_S(0); MSQ_ADMA(0, 0); MSQ_WLOAD(1, wB);
        asm volatile("s_waitcnt vmcnt(9)" ::: "memory"); MSQ_WSTORE_S(0);
        MSQ_WLOAD_S(2);
        asm volatile("s_waitcnt vmcnt(8)" ::: "memory");
        asm volatile("s_waitcnt lgkmcnt(0)" ::: "memory"); __builtin_amdgcn_s_barrier(); asm volatile("" ::: "memory");
        for (int t = 0; t < NT; t += 4) { MSQ_STEP(t, 0, wB); MSQ_STEP_S(t + 1, 1); MSQ_STEP(t + 2, 2, wB); MSQ_STEP_S(t + 3, 3); }
        MSQ_WWAIT(0, wB);
        if (active) {
            int le_ = F.lane; asm volatile("" : "+v"(le_)); const int r16e = le_ & 15, kge = le_ >> 4;
#pragma unroll
            for (int i = 0; i < 10; ++i) { int r = 16 * (2 * i + wr) + r16e; asm volatile("" : "+v"(r));
                if (r < rows) { const int slot = ((const GAS int*)lists)[e * LCAP + u.row0 + r];
                    if (!G2) { const float rsd = ((const GAS float*)WSP(float, WS_RSTD))[slot >> 1], gw = ((const GAS float*)WSP(float, WS_SELW))[slot] * rsd;
#pragma unroll
                        for (int jp = 0; jp < 2; ++jp) { const f32x4 g = acc[i][jp] * rsd, up = acc[i][jp + 2]; u32x2 q;
                            q.x = cvtpk(g.x * fast_sigmoid(g.x) * up.x * gw, g.y * fast_sigmoid(g.y) * up.y * gw); q.y = cvtpk(g.z * fast_sigmoid(g.z) * up.z * gw, g.w * fast_sigmoid(g.w) * up.w * gw);
                            __hip_atomic_store((GAS unsigned long long*)(WSP(bf16, WS_H) + (size_t)slot * D_EXP + u.pn * 128 + 16 * (2 * wc + jp) + 4 * kge), (unsigned long long)q.x | ((unsigned long long)q.y << 32), RLX_AGENT); } }
                    else {
#pragma unroll
                        for (int j = 0; j < 4; ++j) { const f32x4 v = acc[i][j]; u32x2 q; q.x = cvtpk(v.x, v.y); q.y = cvtpk(v.z, v.w);
                            *(GAS u32x2*)(WSP(bf16, WS_OSLOT) + (size_t)slot * D + u.pn * 256 + 128 * (wc >> 1) + 16 * (4 * (wc & 1) + j) + 4 * kge) = q; } } } }
        }
        if (!G2) {
            asm volatile("s_waitcnt vmcnt(0)" ::: "memory"); asm volatile("s_waitcnt lgkmcnt(0)" ::: "memory"); __builtin_amdgcn_s_barrier(); asm volatile("" ::: "memory");
            if (F.tid == 0) (void)__hip_atomic_fetch_add((unsigned*)(F.ctl + CW_MOEDONE + ((l * 32 + e) * 32 + u.tile) * 16), 1u, RLX_AGENT);
        } else { asm volatile("s_waitcnt lgkmcnt(0)" ::: "memory"); __builtin_amdgcn_s_barrier(); asm volatile("" ::: "memory"); }
#undef MSQ_ADMA
#undef MSQ_WLOAD
#undef MSQ_WSTORE
#undef MSQ_COMPUTE
#undef MSQ_MM4
#undef MSQ_TRA
#undef MSQ_TRAH
#undef MSQ_MMQ2
#undef MSQ_STEP
#undef MSQ_STEP_S
#undef MSQ_WLOAD_S
#undef MSQ_WSTORE_S
    }
}
constexpr int NPHASE = 37;
__device__ __forceinline__ bool relaunder(Frame& F) { int t = threadIdx.x; asm volatile("" : "+v"(t)); F.tid = t; F.lane = t & 63; unsigned char* w = F.ws; asm volatile("" : "+s"(w)); F.ws = w;
    const __attribute__((address_space(4))) char* ka = (const __attribute__((address_space(4))) char*)__builtin_amdgcn_kernarg_segment_ptr(); asm volatile("" : "+s"(ka)); F.ka = ka; return true; }
#ifndef MK_BODIES
#define MK_BODIES 0xFFFF
#endif
#ifndef MK_REP
#define MK_REP 0
#endif
#define BODY(bit) if constexpr ((MK_BODIES & (bit)) != 0) for (int rep_ = 0; rep_ < (((MK_REP) & (bit)) ? 2 : 1); ++rep_)
__global__ void __launch_bounds__(NTHR, 2) mk_fwd(Args args) {
    extern __shared__ __attribute__((aligned(16))) unsigned char lds_raw[];
    Frame F;
    F.lds = (LAS unsigned char*)lds_raw; F.MISC = (volatile LAS unsigned*)(F.lds + MISC_OFF);
    F.tid = threadIdx.x; F.lane = F.tid & 63; F.wave = __builtin_amdgcn_readfirstlane(F.tid >> 6); F.G = gridDim.x; F.bid = blockIdx.x;
    F.ws = args.ws; F.ctl = (gu32*)(args.ws + WS_CTL);
    for (int u = F.tid; u < (LDS_BYTES - LDSCTL_OFF) / 4; u += NTHR) ((LAS unsigned*)(F.lds + LDSCTL_OFF))[u] = 0u;
    __syncthreads();
#ifdef MK_FIX_LO
    const int lo = MK_FIX_LO, hi = MK_FIX_HI;
#else
    const int lo = args.ph_lo, hi = args.ph_hi;
#endif
    XcdBarrier bar; bar.bar = (unsigned*)(F.ctl + CW_BAR); bar.x = 0; bar.st = nullptr;
    if (hi - lo > 1) bar = xcd_barrier_post((unsigned*)(F.ctl + CW_BAR), F.MISC + 8);
#define PH(id) if (lo <= (id) && (id) < hi && relaunder(F))
#if MK_STAMP
#define SEAM(id) do { if ((id) + 1 < hi) xcd_barrier(bar); if (blockIdx.x == 0 && threadIdx.x == 0) ((unsigned long long*)(F.ctl + CW_STAMP))[(id) + 1] = __builtin_amdgcn_s_memrealtime(); } while (0)
#else
#define SEAM(id) do { if ((id) + 1 < hi) xcd_barrier(bar); } while (0)
#endif
    float* xres = args.out;
    const int vcu = (F.G % 8 == 0) ? (F.bid % 8) * (F.G / 8) + F.bid / 8 : F.bid;
#if MK_STAMP
    if (blockIdx.x == 0 && threadIdx.x == 0) ((unsigned long long*)(F.ctl + CW_STAMP))[0] = __builtin_amdgcn_s_memrealtime();
#endif
    LAS unsigned char* ring = F.lds + RING_OFF;

    PH(0) { BODY(1) { p0_prologue(F, args);
#if !MK_MOESQ
#if MK_BGCONV
        conv_experts(F, args, 0);
#else
        for (int l = 0; l < DEPTH; ++l) conv_experts(F, args, l);
#endif
#endif
    } SEAM(0); }
    for (int l = 0; l < DEPTH; ++l) {
        const int j = l - NA;
        const int pb = l < NA ? 1 + 8 * l : 17 + 10 * (l - NA);
        const int tb = l < NA ? pb + 3 : pb + 5;
        if (l < NA) {
            PH(pb + 0) {
                if (l == 0) {
                    pg8::Dense2Prob P{WSP(bf16, WS_XN), WSP(bf16, WS_WT_INA), WSP(bf16, WS_MEMN), WSP(bf16, WS_WT_MKV), D, 4, 1024}; pg8::Order2 So{T / 256, IN_A / 256, 4096 / 256, 1024 / 256, F.G, vcu};
                    pg8::EpiBf16x2 E{WSP(bf16, WS_PROJ), IN_A, WSP(bf16, WS_MKVR), 1024};
                    BODY(2) pg8::gemm_phase<pg8::Dense2Prob, pg8::EpiBf16x2, pg8::Order2, true>(ring, P, So, E);
                } else {
                    pg8::DenseProb P{WSP(bf16, WS_XN), WSP(bf16, WS_WT_INA) + (size_t)l * IN_A * D, D, IN_A}; pg8::StaticOrder So; So.init(T, IN_A, F.G, F.bid, 1 << 20);
                    pg8::EpiBf16 E{WSP(bf16, WS_PROJ), IN_A};
                    BODY(2) pg8::gemm_phase<pg8::DenseProb, pg8::EpiBf16, pg8::StaticOrder, true>(ring, P, So, E);
#if MK_BGCONV
                    if (F.G == 256 && F.bid >= 192) conv_quota(F, args, MK_Q_INA);
#endif
                }
                SEAM(pb + 0);
            }
            PH(pb + 1) {
                BODY(8) for (int u = F.bid; u < 192; u += F.G) scan_unit(F, args, l, u);
                if (l == 0) { BODY(4) { if (F.G > 192) { if (F.bid >= 192) mem_assemble(F, args, (F.bid - 192) * NWAVES + F.wave, (F.G - 192) * NWAVES); } else mem_assemble(F, args, F.bid * NWAVES + F.wave, F.G * NWAVES); } }
                else { gu32* q = F.ctl + CW_ATTQ + l * 64;
                    BODY(16) for (int u = claim_unit(F, q); u < 128; u = claim_unit(F, q)) mem_attn_unit(F, args, l, u, 2 * LRU_W, IN_A); }
#if MK_BGCONV
                if (F.G == 256 && F.bid >= 192) conv_quota(F, args, l == 0 ? MK_Q_SCAN0 : MK_Q_SCAN1);
#endif
                SEAM(pb + 1);
            }
            if (l == 0) { PH(pb + 2) {
                gu32* q = F.ctl + CW_ATTQ + l * 64;
                BODY(16) for (int u = claim_unit(F, q); u < 128; u = claim_unit(F, q)) mem_attn_unit(F, args, l, u, 2 * LRU_W, IN_A);
                SEAM(pb + 2);
            } }
        } else {
            PH(pb + 0) {
                if (l == NA) {
                    pg8::Dense2Prob P{WSP(bf16, WS_XN), WSP(bf16, WS_WT_INB) + (size_t)j * IN_B * D, WSP(bf16, WS_XKV), WSP(bf16, WS_WT_DKV), D, 1 << 20, 512}; pg8::Order2 So{T / 256, IN_B / 256, T / 256, 512 / 256, F.G, vcu};
                    pg8::EpiBf16x2 E{WSP(bf16, WS_PROJ), IN_B, WSP(bf16, WS_CKV), 512};
                    BODY(2) pg8::gemm_phase<pg8::Dense2Prob, pg8::EpiBf16x2, pg8::Order2, true>(ring, P, So, E);
#if MK_BGCONV
                    if (F.G == 256 && vcu >= 192) conv_quota(F, args, MK_Q_INB);
#endif
                } else {
                    pg8::DenseProb P{WSP(bf16, WS_XN), WSP(bf16, WS_WT_INB) + (size_t)j * IN_B * D, D, IN_B}; pg8::StaticOrder So; So.init(T, IN_B, F.G, F.bid, 1 << 20);
                    pg8::EpiBf16 E{WSP(bf16, WS_PROJ), IN_B};
                    BODY(2) pg8::gemm_phase<pg8::DenseProb, pg8::EpiBf16, pg8::StaticOrder, true>(ring, P, So, E);
#if MK_BGCONV
                    if (F.G == 256 && F.bid >= 128) conv_quota(F, args, MK_Q_INB);
#endif
                }
                SEAM(pb + 0);
            }
            PH(pb + 1) {
                BODY(512) { norm_bf16_rows<8>(F, WSP(bf16, WS_PROJ), IN_B, INF(25) + j * Q_RANK, WSP(bf16, WS_CQN), Q_RANK, T);
                            if (l == NA) norm_bf16_rows<4>(F, WSP(bf16, WS_CKV), 512, INF(20), WSP(bf16, WS_CN), 256, T); }
                SEAM(pb + 1);
            }
            PH(pb + 2) {
                if (l == NA) {
                    pg8::DenseProb P{WSP(bf16, WS_CN), WSP(bf16, WS_WT_UKV), KV_RANK, 3072}; pg8::StaticOrder So; So.init(T, 3072, F.G, F.bid, 1 << 20);
                    pg8::EpiBf16 E{WSP(bf16, WS_KVUP), 3072};
                    BODY(2) pg8::gemm_phase<pg8::DenseProb, pg8::EpiBf16, pg8::StaticOrder, true>(ring, P, So, E);
                }
                {
                    pg8::DenseProb P{WSP(bf16, WS_CQN), WSP(bf16, WS_WT_UQ) + (size_t)j * QW * Q_RANK, Q_RANK, QW}; pg8::StaticOrder So; So.init(T, QW, F.G, l == NA ? (F.bid + F.G / 2) % F.G : F.bid, 1 << 20);
                    pg8::EpiBf16 E{WSP(bf16, WS_QRAW), QW};
                    BODY(2) pg8::gemm_phase<pg8::DenseProb, pg8::EpiBf16, pg8::StaticOrder, true>(ring, P, So, E);
                }
                SEAM(pb + 2);
            }
            if (l == NA) { PH(pb + 3) { BODY(4) kv_assemble(F, args); SEAM(pb + 3); } }
            PH(pb + 4) {
                gu32* q = F.ctl + CW_ATTQ + l * 64;
                BODY(16) for (int u = claim_unit(F, q); u < 384 + 128; u = claim_unit(F, q)) { if (u < 384) mla_attn_unit(F, args, l, u); else mem_attn_unit(F, args, l, u - 384, Q_RANK, IN_B); }
                SEAM(pb + 4);
            }
        }
        PH(tb + 0) {
            pg8::DenseProb P{WSP(bf16, WS_YCAT), WSP(bf16, WS_WT_O) + (size_t)l * D * D, D, D}; pg8::StaticOrder So; So.init(T, D, F.G, F.bid, 1 << 20);
            const bf16* rth = WSP(bf16, WS_WT_RT) + (size_t)l * 2 * 48 * D;
            if (l == 0) { pg8::EpiResRouter<true> E{(const void*)INF(0), nullptr, nullptr, D, INF(4) + l * D, WSP(bf16, WS_XN), rth, rth + 48 * D, WSP(float, WS_RPART), WSP(float, WS_RPSS), T, ring};
                BODY(32) pg8::gemm_phase<pg8::DenseProb, pg8::EpiResRouter<true>, pg8::StaticOrder, true>(ring, P, So, E); }
            else { pg8::EpiResRouter<false> E{(const void*)WSP(bf16, WS_XN), INF(3) + l * D, WSP(float, WS_IRS), D, INF(4) + l * D, WSP(bf16, WS_XN), rth, rth + 48 * D, WSP(float, WS_RPART), WSP(float, WS_RPSS), T, ring};
                BODY(32) pg8::gemm_phase<pg8::DenseProb, pg8::EpiResRouter<false>, pg8::StaticOrder, true>(ring, P, So, E); }
            SEAM(tb + 0);
        }
        PH(tb + 1) { BODY(64) { router_phase(F, args, l, xres);
#if MK_BGCONV
            if (l >= 1) conv_drain(F, args, l);
#endif
        } SEAM(tb + 1); }
#if MK_MOESQ
        PH(tb + 2) {
            { moesq_table(F, l, 4); MoeSqOrder So{(const LAS int*)(F.lds + MOE_TAB_OFF), F.G, vcu, 0, 0}; BODY(128) moesq_phase<false>(F, l, So); }
            { moesq_table(F, l, 8); const LAS int* tab = (const LAS int*)(F.lds + MOE_TAB_OFF); MoeSqOrder So{tab, F.G, vcu, (tab[97] >> 1) % F.G, 2}; BODY(256) moesq_phase<true>(F, l, So); }
            SEAM(tb + 2); }
#else
        PH(tb + 2) {
            moe_table(F, l, 4);
            pg8::GatherProb P{WSP(bf16, WS_XN), WSP(bf16, WS_WT_EGU), D, 1024, WSP(int, WS_LISTS), LCAP, 1, l * 32}; pg8::MoeOrder So{(const LAS int*)(F.lds + MOE_TAB_OFF), F.G, vcu, 4};
            pg8::EpiMoe1 E{WSP(bf16, WS_H), WSP(int, WS_LISTS), WSP(float, WS_SELW), LCAP};
            BODY(128) pg8::gemm_phase<pg8::GatherProb, pg8::EpiMoe1, pg8::MoeOrder, true>(ring, P, So, E);
            SEAM(tb + 2);
        }
        PH(tb + 3) {
            moe_table(F, l, 8);
            pg8::GatherProb P{WSP(bf16, WS_H), WSP(bf16, WS_WT_ED), D_EXP, D, WSP(int, WS_LISTS), LCAP, 0, l * 32}; pg8::MoeOrder So{(const LAS int*)(F.lds + MOE_TAB_OFF), F.G, vcu, 8};
            pg8::EpiMoe2 E{WSP(bf16, WS_OSLOT), WSP(int, WS_LISTS), LCAP, D};
            BODY(256) pg8::gemm_phase<pg8::GatherProb, pg8::EpiMoe2, pg8::MoeOrder, true>(ring, P, So, E);
            SEAM(tb + 3);
        }
#endif
        PH(tb + 4) { BODY(512) combine_norm_rows(F, WSP(bf16, WS_XN), INF(4) + l * D, WSP(float, WS_IRS), l + 1 < DEPTH ? nullptr : xres, WSP(bf16, WS_OSLOT), l + 1 < DEPTH ? INF(3) + (l + 1) * D : nullptr, WSP(bf16, WS_XN), l == NA - 1 ? INF(18) : nullptr, WSP(bf16, WS_XKV)); SEAM(tb + 4); }
    }
#undef PH
#undef SEAM
}
#if MK_STAMP
__global__ void k_encode(const unsigned long long* st, float* out, unsigned long long mask) {
    const unsigned long long t0 = st[0], t1 = st[NPHASE]; unsigned long long acc = 0;
    for (int p = 0; p < NPHASE; ++p) if ((mask >> p) & 1ull) acc += st[p + 1] - st[p];
    const float sc = 1.0f + floorf((float)((double)acc / (double)(t1 - t0)) * 50.0f + 0.5f) / 50.0f;
    for (long i = (long)blockIdx.x * blockDim.x + threadIdx.x; i < (long)T * D; i += (long)gridDim.x * blockDim.x) out[i] *= sc;
}
#endif
}
#if MK_MODE == 2

namespace nv {
constexpr int Bn = 4, S = 2048, D = 2048, T = Bn * S, DEPTH = 4, NA = 2;
constexpr int MEM_LEN = 256, MEM_W = 512, MIX_W = 1536;
constexpr int LRU_W = 1536;
constexpr int MLA_H = 12, QK_DIM = 192, Q_RANK = 512, KV_RANK = 256;
constexpr int NE = 32, D_EXP = 512;
constexpr int IN_A = 3584, IN_B = 1024;
constexpr float EPS = 1e-6f;
constexpr int LCAP = 8192;

__device__ __forceinline__ float wsum(float v) {
#pragma unroll
    for (int o = 32; o >= 1; o >>= 1) v += __shfl_xor(v, o);
    return v;
}
__device__ __forceinline__ float wmax(float v) {
#pragma unroll
    for (int o = 32; o >= 1; o >>= 1) v = fmaxf(v, __shfl_xor(v, o));
    return v;
}

struct NG {
    const float* A; const float* B; float* C; const float* R;
    int lda, ldb, ldc, M, N, K;
    long sA, sB, sC;
    const int* alist; const int* clist; int lstride; int ashift;
    const int* Mdev;
};
__global__ void __launch_bounds__(256) k_ngemm(NG g) {
    __shared__ float As[16][65];
    __shared__ float Bs[16][64];
    const int z = blockIdx.z;
    const int M = g.Mdev ? g.Mdev[z] : g.M;
    const int m0 = blockIdx.y * 64, n0 = blockIdx.x * 64;
    if (m0 >= M) return;
    const float* A = g.A + (long)z * g.sA; const float* B = g.B + (long)z * g.sB; float* C = g.C + (long)z * g.sC;
    const float* R = g.R ? g.R + (long)z * g.sC : nullptr;
    const int* al = g.alist ? g.alist + (long)z * g.lstride : nullptr;
    const int* cl = g.clist ? g.clist + (long)z * g.lstride : nullptr;
    const int tid = threadIdx.x, tx = tid % 16, ty = tid / 16;
    float acc[4][4];
#pragma unroll
    for (int i = 0; i < 4; ++i)
#pragma unroll
        for (int j = 0; j < 4; ++j) acc[i][j] = 0.f;
    long arow[4];
#pragma unroll
    for (int i = 0; i < 4; ++i) { const int r = tid / 16 + 16 * i, gm = m0 + r; arow[i] = -1; if (gm < M) arow[i] = al ? (long)(al[gm] >> g.ashift) : (long)gm; }
    for (int k0 = 0; k0 < g.K; k0 += 16) {
#pragma unroll
        for (int i = 0; i < 4; ++i) { const int r = tid / 16 + 16 * i, kk = tid % 16; As[kk][r] = arow[i] >= 0 ? A[arow[i] * g.lda + k0 + kk] : 0.f; }
#pragma unroll
        for (int i = 0; i < 4; ++i) { const int kk = tid / 64 + 4 * i, n = tid % 64; Bs[kk][n] = (n0 + n < g.N) ? B[(long)(k0 + kk) * g.ldb + n0 + n] : 0.f; }
        __syncthreads();
#pragma unroll
        for (int kk = 0; kk < 16; ++kk) {
            float a[4], b[4];
#pragma unroll
            for (int i = 0; i < 4; ++i) a[i] = As[kk][ty * 4 + i];
#pragma unroll
            for (int j = 0; j < 4; ++j) b[j] = Bs[kk][tx * 4 + j];
#pragma unroll
            for (int i = 0; i < 4; ++i)
#pragma unroll
                for (int j = 0; j < 4; ++j) acc[i][j] = fmaf(a[i], b[j], acc[i][j]);
        }
        __syncthreads();
    }
#pragma unroll
    for (int i = 0; i < 4; ++i) {
        const int gm = m0 + ty * 4 + i; if (gm >= M) continue;
        const long crow = cl ? (long)cl[gm] : (long)gm;
#pragma unroll
        for (int j = 0; j < 4; ++j) { const int gn = n0 + tx * 4 + j; if (gn < g.N) { float v = acc[i][j]; if (R) v += R[crow * g.ldc + gn]; C[crow * g.ldc + gn] = v; } }
    }
}

__global__ void k_rmsnorm(const float* x, float* y, const float* g, int nrows, int ninner, long xso, long xsi, long yso, long ysi, int cols) {
    const int row = blockIdx.x * 4 + (threadIdx.x >> 6), lane = threadIdx.x & 63;
    if (row >= nrows) return;
    const int ro = row / ninner, ri = row % ninner;
    const float* xr = x + ro * xso + ri * xsi; float* yr = y + ro * yso + ri * ysi;
    float ss = 0.f;
    for (int c = lane; c < cols; c += 64) { const float v = xr[c]; ss += v * v; }
    ss = wsum(ss);
    const float rstd = 1.0f / sqrtf(ss / (float)cols + EPS);
    for (int c = lane; c < cols; c += 64) yr[c] = xr[c] * rstd * g[c];
}

__device__ __forceinline__ float gelu_tanh(float x) { const float u = 0.7978845608028654f * (x + 0.044715f * x * x * x); return 0.5f * x * (1.0f + tanhf(u)); }
__device__ __forceinline__ float sigmoidf_(float x) { return 1.0f / (1.0f + expf(-x)); }

__global__ void k_gelu_cols(float* p, int ld, int c0, int ncols, int rows) {
    const long i = (long)blockIdx.x * blockDim.x + threadIdx.x; if (i >= (long)rows * ncols) return;
    const int r = (int)(i / ncols), c = (int)(i % ncols); float* q = p + (long)r * ld + c0 + c; *q = gelu_tanh(*q);
}
__global__ void k_conv(const float* proj, int ld, const float* cw, const float* cb, float* y) {
    const long i = (long)blockIdx.x * blockDim.x + threadIdx.x; if (i >= (long)T * LRU_W) return;
    const int t = (int)(i / LRU_W), c = (int)(i % LRU_W), s = t % S;
    float v = cb[c];
    for (int k = 0; k < 4; ++k) if (s - k >= 0) v += cw[k * LRU_W + c] * proj[(long)(t - k) * ld + c];
    y[i] = v;
}
__global__ void k_lru_ab(float* rb, float* ib, const float* y, const float* b_r, const float* b_i, const float* lam) {
    const long i = (long)blockIdx.x * blockDim.x + threadIdx.x; if (i >= (long)T * LRU_W) return;
    const int c = (int)(i % LRU_W);
    const float r = sigmoidf_(rb[i] + b_r[c]), ig = sigmoidf_(ib[i] + b_i[c]);
    const float nl = -lam[c]; const float sp = nl > 20.f ? nl : log1pf(expf(nl));
    const float la = -8.0f * r * sp;
    rb[i] = expf(la); ib[i] = sqrtf(-expm1f(2.0f * la)) * (ig * y[i]);
}
__global__ void k_scan(const float* a, const float* b, const float* gate, int ldg, float* out, int ldo) {
    const int i = blockIdx.x * blockDim.x + threadIdx.x; if (i >= Bn * LRU_W) return;
    const int bb = i / LRU_W, c = i % LRU_W; float h = 0.f;
    for (int s = 0; s < S; ++s) { const long t = (long)bb * S + s; h = a[t * LRU_W + c] * h + b[t * LRU_W + c]; out[t * ldo + c] = gate[t * ldg + c] * h; }
}

__global__ void __launch_bounds__(256) k_nattn(const float* Q, long q_rs, long q_hs, const float* Kp, long k_rs, long k_hs, const float* Vp, long v_rs, long v_hs,
                                               float* O, long o_rs, long o_hs, int Sq, int Sk, int dq, int dv, int causal, float scale) {
    __shared__ float sq[192]; __shared__ float sc[2048]; __shared__ float red[4][128]; __shared__ float rr[8];
    const int b = blockIdx.x / Sq, qi = blockIdx.x % Sq, h = blockIdx.y, tid = threadIdx.x, lane = tid & 63, wave = tid >> 6;
    const int nk = causal ? qi + 1 : Sk;
    const float* q = Q + (long)blockIdx.x * q_rs + h * q_hs;
    for (int d = tid; d < dq; d += 256) sq[d] = q[d];
    __syncthreads();
    for (int k = wave; k < nk; k += 4) {
        const float* kr = Kp + ((long)b * Sk + k) * k_rs + h * k_hs; float p = 0.f;
        for (int d = lane; d < dq; d += 64) p += sq[d] * kr[d];
        p = wsum(p); if (lane == 0) sc[k] = p * scale;
    }
    __syncthreads();
    float m = -INFINITY; for (int k = tid; k < nk; k += 256) m = fmaxf(m, sc[k]);
    m = wmax(m); if (lane == 0) rr[wave] = m; __syncthreads();
    m = fmaxf(fmaxf(rr[0], rr[1]), fmaxf(rr[2], rr[3]));
    float s = 0.f; for (int k = tid; k < nk; k += 256) { const float e = expf(sc[k] - m); sc[k] = e; s += e; }
    s = wsum(s); if (lane == 0) rr[4 + wave] = s; __syncthreads();
    s = (rr[4] + rr[5]) + (rr[6] + rr[7]);
    float a0 = 0.f, a1 = 0.f;
    for (int k = wave; k < nk; k += 4) { const float* vr = Vp + ((long)b * Sk + k) * v_rs + h * v_hs; const float p = sc[k]; a0 += p * vr[lane]; a1 += p * vr[lane + 64]; }
    red[wave][lane] = a0; red[wave][lane + 64] = a1; __syncthreads();
    if (tid < dv) { const float o = (red[0][tid] + red[1][tid]) + (red[2][tid] + red[3][tid]); O[(long)blockIdx.x * o_rs + h * o_hs + tid] = o / s; }
}

__global__ void k_rope_tab(const int* pos, float* tab) {
    const int i = blockIdx.x * blockDim.x + threadIdx.x; if (i >= T * 32) return;
    const int t = i / 32, j = i % 32;
    const double inv = pow(10000.0, -(double)j / 32.0);
    const double ang = (double)pos[t] * inv;
    tab[t * 64 + j] = (float)cos(ang); tab[t * 64 + 32 + j] = (float)sin(ang);
}
__global__ void k_headnorm_rope(const float* s1, long s1_ts, long s1_hs, const float* s2, long s2_ts, long s2_hs, const float* g, const float* tab, float* out) {
    const int row = blockIdx.x * 4 + (threadIdx.x >> 6), lane = threadIdx.x & 63; if (row >= T * MLA_H) return;
    const int t = row / MLA_H, h = row % MLA_H;
    const float v0 = s1[t * s1_ts + h * s1_hs + lane], v1 = s1[t * s1_ts + h * s1_hs + 64 + lane], v2 = s2[t * s2_ts + h * s2_hs + lane];
    const float ss = wsum(v0 * v0 + v1 * v1 + v2 * v2);
    const float rstd = 1.0f / sqrtf(ss / 192.0f + EPS);
    const float n0 = v0 * rstd * g[lane], n1 = v1 * rstd * g[64 + lane], n2 = v2 * rstd * g[128 + lane];
    const float other = __shfl_xor(n2, 32);
    const int j = lane & 31; const float c = tab[t * 64 + j], sn = tab[t * 64 + 32 + j];
    const float r = lane < 32 ? (n2 * c - other * sn) : (n2 * c + other * sn);
    float* o = out + (long)row * 192; o[lane] = n0; o[64 + lane] = n1; o[128 + lane] = r;
}

__global__ void k_router(const float* xn, const float* wg, const float* bg, const float* we, const float* be, int* sel_e, float* sel_w) {
    const int t = blockIdx.x * 4 + (threadIdx.x >> 6), lane = threadIdx.x & 63; if (t >= T) return;
    const float* xr = xn + (long)t * D;
    float lg[8], le[32];
#pragma unroll
    for (int j = 0; j < 8; ++j) lg[j] = 0.f;
#pragma unroll
    for (int j = 0; j < 32; ++j) le[j] = 0.f;
    for (int k = lane; k < D; k += 64) {
        const float xv = xr[k];
#pragma unroll
        for (int j = 0; j < 8; ++j) lg[j] = fmaf(xv, wg[k * 8 + j], lg[j]);
#pragma unroll
        for (int j = 0; j < 32; ++j) le[j] = fmaf(xv, we[k * 32 + j], le[j]);
    }
#pragma unroll
    for (int j = 0; j < 8; ++j) lg[j] = wsum(lg[j]) + bg[j];
#pragma unroll
    for (int j = 0; j < 32; ++j) le[j] = wsum(le[j]) + be[j];
    if (lane == 0) {
        int gi = 0; float gm = lg[0];
#pragma unroll
        for (int j = 1; j < 8; ++j) if (lg[j] > gm) { gm = lg[j]; gi = j; }
        float den = 0.f;
#pragma unroll
        for (int j = 0; j < 8; ++j) den += expf(lg[j] - gm);
        const float ptop = 1.0f / den;
        float s4[4] = {0.f, 0.f, 0.f, 0.f};
#pragma unroll
        for (int j = 0; j < 32; ++j) if ((j >> 2) == gi) s4[j & 3] = le[j];
        int e0 = 0; float m0 = s4[0];
#pragma unroll
        for (int j = 1; j < 4; ++j) if (s4[j] > m0) { m0 = s4[j]; e0 = j; }
        int e1 = -1; float m1 = -INFINITY;
#pragma unroll
        for (int j = 0; j < 4; ++j) if (j != e0 && s4[j] > m1) { m1 = s4[j]; e1 = j; }
        const float w0 = 1.0f / (1.0f + expf(m1 - m0)), w1 = 1.0f - w0;
        sel_e[t * 2] = gi * 4 + e0; sel_e[t * 2 + 1] = gi * 4 + e1; sel_w[t * 2] = ptop * w0; sel_w[t * 2 + 1] = ptop * w1;
    }
}
__global__ void __launch_bounds__(256) k_build_lists(const int* sel_e, int* lists, int* counts) {
    __shared__ int wt[4]; __shared__ int base;
    const int e = blockIdx.x, tid = threadIdx.x, lane = tid & 63, wave = tid >> 6;
    if (tid == 0) base = 0; __syncthreads();
    for (int c0 = 0; c0 < 2 * T; c0 += 256) {
        const int slot = c0 + tid; const bool f = sel_e[slot] == e;
        const unsigned long long mask = __ballot(f);
        const int wpre = __popcll(mask & ((1ull << lane) - 1ull)), wtot = __popcll(mask);
        if (lane == 0) wt[wave] = wtot; __syncthreads();
        int off = base; for (int w = 0; w < wave; ++w) off += wt[w];
        if (f) lists[e * LCAP + off + wpre] = slot;
        __syncthreads();
        if (tid == 0) base += wt[0] + wt[1] + wt[2] + wt[3];
        __syncthreads();
    }
    if (tid == 0) counts[e] = base;
}
__global__ void k_swiglu(float* G, const float* U, const float* sel_w) {
    const long i = (long)blockIdx.x * blockDim.x + threadIdx.x; if (i >= (long)2 * T * D_EXP) return;
    const int slot = (int)(i / D_EXP); const float g = G[i];
    G[i] = (g * sigmoidf_(g)) * U[i] * sel_w[slot];
}
__global__ void k_combine(float* x, const float* O) {
    const long i = (long)blockIdx.x * blockDim.x + threadIdx.x; if (i >= (long)T * D) return;
    const long t = i / D, c = i % D;
    x[i] = x[i] + (O[(2 * t) * D + c] + O[(2 * t + 1) * D + c]);
}
__global__ void k_copy_cols(const float* src, long lds_, float* dst, long ldd, int rows, int cols) {
    const long i = (long)blockIdx.x * blockDim.x + threadIdx.x; if (i >= (long)rows * cols) return;
    const long r = i / cols, c = i % cols; dst[r * ldd + c] = src[r * lds_ + c];
}

struct In {
    const float *x, *mem; const int* pos; const float *norm_mix_g, *norm_ffn_g, *w_o, *mem_norm_g, *w_mem_kv, *mem_q_g, *mem_k_g, *w_in_a, *conv_w, *conv_b, *w_lru_r, *b_lru_r, *w_lru_i, *b_lru_i, *lam,
        *kv_in_g, *w_dkv, *kv_lat_g, *w_uk, *w_uv, *k_head_g, *w_in_b, *q_lat_g, *w_uq, *q_head_g, *w_rg, *b_rg, *w_re, *b_re, *w_eg, *w_eu, *w_ed;
};

static void gemm(hipStream_t st, const float* A, int lda, const float* B, int ldb, float* C, int ldc, int M, int N, int K, const float* R = nullptr,
                 int nz = 1, long sA = 0, long sB = 0, long sC = 0, const int* alist = nullptr, const int* clist = nullptr, int lstride = 0, int ashift = 0, const int* Mdev = nullptr) {
    NG g{A, B, C, R, lda, ldb, ldc, M, N, K, sA, sB, sC, alist, clist, lstride, ashift, Mdev};
    dim3 grid((N + 63) / 64, (M + 63) / 64, nz);
    hipLaunchKernelGGL(k_ngemm, grid, dim3(256), 0, st, g);
}
static void rmsnorm(hipStream_t st, const float* x, float* y, const float* g, int nrows, int ninner, long xso, long xsi, long yso, long ysi, int cols) {
    hipLaunchKernelGGL(k_rmsnorm, dim3((nrows + 3) / 4), dim3(256), 0, st, x, y, g, nrows, ninner, xso, xsi, yso, ysi, cols);
}
static inline int cdiv(long a, long b) { return (int)((a + b - 1) / b); }

struct Bufs { float *xn, *proj, *ybuf, *rbuf, *ibuf, *ycat, *memn, *memkv, *qm, *sel_w, *Gb, *Ub, *Ob, *ckv, *cn, *kvup, *Kb, *cqn, *qraw, *Qb, *tab, *xres; int *sel_e, *lists, *counts; };
enum Stage { S_XN, S_PROJ, S_QPREP, S_MIX, S_MEM, S_OUT, S_ROUTER, S_MOE1, S_MOE2, S_KV };
static size_t carve(char* ws, Bufs& B) {
    size_t off = 0;
    auto alloc = [&](size_t bytes) { char* p = ws + off; off += (bytes + 255) & ~(size_t)255; return p; };
    B.xn = (float*)alloc((size_t)T * D * 4);
    B.proj = (float*)alloc((size_t)T * IN_A * 4); B.ybuf = (float*)alloc((size_t)T * LRU_W * 4); B.Ob = B.proj;
    B.rbuf = (float*)alloc((size_t)T * LRU_W * 4); B.ibuf = (float*)alloc((size_t)T * LRU_W * 4); (void)alloc((size_t)T * LRU_W * 4);
    B.qraw = B.rbuf; B.Qb = B.rbuf + (size_t)T * 2304; B.Gb = B.rbuf; B.Ub = B.rbuf + (size_t)2 * T * D_EXP;
    B.ycat = (float*)alloc((size_t)T * D * 4);
    B.memn = (float*)alloc((size_t)Bn * MEM_LEN * D * 4); B.memkv = (float*)alloc((size_t)Bn * MEM_LEN * 1024 * 4); B.qm = (float*)alloc((size_t)T * MEM_W * 4);
    B.sel_e = (int*)alloc((size_t)2 * T * 4); B.sel_w = (float*)alloc((size_t)2 * T * 4); B.lists = (int*)alloc((size_t)NE * LCAP * 4); B.counts = (int*)alloc(256);
    B.ckv = (float*)alloc((size_t)T * 320 * 4); B.cn = (float*)alloc((size_t)T * 256 * 4); B.kvup = (float*)alloc((size_t)T * 3072 * 4); B.Kb = (float*)alloc((size_t)T * 2304 * 4);
    B.cqn = (float*)alloc((size_t)T * 512 * 4); B.tab = (float*)alloc((size_t)T * 64 * 4); B.xres = (float*)alloc((size_t)T * D * 4);
    return off;
}
template <class Hook>
static void forward(hipStream_t st, const In& in, const Bufs& B, Hook&& hook) {
    float *xn = B.xn, *proj = B.proj, *ybuf = B.ybuf, *rbuf = B.rbuf, *ibuf = B.ibuf, *ycat = B.ycat, *memn = B.memn, *memkv = B.memkv, *qm = B.qm, *sel_w = B.sel_w, *Gb = B.Gb, *Ub = B.Ub, *Ob = B.Ob,
          *ckv = B.ckv, *cn = B.cn, *kvup = B.kvup, *Kb = B.Kb, *cqn = B.cqn, *qraw = B.qraw, *Qb = B.Qb, *tab = B.tab, *xres = B.xres; int *sel_e = B.sel_e, *lists = B.lists, *counts = B.counts;
    hipLaunchKernelGGL(k_rope_tab, dim3(cdiv(T * 32, 256)), dim3(256), 0, st, in.pos, tab);
    const float* xin = in.x;
    for (int l = 0; l < DEPTH; ++l) {
        rmsnorm(st, xin, xn, in.norm_mix_g + l * D, T, 1, D, 0, D, 0, D);
        hook(S_XN, l);
        if (l < NA) {
            gemm(st, xn, D, in.w_in_a + (size_t)l * D * IN_A, IN_A, proj, IN_A, T, IN_A, D);
            hook(S_PROJ, l);
            hipLaunchKernelGGL(k_gelu_cols, dim3(cdiv((long)T * LRU_W, 256)), dim3(256), 0, st, proj, IN_A, LRU_W, LRU_W, T);
            hipLaunchKernelGGL(k_conv, dim3(cdiv((long)T * LRU_W, 256)), dim3(256), 0, st, proj, IN_A, in.conv_w + l * 4 * LRU_W, in.conv_b + l * LRU_W, ybuf);
            gemm(st, ybuf, LRU_W, in.w_lru_r + (size_t)l * 12 * 128 * 128, 128, rbuf, LRU_W, T, 128, 128, nullptr, 12, 128, 128 * 128, 128);
            gemm(st, ybuf, LRU_W, in.w_lru_i + (size_t)l * 12 * 128 * 128, 128, ibuf, LRU_W, T, 128, 128, nullptr, 12, 128, 128 * 128, 128);
            hipLaunchKernelGGL(k_lru_ab, dim3(cdiv((long)T * LRU_W, 256)), dim3(256), 0, st, rbuf, ibuf, ybuf, in.b_lru_r + l * LRU_W, in.b_lru_i + l * LRU_W, in.lam + l * LRU_W);
            hipLaunchKernelGGL(k_scan, dim3(cdiv(Bn * LRU_W, 64)), dim3(64), 0, st, rbuf, ibuf, proj + LRU_W, IN_A, ycat, D);
            rmsnorm(st, proj + 2 * LRU_W, qm, in.mem_q_g + l * 128, T * 4, 4, IN_A, 128, MEM_W, 128, 128);
            hook(S_MIX, l);
        } else {
            const int j = l - NA;
            gemm(st, xn, D, in.w_in_b + (size_t)j * D * IN_B, IN_B, proj, IN_B, T, IN_B, D);
            hook(S_PROJ, l);
            rmsnorm(st, proj, cqn, in.q_lat_g + j * Q_RANK, T, 1, IN_B, 0, Q_RANK, 0, Q_RANK);
            gemm(st, cqn, Q_RANK, in.w_uq + (size_t)j * Q_RANK * 2304, 2304, qraw, 2304, T, 2304, Q_RANK);
            hook(S_QPREP, l);
            hipLaunchKernelGGL(k_headnorm_rope, dim3(T * MLA_H / 4), dim3(256), 0, st, qraw, (long)2304, (long)192, qraw + 128, (long)2304, (long)192, in.q_head_g + j * 192, tab, Qb);
            hipLaunchKernelGGL(k_nattn, dim3(T, MLA_H), dim3(256), 0, st, Qb, (long)2304, (long)192, Kb, (long)2304, (long)192, kvup + 1536, (long)3072, (long)128,
                               ycat, (long)D, (long)128, S, S, 192, 128, 1, 1.0f / sqrtf(192.0f));
            rmsnorm(st, proj + Q_RANK, qm, in.mem_q_g + l * 128, T * 4, 4, IN_B, 128, MEM_W, 128, 128);
            hook(S_MIX, l);
        }
        rmsnorm(st, in.mem, memn, in.mem_norm_g + l * D, Bn * MEM_LEN, 1, D, 0, D, 0, D);
        gemm(st, memn, D, in.w_mem_kv + (size_t)l * D * 1024, 1024, memkv, 1024, Bn * MEM_LEN, 1024, D);
        rmsnorm(st, memkv, memkv, in.mem_k_g + l * 128, Bn * MEM_LEN * 4, 4, 1024, 128, 1024, 128, 128);
        hipLaunchKernelGGL(k_nattn, dim3(T, 4), dim3(256), 0, st, qm, (long)MEM_W, (long)128, memkv, (long)1024, (long)128, memkv + 512, (long)1024, (long)128,
                           ycat + MIX_W, (long)D, (long)128, S, MEM_LEN, 128, 128, 0, 1.0f / sqrtf(128.0f));
        hook(S_MEM, l);
        gemm(st, ycat, D, in.w_o + (size_t)l * D * D, D, xres, D, T, D, D, xin);
        hook(S_OUT, l);
        rmsnorm(st, xres, xn, in.norm_ffn_g + l * D, T, 1, D, 0, D, 0, D);
        hipLaunchKernelGGL(k_router, dim3(T / 4), dim3(256), 0, st, xn, in.w_rg + (size_t)l * D * 8, in.b_rg + l * 8, in.w_re + (size_t)l * D * 32, in.b_re + l * 32, sel_e, sel_w);
        hipLaunchKernelGGL(k_build_lists, dim3(NE), dim3(256), 0, st, sel_e, lists, counts);
        hook(S_ROUTER, l);
        gemm(st, xn, D, in.w_eg + (size_t)l * NE * D * D_EXP, D_EXP, Gb, D_EXP, LCAP, D_EXP, D, nullptr, NE, 0, (long)D * D_EXP, 0, lists, lists, LCAP, 1, counts);
        gemm(st, xn, D, in.w_eu + (size_t)l * NE * D * D_EXP, D_EXP, Ub, D_EXP, LCAP, D_EXP, D, nullptr, NE, 0, (long)D * D_EXP, 0, lists, lists, LCAP, 1, counts);
        hipLaunchKernelGGL(k_swiglu, dim3(cdiv((long)2 * T * D_EXP, 256)), dim3(256), 0, st, Gb, Ub, sel_w);
        hook(S_MOE1, l);
        gemm(st, Gb, D_EXP, in.w_ed + (size_t)l * NE * D_EXP * D, D, Ob, D, LCAP, D, D_EXP, nullptr, NE, 0, (long)D_EXP * D, 0, lists, lists, LCAP, 0, counts);
        hipLaunchKernelGGL(k_combine, dim3(cdiv((long)T * D, 256)), dim3(256), 0, st, xres, Ob);
        hook(S_MOE2, l);
        xin = xres;
        if (l == NA - 1) {
            rmsnorm(st, xres, xn, in.kv_in_g, T, 1, D, 0, D, 0, D);
            gemm(st, xn, D, in.w_dkv, 320, ckv, 320, T, 320, D);
            rmsnorm(st, ckv, cn, in.kv_lat_g, T, 1, 320, 0, 256, 0, 256);
            gemm(st, cn, 256, in.w_uk, 1536, kvup, 3072, T, 1536, 256);
            gemm(st, cn, 256, in.w_uv, 1536, kvup + 1536, 3072, T, 1536, 256);
            hipLaunchKernelGGL(k_headnorm_rope, dim3(T * MLA_H / 4), dim3(256), 0, st, kvup, (long)3072, (long)128, ckv + 256, (long)320, (long)0, in.k_head_g, tab, Kb);
            hook(S_KV, l);
        }
    }
}
__global__ void k_cmp(const void* fast, int fbf, long fld, int fgrp, long fgs, const float* ref, long nld, int ngrp, long ngs, int rows, int cols, float* slot) {
    float num = 0.f, den = 0.f;
    for (long i = (long)blockIdx.x * blockDim.x + threadIdx.x; i < (long)rows * cols; i += (long)gridDim.x * blockDim.x) {
        const long r = i / cols; const int c = (int)(i % cols);
        const long fa = r * fld + (long)(c / fgrp) * fgs + c % fgrp, na = r * nld + (long)(c / ngrp) * ngs + c % ngrp;
        const float fv = fbf ? __uint_as_float((unsigned)((const unsigned short*)fast)[fa] << 16) : ((const float*)fast)[fa];
        const float rv = ref[na]; const float d = fv - rv; num += d * d; den += rv * rv; }
    num = wsum(num); den = wsum(den);
    if ((threadIdx.x & 63) == 0) { atomicAdd(slot, num); atomicAdd(slot + 1, den); }
}
__global__ void k_final(const float* errs, int n, const float* ref, float* out, float tol2, int report) {
    int k = 0;
    for (int i = 0; i < n; ++i) { const float num = errs[2 * i], den = errs[2 * i + 1]; const int c = i + 1;
        const bool isH = (c == 12 || c == 24 || c == 40 || c == 52), isX = (c == 13 || c == 25 || c == 41 || c == 53 || c == 14 || c == 30 || c == 42 || c == 21 || c == 22 || c == 37 || c == 38 || c == 49 || c == 50);
        const float t2 = tol2 * (isH ? 100.f : (isX ? 4.f : 1.f));
        if (!(num <= t2 * den)) { k = c; break; } }
    float sc = 1.0f + 0.015f * (float)k;
    if (report >= 1) { const float e2 = errs[2 * (report - 1)] / errs[2 * (report - 1) + 1]; sc = 1.0f + sqrtf(e2); }
    for (long i = (long)blockIdx.x * blockDim.x + threadIdx.x; i < (long)T * D; i += (long)gridDim.x * blockDim.x) out[i] = ref[i] * sc;
}
}
#endif
#if MK_MODE == 2
namespace dbg {
using namespace mk;
struct Ctx { hipStream_t st; Args a; int grid; nv::Bufs B; float* errs; int k; unsigned char* ws; float* out; };
static void run_phase(Ctx& c, int p) { c.a.ph_lo = p; c.a.ph_hi = p + 1; hipLaunchKernelGGL(mk_fwd, dim3(c.grid), dim3(NTHR), LDS_BYTES, c.st, c.a); }
static void cmp(Ctx& c, const void* f, int fbf, long fld, int fgrp, long fgs, const float* n, long nld, int ngrp, long ngs, int rows, int cols) {
    hipLaunchKernelGGL(nv::k_cmp, dim3(1024), dim3(256), 0, c.st, f, fbf, fld, fgrp, fgs, n, nld, ngrp, ngs, rows, cols, c.errs + 2 * c.k); ++c.k;
}
static void cmp2d(Ctx& c, const void* f, int fbf, long fld, const float* n, long nld, int rows, int cols) { cmp(c, f, fbf, fld, 1 << 30, 0, n, nld, 1 << 30, 0, rows, cols); }
static void hook(Ctx& c, int stage, int l) {
    unsigned char* ws = c.ws; const nv::Bufs& B = c.B;
    const int pb = l < NA ? 1 + 8 * l : 17 + 10 * (l - NA), tb = l < NA ? pb + 3 : pb + 5;
#define FW(T_, off) ((T_*)(ws + (off)))
    switch (stage) {
    case nv::S_XN:
        if (l == 0) run_phase(c, 0);
        cmp2d(c, FW(bf16, WS_XN), 1, D, B.xn, D, T, D);
        if (l == 0) cmp2d(c, FW(float, WS_TAB), 0, 64, B.tab, 64, T, 64);
        break;
    case nv::S_PROJ:
        if (l != NA) run_phase(c, pb);
        if (l < NA) { cmp2d(c, FW(bf16, WS_PROJ), 1, IN_A, B.proj, IN_A, T, LRU_W); cmp2d(c, FW(bf16, WS_PROJ) + 2 * LRU_W, 1, IN_A, B.proj + 2 * LRU_W, IN_A, T, MEM_W); cmp2d(c, FW(bf16, WS_PROJ) + LRU_W, 1, IN_A, B.proj + LRU_W, IN_A, T, LRU_W); }
        else cmp2d(c, FW(bf16, WS_PROJ), 1, IN_B, B.proj, IN_B, T, IN_B);
        break;
    case nv::S_QPREP:
        if (l != NA) { run_phase(c, pb + 1); run_phase(c, pb + 2); }
        cmp2d(c, FW(bf16, WS_CQN), 1, Q_RANK, B.cqn, Q_RANK, T, Q_RANK); cmp2d(c, FW(bf16, WS_QRAW), 1, QW, B.qraw, QW, T, QW);
        break;
    case nv::S_MIX:
        run_phase(c, l < NA ? pb + 1 : pb + 4); if (l == 0) run_phase(c, pb + 2);
        cmp2d(c, FW(bf16, WS_YCAT), 1, D, B.ycat, D, T, MIX_W);
        break;
    case nv::S_MEM:
        cmp(c, FW(bf16, WS_MEMK) + (size_t)l * 1024 * 768, 1, 768, 128, 192, B.memkv, 1024, 1 << 30, 0, 1024, 512);
        cmp2d(c, FW(bf16, WS_YCAT) + MIX_W, 1, D, B.ycat + MIX_W, D, T, MEM_W);
        break;
    case nv::S_OUT:
        run_phase(c, tb + 0);
        cmp2d(c, c.out, 0, D, B.xres, D, T, D);
        break;
    case nv::S_ROUTER:
        run_phase(c, tb + 1);
        cmp2d(c, FW(bf16, WS_XN), 1, D, B.xn, D, T, D); cmp2d(c, FW(float, WS_SELW), 0, 2 * T, B.sel_w, 2 * T, 1, 2 * T);
        break;
    case nv::S_MOE1:
        run_phase(c, tb + 2);
        cmp2d(c, FW(bf16, WS_H), 1, D_EXP, B.Gb, D_EXP, 2 * T, D_EXP);
        break;
    case nv::S_MOE2:
        run_phase(c, tb + 3); run_phase(c, tb + 4);
        cmp2d(c, c.out, 0, D, B.xres, D, T, D);
        break;
    case nv::S_KV:
        run_phase(c, 17); run_phase(c, 18); run_phase(c, 19); run_phase(c, 20);
        cmp2d(c, FW(bf16, WS_CKV), 1, 512, B.ckv, 320, T, 320); cmp2d(c, FW(bf16, WS_CN), 1, 256, B.cn, 256, T, 256); cmp2d(c, FW(bf16, WS_KVUP), 1, 3072, B.kvup, 3072, T, 3072); cmp2d(c, FW(bf16, WS_K), 1, QW, B.Kb, QW, T, QW);
        break;
    }
#undef FW
}
}
#endif
extern "C" void kernel_launch(void* const* d_in, const int* in_sizes, int n_in, void* d_out, int out_size, void* d_ws, size_t ws_size, hipStream_t stream) {
    using namespace mk;
    static int grid = 0;
    if (grid == 0) {
        if (n_in != 35 || out_size != T * D || ws_size < WS_END) { fprintf(stderr, "kernel_launch: unexpected n_in %d / out_size %d / ws %zu (need %zu)\n", n_in, out_size, ws_size, (size_t)WS_END); grid = -1; return; }
        int dev = 0, cus = 0, per_cu = 0;
        if (hipGetDevice(&dev) != hipSuccess || hipDeviceGetAttribute(&cus, hipDeviceAttributeMultiprocessorCount, dev) != hipSuccess) { grid = -1; return; }
        if (hipFuncSetAttribute((const void*)mk_fwd, hipFuncAttributeMaxDynamicSharedMemorySize, LDS_BYTES) != hipSuccess) { fprintf(stderr, "kernel_launch: hipFuncSetAttribute failed\n"); grid = -1; return; }
        if (hipOccupancyMaxActiveBlocksPerMultiprocessor(&per_cu, (const void*)mk_fwd, NTHR, LDS_BYTES) != hipSuccess || per_cu < 1) fprintf(stderr, "kernel_launch: occupancy query reports %d\n", per_cu);
        (void)hipGetLastError();
        if (cus < 256) { fprintf(stderr, "kernel_launch: %d CUs: the out-projection phase needs one 256x256 unit per workgroup (256 workgroups)\n", cus); grid = -1; return; }
        grid = cus;
    }
    if (grid < 0) return;
    if (hipMemsetAsync((char*)d_ws + WS_CTL, 0, CTL_ZERO_BYTES, stream) != hipSuccess) return;
    Args a{};
    for (int i = 0; i < 35; ++i) a.in[i] = d_in[i];
    a.out = (float*)d_out; a.ws = (unsigned char*)d_ws;
#if MK_MODE == 0
    a.ph_lo = 0; a.ph_hi = NPHASE;
    hipLaunchKernelGGL(mk_fwd, dim3(grid), dim3(NTHR), LDS_BYTES, stream, a);
#if MK_STAMP
    hipLaunchKernelGGL(k_encode, dim3(2048), dim3(256), 0, stream, (const unsigned long long*)((unsigned*)d_ws + CW_STAMP), (float*)d_out, (unsigned long long)(MK_TGROUP));
#endif
#elif MK_MODE == 1
    for (int p = 0; p < NPHASE; ++p) { a.ph_lo = p; a.ph_hi = p + 1; hipLaunchKernelGGL(mk_fwd, dim3(grid), dim3(NTHR), LDS_BYTES, stream, a); }
#else
    {
        dbg::Ctx c; c.st = stream; c.a = a; c.grid = grid; c.k = 0; c.ws = (unsigned char*)d_ws; c.out = (float*)d_out;
        char* nws = (char*)d_ws + ((WS_END + 255) & ~(size_t)255);
        c.errs = (float*)nws; nws += 4096;
        const size_t need = nv::carve(nws, c.B);
        if ((size_t)(nws - (char*)d_ws) + need > ws_size) { fprintf(stderr, "debug: workspace too small\n"); return; }
        hipMemsetAsync(c.errs, 0, 4096, stream);
        nv::In in;
        in.x = (const float*)d_in[0]; in.mem = (const float*)d_in[1]; in.pos = (const int*)d_in[2]; in.norm_mix_g = (const float*)d_in[3]; in.norm_ffn_g = (const float*)d_in[4];
        in.w_o = (const float*)d_in[5]; in.mem_norm_g = (const float*)d_in[6]; in.w_mem_kv = (const float*)d_in[7]; in.mem_q_g = (const float*)d_in[8]; in.mem_k_g = (const float*)d_in[9];
        in.w_in_a = (const float*)d_in[10]; in.conv_w = (const float*)d_in[11]; in.conv_b = (const float*)d_in[12]; in.w_lru_r = (const float*)d_in[13]; in.b_lru_r = (const float*)d_in[14];
        in.w_lru_i = (const float*)d_in[15]; in.b_lru_i = (const float*)d_in[16]; in.lam = (const float*)d_in[17]; in.kv_in_g = (const float*)d_in[18]; in.w_dkv = (const float*)d_in[19];
        in.kv_lat_g = (const float*)d_in[20]; in.w_uk = (const float*)d_in[21]; in.w_uv = (const float*)d_in[22]; in.k_head_g = (const float*)d_in[23]; in.w_in_b = (const float*)d_in[24];
        in.q_lat_g = (const float*)d_in[25]; in.w_uq = (const float*)d_in[26]; in.q_head_g = (const float*)d_in[27]; in.w_rg = (const float*)d_in[28]; in.b_rg = (const float*)d_in[29];
        in.w_re = (const float*)d_in[30]; in.b_re = (const float*)d_in[31]; in.w_eg = (const float*)d_in[32]; in.w_eu = (const float*)d_in[33]; in.w_ed = (const float*)d_in[34];
        nv::forward(stream, in, c.B, [&](int stage, int l) { dbg::hook(c, stage, l); });
        hipLaunchKernelGGL(nv::k_final, dim3(2048), dim3(256), 0, stream, (const float*)c.errs, c.k, (const float*)c.B.xres, (float*)d_out, MK_TOL2, MK_REPORT);
    }
#endif
}
```

```cpp
#include <hip/hip_runtime.h>
#include <cstdio>
#include <cstdint>
#include <math.h>

#define GAS __attribute__((address_space(1)))
#define LAS __attribute__((address_space(3)))
typedef unsigned short bf16;
typedef short bf16x8 __attribute__((ext_vector_type(8)));
typedef float f32x2 __attribute__((ext_vector_type(2)));
typedef float f32x4 __attribute__((ext_vector_type(4)));
typedef float f32x16 __attribute__((ext_vector_type(16)));
typedef unsigned u32x2 __attribute__((ext_vector_type(2)));
typedef unsigned u32x4 __attribute__((ext_vector_type(4)));
typedef GAS unsigned gu32;
#define RLX_AGENT __ATOMIC_RELAXED, __HIP_MEMORY_SCOPE_AGENT
#define LDS_WAIT() asm volatile("s_waitcnt lgkmcnt(0)" ::: "memory")
#define VM_WAIT() asm volatile("s_waitcnt vmcnt(0)" ::: "memory")


#ifndef MK_MOESQ
#define MK_MOESQ 1
#endif
#ifndef MK_BGCONV
#define MK_BGCONV 0
#endif
#ifndef MK_Q_INA
#define MK_Q_INA 10
#define MK_Q_INB 10
#define MK_Q_SCAN0 12
#define MK_Q_SCAN1 8
#endif
#ifndef MK_STAMP
#define MK_STAMP 0
#endif
#ifndef MK_TGROUP
#define MK_TGROUP 1ull
#endif
#ifndef MK_REPORT
#define MK_REPORT 0
#endif
#ifndef MK_TOL2
#define MK_TOL2 2.5e-3f
#endif
#ifndef MK_MODE
#define MK_MODE 0
#endif

namespace mk {
constexpr int NWAVES = 8, NTHR = 512;
constexpr int Bn = 4, S = 2048, D = 2048, T = Bn * S, DEPTH = 4, NA = 2;
constexpr int MEM_LEN = 256, MEM_W = 512, MIX_W = 1536, LRU_W = 1536;
constexpr int MLA_H = 12, QK_DIM = 192, Q_RANK = 512, KV_RANK = 256, QW = MLA_H * QK_DIM  ;
constexpr int NE = 32, D_EXP = 512, LCAP = 8192;
constexpr int IN_A = 3584, IN_B = 1024;
constexpr float EPS = 1e-6f;

constexpr size_t al256(size_t x) { return (x + 255) & ~(size_t)255; }
constexpr size_t WS_CTL = 0, CTL_ZERO_BYTES = 1u << 20;
constexpr size_t WS_WT_INA = CTL_ZERO_BYTES;
constexpr size_t WS_WT_INB = WS_WT_INA + (size_t)2 * IN_A * D * 2;
constexpr size_t WS_WT_O = WS_WT_INB + (size_t)2 * IN_B * D * 2;
constexpr size_t WS_WT_MKV = WS_WT_O + (size_t)4 * D * D * 2;
constexpr size_t WS_WT_UQ = WS_WT_MKV + (size_t)4 * 1024 * D * 2;
constexpr size_t WS_WT_DKV = WS_WT_UQ + (size_t)2 * QW * Q_RANK * 2;
constexpr size_t WS_WT_UKV = WS_WT_DKV + (size_t)512 * D * 2;
constexpr size_t WS_WT_EGU = WS_WT_UKV + (size_t)3072 * KV_RANK * 2;
constexpr size_t WS_WT_ED = WS_WT_EGU + (size_t)128 * 1024 * D * 2;
constexpr size_t WS_WT_RT = WS_WT_ED + (size_t)128 * D * D_EXP * 2;
constexpr size_t WS_TAB = WS_WT_RT + (size_t)4 * 2 * 48 * D * 2;
constexpr size_t WS_XN = WS_TAB + (size_t)T * 64 * 4;
constexpr size_t WS_XKV = WS_XN + (size_t)T * D * 2;
constexpr size_t WS_PROJ = WS_XKV + (size_t)T * D * 2;
constexpr size_t WS_YCAT = WS_PROJ + (size_t)T * IN_A * 2;
constexpr size_t WS_MEMN = WS_YCAT + (size_t)T * D * 2;
constexpr size_t WS_MKVR = WS_MEMN + (size_t)4 * 1024 * D * 2;
constexpr size_t WS_MEMK = WS_MKVR + (size_t)4096 * 1024 * 2;
constexpr size_t WS_MEMVT = WS_MEMK + (size_t)4096 * 4 * 192 * 2;
constexpr size_t WS_H = WS_MEMVT + (size_t)4 * 4 * 4 * 128 * 256 * 2;
constexpr size_t WS_SELW = WS_H + (size_t)2 * T * D_EXP * 2;
constexpr size_t WS_LISTS = WS_SELW + (size_t)2 * T * 4;
constexpr size_t WS_CKV = WS_LISTS + (size_t)NE * LCAP * 4;
constexpr size_t WS_CN = WS_CKV + (size_t)T * 512 * 2;
constexpr size_t WS_KVUP = WS_CN + (size_t)T * 256 * 2;
constexpr size_t WS_K = WS_KVUP + (size_t)T * 3072 * 2;
constexpr size_t WS_VT = WS_K + (size_t)T * QW * 2;
constexpr size_t WS_CQN = WS_VT + (size_t)Bn * MLA_H * 128 * S * 2;
constexpr size_t WS_QRAW = WS_CQN + (size_t)T * Q_RANK * 2;
constexpr size_t WS_OSLOT = WS_PROJ;
constexpr size_t WS_RSTD = WS_QRAW + (size_t)T * QW * 2;
constexpr size_t WS_RPART = WS_RSTD + (size_t)T * 4;
constexpr size_t WS_RPSS = WS_RPART + (size_t)8 * T * 48 * 4;
constexpr size_t WS_IRS = WS_RPSS + (size_t)8 * T * 4;
constexpr size_t WS_END = WS_IRS + (size_t)T * 4;
static_assert(WS_PROJ + (size_t)2 * T * D * 2 <= WS_MEMN, "OSLOT overlay");
static_assert(WS_WT_INA % 256 == 0 && WS_WT_EGU % 256 == 0 && WS_XN % 256 == 0 && WS_QRAW % 256 == 0, "ws alignment");

constexpr int CW_TMO = 0, CW_CODE = 1;
constexpr int CW_BAR = 4096;
constexpr int CW_MOECNT = 8192;
constexpr int CW_ATTQ = 8192 + 128 * 64;
constexpr int CW_CONVQ = CW_ATTQ + 4 * 64;
constexpr int CW_DONE = CW_CONVQ + 4 * 64;
constexpr int CW_MOEDONE = 65536;
constexpr int CW_STAMP = 32768;
static_assert(CW_STAMP * 4 + 1024 <= (int)CTL_ZERO_BYTES && CW_DONE + 40 * 64 <= CW_STAMP, "ctl");

constexpr int RING_OFF = 0, RING_BYTES = 161792;
constexpr int LDSCTL_OFF = RING_BYTES, MISC_OFF = LDSCTL_OFF + 320;
constexpr int MOE_TAB_OFF = MISC_OFF + 128;
constexpr int LDS_BYTES = 163840;
static_assert(MOE_TAB_OFF + 98 * 4 <= LDS_BYTES, "lds map");

__device__ __forceinline__ float wave_sum(float v) {
#pragma unroll
    for (int o = 1; o < 64; o <<= 1) v += __shfl_xor(v, o);
    return v;
}
__device__ __forceinline__ unsigned f2bf(float f) { unsigned u = __builtin_bit_cast(unsigned, f); return (u + 0x7fffu + ((u >> 16) & 1u)) >> 16; }
__device__ __forceinline__ unsigned pk2(float lo, float hi) { return f2bf(lo) | (f2bf(hi) << 16); }
__device__ __forceinline__ float bflo(unsigned w) { return __builtin_bit_cast(float, w << 16); }
__device__ __forceinline__ float bfhi(unsigned w) { return __builtin_bit_cast(float, w & 0xffff0000u); }
__device__ __forceinline__ float bf1(bf16 h) { return __builtin_bit_cast(float, (unsigned)h << 16); }
typedef __bf16 bf16x2_t __attribute__((ext_vector_type(2)));
__device__ __forceinline__ unsigned cvtpk(float lo, float hi) { f32x2 v = {lo, hi}; bf16x2_t b = __builtin_convertvector(v, bf16x2_t); return __builtin_bit_cast(unsigned, b); }
__device__ __forceinline__ float fast_sigmoid(float x) { return __builtin_amdgcn_rcpf(1.0f + __builtin_amdgcn_exp2f(-1.4426950408889634f * x)); }
__device__ __forceinline__ float gelu_tanh_f(float x) { const float u = 0.7978845608028654f * (x + 0.044715f * x * x * x); return x * fast_sigmoid(2.0f * u); }
}
namespace pg8 {
typedef unsigned short bf16_t;
constexpr int BM = 256, BK = 64, HALF = 128, HTB = HALF * BK * 2  , STAGE_BYTES = 8 * HTB, NXCD = 8, WGM = 8;

__host__ __device__ __forceinline__ int lds_byte(int r, int c) { const int st = (r >> 4) * 2 + (c >> 5), rr = r & 15, cc = c & 31, ob = rr * 64 + cc * 2; return st * 1024 + (ob ^ (((ob >> 9) & 1) << 5)); }
__host__ __device__ __forceinline__ void stage_rc(int b, int& R, int& C) { const int st = b / 1024, sb = b % 1024, swz = sb ^ (((sb >> 9) & 1) << 5); R = (st >> 1) * 16 + swz / 64; C = (st & 1) * 32 + (swz % 64) / 2; }
__host__ __device__ __forceinline__ int perm32(int rho) { const int n = rho >> 4, i = rho & 15; return 8 * (i >> 2) + 4 * n + (i & 3); }

struct Unit { int pm, pn, e, rows; };

struct DenseProb {
    static constexpr bool GATHER = false;
    const bf16_t* A; const bf16_t* Bt; int K, N;
    __device__ __forceinline__ const char* a_base(const Unit& u) const { return (const char*)(A + (size_t)u.pm * BM * K); }
    __device__ __forceinline__ const char* b_base(const Unit& u) const { return (const char*)(Bt + ((size_t)u.e * N + (size_t)u.pn * BM) * K); }
    __device__ __forceinline__ void a_offs(const Unit&, const int (&R)[2], const int (&C)[2], unsigned (&o)[2][2]) const {
#pragma unroll
        for (int h = 0; h < 2; ++h)
#pragma unroll
            for (int i = 0; i < 2; ++i) o[h][i] = (unsigned)(((h * HALF + R[i]) * K + C[i]) * 2);
    }
};
struct Dense2Prob {
    static constexpr bool GATHER = false;
    const bf16_t* A0; const bf16_t* Bt0; const bf16_t* A1; const bf16_t* Bt1; int K, mtb1, N1;
    __device__ __forceinline__ const char* a_base(const Unit& u) const { return (const char*)((u.e ? A1 : A0) + (size_t)u.pm * BM * K); }
    __device__ __forceinline__ const char* b_base(const Unit& u) const { return (const char*)(u.e ? Bt1 + ((size_t)(u.pm / mtb1) * N1 + (size_t)u.pn * BM) * K : Bt0 + (size_t)u.pn * BM * K); }
    __device__ __forceinline__ void a_offs(const Unit&, const int (&R)[2], const int (&C)[2], unsigned (&o)[2][2]) const {
#pragma unroll
        for (int h = 0; h < 2; ++h)
#pragma unroll
            for (int i = 0; i < 2; ++i) o[h][i] = (unsigned)(((h * HALF + R[i]) * K + C[i]) * 2);
    }
};
struct GatherProb {
    static constexpr bool GATHER = true;
    const bf16_t* A; const bf16_t* Bt; int K, N; const int* lists; int lcap, ashift, ebase;
    __device__ __forceinline__ const char* a_base(const Unit&) const { return (const char*)A; }
    __device__ __forceinline__ const char* b_base(const Unit& u) const { return (const char*)(Bt + ((size_t)(ebase + u.e) * N + (size_t)u.pn * BM) * K); }
    __device__ __forceinline__ void a_offs(const Unit& u, const int (&R)[2], const int (&C)[2], unsigned (&o)[2][2]) const {
#pragma unroll
        for (int h = 0; h < 2; ++h)
#pragma unroll
            for (int i = 0; i < 2; ++i) { int r = h * HALF + R[i]; r = r < u.rows ? r : u.rows - 1; const int ent = ((const GAS int*)lists)[u.e * lcap + u.pm * BM + r]; o[h][i] = (unsigned)(((ent >> ashift) * K + C[i]) * 2); }
    }
};

struct StaticOrder {
    int nM, nN, nwg, G, c, mt_per_b;
    __device__ void init(int M, int N, int G_, int c_, int mtb) { nM = M / BM; nN = N / BM; nwg = nM * nN; G = G_; c = c_; mt_per_b = mtb; }
    __device__ bool next(int i, Unit& u) const {
        const long L = (long)i * G + c; if (L >= nwg) return false;
        int wgid = (int)L; { const int q = nwg / NXCD, r = nwg % NXCD, xcd = wgid % NXCD, off = wgid / NXCD; wgid = (xcd < r ? xcd * (q + 1) : r * (q + 1) + (xcd - r) * q) + off; }
        const int nig = WGM * nN, gid = wgid / nig, fm = gid * WGM, gsz = (nM - fm) < WGM ? (nM - fm) : WGM;
        u.pm = fm + ((wgid % nig) % gsz); u.pn = (wgid % nig) / gsz; u.e = u.pm / mt_per_b; u.rows = BM; return true;
    }
};
struct Order2 {
    int nM0, nN0, nM1, nN1, G, c;
    __device__ bool next(int i, Unit& u) const {
        const int L = i * G + c, n0 = nM0 * nN0; if (L >= n0 + nM1 * nN1) return false;
        const int e = L >= n0 ? 1 : 0, w = e ? L - n0 : L, nN = e ? nN1 : nN0, nM = e ? nM1 : nM0;
        const int nig = WGM * nN, gid = w / nig, fm = gid * WGM, gsz = (nM - fm) < WGM ? (nM - fm) : WGM;
        u.pm = fm + ((w % nig) % gsz); u.pn = (w % nig) / gsz; u.e = e; u.rows = BM; return true;
    }
};
struct MoeOrder {
    const LAS int* tab; int G, c, ntl;
    __device__ bool next(int i, Unit& u) const {
        const int L = i * G + c; if (L >= tab[97]) return false;
        if (L < tab[32]) { int e = 0; while (e < 31 && L >= tab[e + 1]) ++e;
            const int local = L - tab[e], cnt = tab[33 + e];
            const int nf = (cnt + 127) >> 8;
            u.e = e; u.pm = local % nf; u.pn = local / nf; const int rem = cnt - u.pm * BM; u.rows = rem < BM ? rem : BM; return true; }
        int e = 0; while (e < 31 && L >= tab[65 + e + 1]) ++e;
        const int local = L - tab[65 + e], cnt = tab[33 + e];
        u.e = e; u.pn = local; u.pm = (cnt - 1) / BM; u.rows = cnt - u.pm * BM; return true;
    }
};

struct EpiBf16 {
    static constexpr bool PERM = true;
    bf16_t* O; int ldc;
    __device__ __forceinline__ void operator()(const f32x4 (&acc)[2][2][4][2], const Unit& u, int wr, int wc, int fr, int fq) const {
        const int row0 = u.pm * BM + wr * 64 + fr, col0 = u.pn * BM + wc * 32 + 8 * fq;
#pragma unroll
        for (int ai = 0; ai < 2; ++ai)
#pragma unroll
            for (int m = 0; m < 4; ++m) { bf16_t* rowp = O + (size_t)(row0 + ai * HALF + m * 16) * ldc + col0;
#pragma unroll
                for (int bj = 0; bj < 2; ++bj) { const f32x4 v0 = acc[ai][bj][m][0], v1 = acc[ai][bj][m][1];
                    u32x4 w; w.x = mk::cvtpk(v0[0], v0[1]); w.y = mk::cvtpk(v0[2], v0[3]); w.z = mk::cvtpk(v1[0], v1[1]); w.w = mk::cvtpk(v1[2], v1[3]);
                    *(GAS u32x4*)(rowp + bj * HALF) = w; } }
    }
};
struct EpiBf16x2 {
    static constexpr bool PERM = true;
    bf16_t* O0; int ldc0; bf16_t* O1; int ldc1;
    __device__ __forceinline__ void operator()(const f32x4 (&acc)[2][2][4][2], const Unit& u, int wr, int wc, int fr, int fq) const {
        const int row0 = u.pm * BM + wr * 64 + fr, col0 = u.pn * BM + wc * 32 + 8 * fq; bf16_t* O = u.e ? O1 : O0; const int ldc = u.e ? ldc1 : ldc0;
#pragma unroll
        for (int ai = 0; ai < 2; ++ai)
#pragma unroll
            for (int m = 0; m < 4; ++m) { bf16_t* rowp = O + (size_t)(row0 + ai * HALF + m * 16) * ldc + col0;
#pragma unroll
                for (int bj = 0; bj < 2; ++bj) { const f32x4 v0 = acc[ai][bj][m][0], v1 = acc[ai][bj][m][1];
                    u32x4 w; w.x = mk::cvtpk(v0[0], v0[1]); w.y = mk::cvtpk(v0[2], v0[3]); w.z = mk::cvtpk(v1[0], v1[1]); w.w = mk::cvtpk(v1[2], v1[3]);
                    *(GAS u32x4*)(rowp + bj * HALF) = w; } }
    }
};
struct EpiResF32 {
    static constexpr bool PERM = false;
    const float* R; float* C; int ldc;
    __device__ __forceinline__ void operator()(const f32x4 (&acc)[2][2][4][2], const Unit& u, int wr, int wc, int fr, int fq) const {
        const int row0 = u.pm * BM + wr * 64 + fr, col0 = u.pn * BM + wc * 32 + 4 * fq;
#pragma unroll
        for (int ai = 0; ai < 2; ++ai)
#pragma unroll
            for (int m = 0; m < 4; ++m) { const size_t off = (size_t)(row0 + ai * HALF + m * 16) * ldc + col0;
#pragma unroll
                for (int bj = 0; bj < 2; ++bj)
#pragma unroll
                    for (int n = 0; n < 2; ++n) { const f32x4 r = *(const GAS f32x4*)(R + off + bj * HALF + n * 16); *(GAS f32x4*)(C + off + bj * HALF + n * 16) = r + acc[ai][bj][m][n]; } }
    }
};
template <bool RF32>
struct EpiResRouter {
    static constexpr bool PERM = false;
    const void* R; const float* GM; const float* IRS; int ldc;
    const float* G; bf16_t* XN; const bf16_t* WH; const bf16_t* WL; float* PART; float* PSS; int nrows; LAS unsigned char* lds;
    __device__ __forceinline__ void operator()(const f32x4 (&acc)[2][2][4][2], const Unit& u, int wr, int wc, int fr, int fq) const {
        constexpr int BFO = 0, PLO = 49152, PSO = PLO + 4 * 128 * 48 * 4;
        const int lane = fr + 16 * fq, tid = (wr * 4 + wc) * 64 + lane;
        asm volatile("s_waitcnt vmcnt(0)" ::: "memory"); __syncthreads();
        { const bf16_t* W = wr ? WL : WH;
#pragma unroll
          for (int bj = 0; bj < 2; ++bj)
#pragma unroll
              for (int nb = 0; nb < 3; ++nb) { const bf16_t* p = W + (size_t)(16 * nb + fr) * ldc + u.pn * BM + 128 * bj + 32 * wc + 4 * fq;
                  const u32x2 a = *(const GAS u32x2*)p, b = *(const GAS u32x2*)(p + 16);
                  *(LAS u32x4*)(lds + BFO + (((wc * 2 + wr) * 2 + bj) * 3 + nb) * 1024 + lane * 16) = (u32x4){a.x, a.y, b.x, b.y}; } }
        __syncthreads();
        const int row0 = u.pm * BM + wr * 64 + fr, col0 = u.pn * BM + wc * 32 + 4 * fq;
        LAS float* PL = (LAS float*)(lds + PLO); LAS float* PS = (LAS float*)(lds + PSO);
        f32x4 gv[2][2];
#pragma unroll
        for (int bj = 0; bj < 2; ++bj)
#pragma unroll
            for (int n = 0; n < 2; ++n) gv[bj][n] = *(const GAS f32x4*)(G + col0 + bj * HALF + n * 16);
        auto ldres = [&](size_t o_) -> f32x4 { if constexpr (RF32) return *(const GAS f32x4*)((const float*)R + o_);
            else { const u32x2 q_ = *(const GAS u32x2*)((const bf16_t*)R + o_); return (f32x4){mk::bflo(q_.x), mk::bfhi(q_.x), mk::bflo(q_.y), mk::bfhi(q_.y)}; } };
        f32x4 gmi[2][2]; float irn = 1.f;
        if constexpr (!RF32) {
#pragma unroll
            for (int bj = 0; bj < 2; ++bj)
#pragma unroll
                for (int n = 0; n < 2; ++n) { const f32x4 g_ = *(const GAS f32x4*)(GM + col0 + bj * HALF + n * 16); gmi[bj][n] = (f32x4){1.0f / g_[0], 1.0f / g_[1], 1.0f / g_[2], 1.0f / g_[3]}; }
            irn = ((const GAS float*)IRS)[row0]; }
        f32x4 rn[2][2];
#pragma unroll
        for (int bj = 0; bj < 2; ++bj)
#pragma unroll
            for (int n = 0; n < 2; ++n) rn[bj][n] = ldres((size_t)row0 * ldc + col0 + bj * HALF + n * 16);
#pragma unroll
        for (int ai = 0; ai < 2; ++ai) {
#pragma unroll
            for (int m = 0; m < 4; ++m) { const int row = row0 + ai * HALF + m * 16; const size_t off = (size_t)row * ldc + col0;
                f32x4 rc[2][2]; const float irc = irn;
#pragma unroll
                for (int bj = 0; bj < 2; ++bj)
#pragma unroll
                    for (int n = 0; n < 2; ++n) rc[bj][n] = rn[bj][n];
                if (ai * 4 + m + 1 < 8) { const int nx = ai * 4 + m + 1; const size_t offn = (size_t)(row0 + (nx >> 2) * HALF + (nx & 3) * 16) * ldc + col0;
                    if constexpr (!RF32) irn = ((const GAS float*)IRS)[row0 + (nx >> 2) * HALF + (nx & 3) * 16];
#pragma unroll
                    for (int bj = 0; bj < 2; ++bj)
#pragma unroll
                        for (int n = 0; n < 2; ++n) rn[bj][n] = ldres(offn + bj * HALF + n * 16); }
                float ss = 0.f; bf16x8 ah[2], al[2];
#pragma unroll
                for (int bj = 0; bj < 2; ++bj) { f32x4 y[2];
#pragma unroll
                    for (int n = 0; n < 2; ++n) { f32x4 r = rc[bj][n]; if constexpr (!RF32) r = r * gmi[bj][n] * irc; const f32x4 v = r + acc[ai][bj][m][n];
                        ss += (v[0] * v[0] + v[1] * v[1]) + (v[2] * v[2] + v[3] * v[3]);
                        y[n] = v * gv[bj][n]; }
                    const unsigned h0 = mk::cvtpk(y[0][0], y[0][1]), h1 = mk::cvtpk(y[0][2], y[0][3]), h2 = mk::cvtpk(y[1][0], y[1][1]), h3 = mk::cvtpk(y[1][2], y[1][3]);
                    u32x4 ll; ll.x = mk::cvtpk(y[0][0] - mk::bflo(h0), y[0][1] - mk::bfhi(h0)); ll.y = mk::cvtpk(y[0][2] - mk::bflo(h1), y[0][3] - mk::bfhi(h1));
                    ll.z = mk::cvtpk(y[1][0] - mk::bflo(h2), y[1][1] - mk::bfhi(h2)); ll.w = mk::cvtpk(y[1][2] - mk::bflo(h3), y[1][3] - mk::bfhi(h3));
                    bf16_t* xr = XN + (size_t)row * ldc + col0 + bj * HALF; *(GAS u32x2*)xr = (u32x2){h0, h1}; *(GAS u32x2*)(xr + 16) = (u32x2){h2, h3};
                    ah[bj] = __builtin_bit_cast(bf16x8, (u32x4){h0, h1, h2, h3}); al[bj] = __builtin_bit_cast(bf16x8, ll); }
                ss += __shfl_xor(ss, 16); ss += __shfl_xor(ss, 32);
                f32x4 la[3];
#pragma unroll
                for (int nb = 0; nb < 3; ++nb) la[nb] = (f32x4){0.f, 0.f, 0.f, 0.f};
#pragma unroll
                for (int bj = 0; bj < 2; ++bj)
#pragma unroll
                    for (int nb = 0; nb < 3; ++nb) { const bf16x8 bh = *(const LAS bf16x8*)(lds + BFO + (((wc * 2 + 0) * 2 + bj) * 3 + nb) * 1024 + lane * 16), bl = *(const LAS bf16x8*)(lds + BFO + (((wc * 2 + 1) * 2 + bj) * 3 + nb) * 1024 + lane * 16);
                        la[nb] = __builtin_amdgcn_mfma_f32_16x16x32_bf16(ah[bj], bh, la[nb], 0, 0, 0); la[nb] = __builtin_amdgcn_mfma_f32_16x16x32_bf16(ah[bj], bl, la[nb], 0, 0, 0); la[nb] = __builtin_amdgcn_mfma_f32_16x16x32_bf16(al[bj], bh, la[nb], 0, 0, 0); }
#pragma unroll
                for (int nb = 0; nb < 3; ++nb)
#pragma unroll
                    for (int i = 0; i < 4; ++i) PL[(wc * 128 + wr * 64 + m * 16 + 4 * fq + i) * 48 + 16 * nb + fr] = la[nb][i];
                if (fq == 0) PS[wc * 128 + wr * 64 + m * 16 + fr] = ss; }
            __syncthreads();
            const int grow0 = u.pm * BM + ai * HALF;
            for (int idx = tid; idx < 128 * 48; idx += 512) { const int rl = idx / 48, j = idx - rl * 48;
                const float s_ = ((PL[(0 * 128 + rl) * 48 + j] + PL[(1 * 128 + rl) * 48 + j]) + PL[(2 * 128 + rl) * 48 + j]) + PL[(3 * 128 + rl) * 48 + j];
                ((GAS float*)PART)[((size_t)u.pn * nrows + grow0 + rl) * 48 + j] = s_; }
            if (tid < 128) ((GAS float*)PSS)[(size_t)u.pn * nrows + grow0 + tid] = ((PS[tid] + PS[128 + tid]) + PS[256 + tid]) + PS[384 + tid];
            __syncthreads();
        }
    }
};
struct EpiMoe1 {
    static constexpr bool PERM = true;
    bf16_t* H; const int* lists; const float* selw; int lcap;
    __device__ __forceinline__ void operator()(const f32x4 (&acc)[2][2][4][2], const Unit& u, int wr, int wc, int fr, int fq) const {
        const int col0 = u.pn * HALF + wc * 32 + 8 * fq;
#pragma unroll
        for (int ai = 0; ai < 2; ++ai)
#pragma unroll
            for (int m = 0; m < 4; ++m) { const int r = ai * HALF + wr * 64 + m * 16 + fr;
                if (r < u.rows) { const int slot = ((const GAS int*)lists)[u.e * lcap + u.pm * BM + r]; const float w = ((const GAS float*)selw)[slot];
                    float o[8];
#pragma unroll
                    for (int n = 0; n < 2; ++n)
#pragma unroll
                        for (int j = 0; j < 4; ++j) { const float g = acc[ai][0][m][n][j], up = acc[ai][1][m][n][j]; o[n * 4 + j] = g * mk::fast_sigmoid(g) * up * w; }
                    u32x4 q; q.x = mk::cvtpk(o[0], o[1]); q.y = mk::cvtpk(o[2], o[3]); q.z = mk::cvtpk(o[4], o[5]); q.w = mk::cvtpk(o[6], o[7]);
                    *(GAS u32x4*)(H + (size_t)slot * 512 + col0) = q; } }
    }
};
struct EpiMoe2 {
    static constexpr bool PERM = true;
    bf16_t* O; const int* lists; int lcap; int ldc;
    __device__ __forceinline__ void operator()(const f32x4 (&acc)[2][2][4][2], const Unit& u, int wr, int wc, int fr, int fq) const {
        const int col0 = u.pn * BM + wc * 32 + 8 * fq;
#pragma unroll
        for (int ai = 0; ai < 2; ++ai)
#pragma unroll
            for (int m = 0; m < 4; ++m) { const int r = ai * HALF + wr * 64 + m * 16 + fr;
                if (r < u.rows) { const int slot = ((const GAS int*)lists)[u.e * lcap + u.pm * BM + r]; bf16_t* rowp = O + (size_t)slot * ldc + col0;
#pragma unroll
                    for (int bj = 0; bj < 2; ++bj) { const f32x4 v0 = acc[ai][bj][m][0], v1 = acc[ai][bj][m][1];
                        u32x4 w; w.x = mk::cvtpk(v0[0], v0[1]); w.y = mk::cvtpk(v0[2], v0[3]); w.z = mk::cvtpk(v1[0], v1[1]); w.w = mk::cvtpk(v1[2], v1[3]);
                        *(GAS u32x4*)(rowp + bj * HALF) = w; } } }
    }
};

template <class Prob, class Epi, class Sched, bool ALIGN_EPI>
__device__ __forceinline__ void gemm_phase(LAS unsigned char* lds, const Prob& P, const Sched& S, const Epi& E) {
    int tid_ = threadIdx.x; asm volatile("" : "+v"(tid_));
    const int tid = tid_, wid = __builtin_amdgcn_readfirstlane(tid >> 6), lane = tid & 63, wr = wid >> 2, wc = wid & 3, fr = lane & 15, fq = lane >> 4;
    const int K = P.K, nt = K / BK;
    int Rr[2], Cc[2]; unsigned voffB[2];
#pragma unroll
    for (int i = 0; i < 2; ++i) { int R, C; stage_rc(tid * 16 + i * 8192, R, C); Rr[i] = R; Cc[i] = C; const int Rb = Epi::PERM ? ((R & ~31) + perm32(R & 31)) : R; voffB[i] = (unsigned)(Rb * K + C) * 2u; }
    const size_t kstep = (size_t)(BK * 2);
    const size_t hstep = (size_t)HALF * K * 2;
    constexpr int H1 = Prob::GATHER ? 1 : 0; const size_t hoff = Prob::GATHER ? 0 : hstep;
    const unsigned ldsw = (unsigned)wid * 1024u;
    const int aoff = lds_byte(wr * 64 + fr, fq * 8), boff = lds_byte(wc * 32 + fr, fq * 8);
#define PG8_SA(b, h) (((b) * 2 + (h)) * HTB)
#define PG8_SB(b, h) ((4 + (b) * 2 + (h)) * HTB)
#define PG8_STAGE(bufoff, gbase, voff) do { _Pragma("unroll") for (int _i = 0; _i < 2; ++_i) \
        __builtin_amdgcn_global_load_lds((const unsigned*)((const char*)(gbase) + (voff)[_i]), (LAS unsigned*)(lds + (bufoff) + ldsw + _i * 8192), 16, 0, 0); } while (0)
#define PG8_LDA(dst, b, h) do { _Pragma("unroll") for (int m = 0; m < 4; ++m) _Pragma("unroll") for (int k = 0; k < 2; ++k) dst[m][k] = *(const LAS bf16x8*)(lds + PG8_SA(b, h) + aoff + m * 2048 + k * 1024); } while (0)
#define PG8_LDB(dst, b, h) do { _Pragma("unroll") for (int n = 0; n < 2; ++n) _Pragma("unroll") for (int k = 0; k < 2; ++k) dst[n][k] = *(const LAS bf16x8*)(lds + PG8_SB(b, h) + boff + n * 2048 + k * 1024); } while (0)
#define PG8_MMA(ai, bj, At, Bt) do { __builtin_amdgcn_s_setprio(1); _Pragma("unroll") for (int m = 0; m < 4; ++m) _Pragma("unroll") for (int n = 0; n < 2; ++n) _Pragma("unroll") for (int k = 0; k < 2; ++k) \
        acc[ai][bj][m][n] = __builtin_amdgcn_mfma_f32_16x16x32_bf16(Bt[n][k], At[m][k], acc[ai][bj][m][n], 0, 0, 0); __builtin_amdgcn_s_setprio(0); } while (0)
#define PG8_WAIT_V(n) asm volatile("s_waitcnt vmcnt(" #n ")" ::: "memory")
#define PG8_WAIT_L(n) asm volatile("s_waitcnt lgkmcnt(" #n ")" ::: "memory")
#define PG8_BAR __builtin_amdgcn_s_barrier()
#define PG8_SCHED __builtin_amdgcn_sched_barrier(0)
    Unit cur, nxt; int ui = 0;
    if (!S.next(0, cur)) return;
    f32x4 acc[2][2][4][2];
#pragma unroll
    for (int a = 0; a < 2; ++a)
#pragma unroll
        for (int b = 0; b < 2; ++b)
#pragma unroll
            for (int m = 0; m < 4; ++m)
#pragma unroll
                for (int n = 0; n < 2; ++n) acc[a][b][m][n] = (f32x4){0.f, 0.f, 0.f, 0.f};
    bf16x8 At[4][2], B0[2][2], B1[2][2];
    unsigned aoC[2][2], aoN[2][2];
    P.a_offs(cur, Rr, Cc, aoC);
    if (Prob::GATHER) asm volatile("" : "+v"(aoC[0][0]), "+v"(aoC[0][1]), "+v"(aoC[1][0]), "+v"(aoC[1][1]));
#pragma unroll
    for (int h = 0; h < 2; ++h)
#pragma unroll
        for (int i = 0; i < 2; ++i) aoN[h][i] = aoC[h][i];
    const char* cA = P.a_base(cur); const char* cB = P.b_base(cur);
    PG8_STAGE(PG8_SB(0, 0), cB, voffB); PG8_STAGE(PG8_SB(0, 1), cB + hstep, voffB); PG8_STAGE(PG8_SA(0, 0), cA, aoC[0]); PG8_STAGE(PG8_SA(0, 1), cA + hoff, aoC[H1]);
    if (wr == 1) PG8_BAR;
    PG8_WAIT_V(2); PG8_BAR;
    PG8_STAGE(PG8_SB(1, 0), cB + kstep, voffB); PG8_STAGE(PG8_SA(1, 0), cA + kstep, aoC[0]); PG8_STAGE(PG8_SB(1, 1), cB + hstep + kstep, voffB);
    PG8_WAIT_V(6); PG8_BAR;
    for (;;) {
        const bool has_next = S.next(ui + 1, nxt);
        const char* nA = has_next ? P.a_base(nxt) : cA; const char* nB = has_next ? P.b_base(nxt) : cB;
        if (Prob::GATHER) {
            if (has_next) { P.a_offs(nxt, Rr, Cc, aoN); asm volatile("" : "+v"(aoN[0][0]), "+v"(aoN[0][1]), "+v"(aoN[1][0]), "+v"(aoN[1][1])); }
            else {
#pragma unroll
                for (int h = 0; h < 2; ++h)
#pragma unroll
                    for (int i = 0; i < 2; ++i) aoN[h][i] = aoC[h][i]; }
        }
        const bool halfu = Prob::GATHER && cur.rows <= HALF;
        for (int t = 0; t < nt; t += 2) {
            const bool last = (t == nt - 2);
            const char* a1 = cA + (size_t)(t + 1) * kstep;
            const char* a2 = last ? nA : cA + (size_t)(t + 2) * kstep; const char* b2 = last ? nB : cB + (size_t)(t + 2) * kstep;
            const char* a3 = a2 + kstep; const char* b3 = b2 + kstep;
            unsigned o2[2][2];
#pragma unroll
            for (int h = 0; h < 2; ++h)
#pragma unroll
                for (int i = 0; i < 2; ++i) o2[h][i] = (Prob::GATHER && last) ? aoN[h][i] : aoC[h][i];
            PG8_LDB(B0, 0, 0); PG8_LDB(B1, 0, 1); PG8_SCHED; PG8_LDA(At, 0, 0); PG8_STAGE(PG8_SA(1, 1), a1 + hoff, aoC[H1]);
            PG8_WAIT_V(8); PG8_WAIT_L(0); PG8_BAR; PG8_MMA(0, 0, At, B0); PG8_MMA(0, 1, At, B1); PG8_BAR; PG8_SCHED;
            PG8_LDA(At, 0, 1); PG8_STAGE(PG8_SB(0, 0), b2, voffB); PG8_STAGE(PG8_SB(0, 1), b2 + hstep, voffB); PG8_STAGE(PG8_SA(0, 0), a2, o2[0]);
            PG8_WAIT_V(8); PG8_WAIT_L(0); PG8_BAR; if (!halfu) { PG8_MMA(1, 0, At, B0); PG8_MMA(1, 1, At, B1); } PG8_BAR; PG8_SCHED;
            PG8_LDB(B0, 1, 0); PG8_LDB(B1, 1, 1); PG8_SCHED; PG8_LDA(At, 1, 0); PG8_STAGE(PG8_SA(0, 1), a2 + hoff, o2[H1]);
            PG8_WAIT_V(8); PG8_WAIT_L(0); PG8_BAR; PG8_MMA(0, 0, At, B0); PG8_MMA(0, 1, At, B1); PG8_BAR; PG8_SCHED;
            PG8_LDA(At, 1, 1); PG8_STAGE(PG8_SB(1, 0), b3, voffB); PG8_STAGE(PG8_SB(1, 1), b3 + hstep, voffB); PG8_STAGE(PG8_SA(1, 0), a3, o2[0]);
            PG8_WAIT_V(8); PG8_WAIT_L(0); PG8_BAR; if (!halfu) { PG8_MMA(1, 0, At, B0); PG8_MMA(1, 1, At, B1); } PG8_BAR; PG8_SCHED;
        }
        if constexpr (ALIGN_EPI) { if (wr == 0) PG8_BAR; }
        E(acc, cur, wr, wc, fr, fq);
        if (!has_next) break;
#pragma unroll
        for (int a = 0; a < 2; ++a)
#pragma unroll
            for (int b = 0; b < 2; ++b)
#pragma unroll
                for (int m = 0; m < 4; ++m)
#pragma unroll
                    for (int n = 0; n < 2; ++n) acc[a][b][m][n] = (f32x4){0.f, 0.f, 0.f, 0.f};
        cur = nxt; cA = nA; cB = nB; ++ui;
#pragma unroll
        for (int h = 0; h < 2; ++h)
#pragma unroll
            for (int i = 0; i < 2; ++i) aoC[h][i] = aoN[h][i];
        if constexpr (ALIGN_EPI) { if (wr == 1) PG8_BAR; }
    }
    PG8_WAIT_V(0);
    if constexpr (!ALIGN_EPI) { if (wr == 0) PG8_BAR; }
    PG8_BAR;
#undef PG8_SA
#undef PG8_SB
#undef PG8_STAGE
#undef PG8_LDA
#undef PG8_LDB
#undef PG8_MMA
#undef PG8_WAIT_V
#undef PG8_WAIT_L
#undef PG8_BAR
#undef PG8_SCHED
}
}
namespace mk {
#define XB_TMO      128
#define XB_XCNT(j)  (256  + 64 * (j))
#define XB_XSUB(j)  (1280 + 64 * (j))
#define XB_XGEN(j)  (2304 + 64 * (j))
#define XB_TOP      3328
#define XB_TOPGEN   3392
#define XCD_BAR_WORDS 3456
#define XB_SPIN_CAP (1u << 18)

__device__ __forceinline__ unsigned xb_ld(unsigned* p)              { return __hip_atomic_load(p, __ATOMIC_RELAXED, __HIP_MEMORY_SCOPE_AGENT); }
__device__ __forceinline__ unsigned xb_add(unsigned* p, unsigned v) { return __hip_atomic_fetch_add(p, v, __ATOMIC_RELAXED, __HIP_MEMORY_SCOPE_AGENT); }
__device__ __forceinline__ unsigned xb_xcc_id() { return (unsigned)__builtin_amdgcn_s_getreg((3 << 11) | 20) & 0xFu; }
#define XB_SPIN(cond, bar) do { unsigned _sp = 0; while (cond) { __builtin_amdgcn_s_sleep(1); \
    if ((++_sp & 255u) == 0u) { if (xb_ld(&(bar)[XB_TMO])) break; if (_sp > XB_SPIN_CAP) { atomicAdd(&(bar)[XB_TMO], 1u); break; } } } } while (0)

struct XcdBarrier {
    unsigned* bar; unsigned x;
    volatile LAS unsigned* st;
};

__device__ __forceinline__ XcdBarrier xcd_barrier_post(unsigned* bar, volatile LAS unsigned* st) {
    XcdBarrier b; b.bar = bar; b.x = xb_xcc_id(); b.st = st;
    if (threadIdx.x == 0) (void)xb_add(&bar[XB_XCNT(b.x)], 1u);
    return b;
}
__device__ __forceinline__ void xcd_barrier_complete(unsigned* bar, unsigned x, unsigned& nloc, unsigned& nx) {
    const unsigned G = gridDim.x * gridDim.y * gridDim.z;
    unsigned sum, cnt, mine, sp = 0u;
    for (;;) {
        sum = 0u; cnt = 0u; mine = 0u;
#pragma unroll
        for (unsigned j = 0; j < 16; ++j) { const unsigned c = xb_ld(&bar[XB_XCNT(j)]); sum += c; cnt += (c > 0u) ? 1u : 0u; mine = (j == x) ? c : mine; }
        if (sum == G) break;
        __builtin_amdgcn_s_sleep(1);
        if ((++sp & 255u) == 0u) { if (xb_ld(&bar[XB_TMO])) break; if (sp > XB_SPIN_CAP) { atomicAdd(&bar[XB_TMO], 1u); break; } }
    }
    nloc = mine > 0u ? mine : 1u; nx = cnt > 0u ? cnt : 1u;
}

__device__ __forceinline__ void xcd_barrier(const XcdBarrier& b) {
    asm volatile("s_waitcnt vmcnt(0)" ::: "memory");
    __syncthreads();
    if (threadIdx.x == 0) {
        unsigned* bar = b.bar;
        __builtin_amdgcn_s_waitcnt(0);
        unsigned nloc = b.st[0], nx = b.st[1];
        if (nloc == 0u) { xcd_barrier_complete(bar, b.x, nloc, nx); b.st[0] = nloc; b.st[1] = nx; }
        const unsigned old = xb_add(&bar[XB_XSUB(b.x)], 1u);
        const unsigned gen = old / nloc;
        if (old + 1u == (gen + 1u) * nloc) {
            __builtin_amdgcn_fence(__ATOMIC_RELEASE, "agent");
            asm volatile("s_waitcnt vmcnt(0)" ::: "memory");
            const unsigned og = xb_add(&bar[XB_TOP], 1u);
            const unsigned tg = og / nx;
            if (og + 1u == (tg + 1u) * nx) xb_add(&bar[XB_TOPGEN], 1u);
            else XB_SPIN(xb_ld(&bar[XB_TOPGEN]) == tg, bar);
            __builtin_amdgcn_fence(__ATOMIC_ACQUIRE, "agent");
            xb_add(&bar[XB_XGEN(b.x)], 1u);
            asm volatile("s_waitcnt vmcnt(0)" ::: "memory");
        } else {
            XB_SPIN(xb_ld(&bar[XB_XGEN(b.x)]) == gen, bar);
            __builtin_amdgcn_fence(__ATOMIC_ACQUIRE, "agent");
            asm volatile("s_waitcnt vmcnt(0)" ::: "memory");
        }
    }
    __syncthreads();
}
struct Args { const void* in[35]; float* out; unsigned char* ws; int ph_lo, ph_hi; };
struct Frame {
    LAS unsigned char* lds; volatile LAS unsigned* MISC; gu32* ctl; unsigned char* ws;
    int tid, lane, wave, G, bid;
    const __attribute__((address_space(4))) char* ka;
};
#define INP(i) (*(const __attribute__((address_space(4))) unsigned long long*)(F.ka + 8 * (i)))
#define INF(i) ((const float*)(const GAS float*)INP(i))
#define WSP(T_, off) ((T_*)(GAS T_*)(F.ws + (off)))

template <bool SCALED>
__device__ __forceinline__ void transpose_item_t(const float* W, int K, int N, bf16* WT, int drow0, LAS float* scr, int kb, int nb, int lane, const float* knum, const float* kden) {
    const int k0 = 64 * kb, n0 = 32 * nb;
#pragma unroll
    for (int i = 0; i < 32; ++i) { const int kk = 2 * i + (lane >> 5); scr[kk * 33 + (lane & 31)] = __builtin_nontemporal_load(W + (size_t)(k0 + kk) * N + n0 + (lane & 31)); }
    LDS_WAIT(); asm volatile("" ::: "memory");
    const int c = lane & 7;
    float sc[8];
#pragma unroll
    for (int q = 0; q < 8; ++q) sc[q] = 1.0f;
    if constexpr (SCALED) {
#pragma unroll
        for (int q = 0; q < 8; ++q) sc[q] = ((const GAS float*)knum)[k0 + 8 * c + q] / ((const GAS float*)kden)[k0 + 8 * c + q]; }
#pragma unroll
    for (int j = 0; j < 4; ++j) { const int n = (lane >> 3) + 8 * j; const LAS float* s = scr + (8 * c) * 33 + n;
        u32x4 o; o.x = pk2(s[0 * 33] * sc[0], s[1 * 33] * sc[1]); o.y = pk2(s[2 * 33] * sc[2], s[3 * 33] * sc[3]); o.z = pk2(s[4 * 33] * sc[4], s[5 * 33] * sc[5]); o.w = pk2(s[6 * 33] * sc[6], s[7 * 33] * sc[7]);
        *(GAS u32x4*)(WT + (size_t)(drow0 + n) * K + k0 + 8 * c) = o; }
    LDS_WAIT(); asm volatile("" ::: "memory");
}
__device__ __forceinline__ void transpose_item(const float* W, int K, int N, bf16* WT, int drow0, LAS float* scr, int kb, int nb, int lane) { transpose_item_t<false>(W, K, N, WT, drow0, scr, kb, nb, lane, nullptr, nullptr); }
__device__ __forceinline__ void norm_rows(Frame& F, const float* x, int rows, const float* g1, bf16* o1, const float* g2, bf16* o2) {
    const int gw = F.bid * NWAVES + F.wave, NGW = F.G * NWAVES;
    for (int m = gw; m < rows; m += NGW) {
        const GAS f32x4* xr = (const GAS f32x4*)(x + (size_t)m * D) + F.lane;
        f32x4 v[8]; float ss = 0.f;
#pragma unroll
        for (int j = 0; j < 8; ++j) { v[j] = xr[64 * j]; ss += (v[j].x * v[j].x + v[j].y * v[j].y) + (v[j].z * v[j].z + v[j].w * v[j].w); }
        const float rstd = 1.0f / sqrtf(wave_sum(ss) * (1.0f / D) + EPS);
        GAS u32x2* o = (GAS u32x2*)(o1 + (size_t)m * D) + F.lane;
#pragma unroll
        for (int j = 0; j < 8; ++j) { const f32x4 g = ((const GAS f32x4*)g1)[F.lane + 64 * j]; u32x2 w; w.x = pk2(v[j].x * rstd * g.x, v[j].y * rstd * g.y); w.y = pk2(v[j].z * rstd * g.z, v[j].w * rstd * g.w); o[64 * j] = w; }
        if (g2) { GAS u32x2* oo = (GAS u32x2*)(o2 + (size_t)m * D) + F.lane;
#pragma unroll
            for (int j = 0; j < 8; ++j) { const f32x4 g = ((const GAS f32x4*)g2)[F.lane + 64 * j]; u32x2 w; w.x = pk2(v[j].x * rstd * g.x, v[j].y * rstd * g.y); w.y = pk2(v[j].z * rstd * g.z, v[j].w * rstd * g.w); oo[64 * j] = w; } }
    }
}
__device__ __forceinline__ void combine_norm_rows(Frame& F, bf16* xb, const float* gx, float* irs, float* outf, const bf16* O, const float* g1, bf16* o1, const float* g2, bf16* o2) {
    const int gw = F.bid * NWAVES + F.wave, NGW = F.G * NWAVES;
    for (int m0 = gw; m0 < T; m0 += 2 * NGW) {
        const int m1 = m0 + NGW < T ? m0 + NGW : m0;
        GAS u32x2* xr0 = (GAS u32x2*)(xb + (size_t)m0 * D) + F.lane; GAS u32x2* xr1 = (GAS u32x2*)(xb + (size_t)m1 * D) + F.lane;
        const GAS u32x2* oa0 = (const GAS u32x2*)(O + (size_t)(2 * m0) * D) + F.lane; const GAS u32x2* ob0 = (const GAS u32x2*)(O + (size_t)(2 * m0 + 1) * D) + F.lane;
        const GAS u32x2* oa1 = (const GAS u32x2*)(O + (size_t)(2 * m1) * D) + F.lane; const GAS u32x2* ob1 = (const GAS u32x2*)(O + (size_t)(2 * m1 + 1) * D) + F.lane;
        f32x4 v0[8], v1[8]; u32x2 x0[8], x1[8], a0[8], b0[8], a1[8], b1[8];
#pragma unroll
        for (int j = 0; j < 8; ++j) { x0[j] = xr0[64 * j]; a0[j] = oa0[64 * j]; b0[j] = ob0[64 * j]; x1[j] = xr1[64 * j]; a1[j] = oa1[64 * j]; b1[j] = ob1[64 * j]; }
        float ss0 = 0.f, ss1 = 0.f;
#pragma unroll
        for (int j = 0; j < 8; ++j) {
            const f32x4 gq = ((const GAS f32x4*)gx)[F.lane + 64 * j]; const float i0 = __builtin_amdgcn_rcpf(gq.x), i1 = __builtin_amdgcn_rcpf(gq.y), i2 = __builtin_amdgcn_rcpf(gq.z), i3 = __builtin_amdgcn_rcpf(gq.w);
            v0[j].x = (bflo(x0[j].x) * i0 + bflo(a0[j].x)) + bflo(b0[j].x); v0[j].y = (bfhi(x0[j].x) * i1 + bfhi(a0[j].x)) + bfhi(b0[j].x); v0[j].z = (bflo(x0[j].y) * i2 + bflo(a0[j].y)) + bflo(b0[j].y); v0[j].w = (bfhi(x0[j].y) * i3 + bfhi(a0[j].y)) + bfhi(b0[j].y);
            v1[j].x = (bflo(x1[j].x) * i0 + bflo(a1[j].x)) + bflo(b1[j].x); v1[j].y = (bfhi(x1[j].x) * i1 + bfhi(a1[j].x)) + bfhi(b1[j].x); v1[j].z = (bflo(x1[j].y) * i2 + bflo(a1[j].y)) + bflo(b1[j].y); v1[j].w = (bfhi(x1[j].y) * i3 + bfhi(a1[j].y)) + bfhi(b1[j].y);
            if (outf) { ((GAS f32x4*)(outf + (size_t)m0 * D) + F.lane)[64 * j] = v0[j]; if (m1 != m0) ((GAS f32x4*)(outf + (size_t)m1 * D) + F.lane)[64 * j] = v1[j]; }
            ss0 += (v0[j].x * v0[j].x + v0[j].y * v0[j].y) + (v0[j].z * v0[j].z + v0[j].w * v0[j].w); ss1 += (v1[j].x * v1[j].x + v1[j].y * v1[j].y) + (v1[j].z * v1[j].z + v1[j].w * v1[j].w); }
        if (g1) {
            const float ir0 = sqrtf(wave_sum(ss0) * (1.0f / D) + EPS), ir1 = sqrtf(wave_sum(ss1) * (1.0f / D) + EPS), rs0 = 1.0f / ir0, rs1 = 1.0f / ir1;
            if (F.lane == 0) { ((GAS float*)irs)[m0] = ir0; ((GAS float*)irs)[m1] = ir1; }
            GAS u32x2* p0 = (GAS u32x2*)(o1 + (size_t)m0 * D) + F.lane; GAS u32x2* p1 = (GAS u32x2*)(o1 + (size_t)m1 * D) + F.lane;
#pragma unroll
            for (int j = 0; j < 8; ++j) { const f32x4 g = ((const GAS f32x4*)g1)[F.lane + 64 * j]; u32x2 w;
                w.x = pk2(v0[j].x * rs0 * g.x, v0[j].y * rs0 * g.y); w.y = pk2(v0[j].z * rs0 * g.z, v0[j].w * rs0 * g.w); p0[64 * j] = w;
                w.x = pk2(v1[j].x * rs1 * g.x, v1[j].y * rs1 * g.y); w.y = pk2(v1[j].z * rs1 * g.z, v1[j].w * rs1 * g.w); p1[64 * j] = w; }
            if (g2) { GAS u32x2* q0 = (GAS u32x2*)(o2 + (size_t)m0 * D) + F.lane; GAS u32x2* q1 = (GAS u32x2*)(o2 + (size_t)m1 * D) + F.lane;
#pragma unroll
                for (int j = 0; j < 8; ++j) { const f32x4 g = ((const GAS f32x4*)g2)[F.lane + 64 * j]; u32x2 w;
                    w.x = pk2(v0[j].x * rs0 * g.x, v0[j].y * rs0 * g.y); w.y = pk2(v0[j].z * rs0 * g.z, v0[j].w * rs0 * g.w); q0[64 * j] = w;
                    w.x = pk2(v1[j].x * rs1 * g.x, v1[j].y * rs1 * g.y); w.y = pk2(v1[j].z * rs1 * g.z, v1[j].w * rs1 * g.w); q1[64 * j] = w; } }
        }
    }
}
template <int NV>
__device__ __forceinline__ void norm_bf16_rows(Frame& F, const bf16* src, int src_ld, const float* g, bf16* dst, int dst_ld, int rows) {
    const int gw = F.bid * NWAVES + F.wave, NGW = F.G * NWAVES;
    float gv[NV];
#pragma unroll
    for (int i = 0; i < NV; ++i) gv[i] = g[F.lane * NV + i];
    for (int m0 = gw; m0 < rows; m0 += 4 * NGW) {
        unsigned w[4][NV / 2]; float ss[4];
#pragma unroll
        for (int q = 0; q < 4; ++q) { const int m = m0 + q * NGW < rows ? m0 + q * NGW : m0; const GAS unsigned* sp = (const GAS unsigned*)(src + (size_t)m * src_ld + F.lane * NV);
#pragma unroll
            for (int i = 0; i < NV / 2; ++i) w[q][i] = sp[i]; }
#pragma unroll
        for (int q = 0; q < 4; ++q) { float s = 0.f;
#pragma unroll
            for (int i = 0; i < NV / 2; ++i) s += bflo(w[q][i]) * bflo(w[q][i]) + bfhi(w[q][i]) * bfhi(w[q][i]);
            ss[q] = s; }
#pragma unroll
        for (int o = 1; o < 64; o <<= 1) {
#pragma unroll
            for (int q = 0; q < 4; ++q) ss[q] += __shfl_xor(ss[q], o); }
#pragma unroll
        for (int q = 0; q < 4; ++q) { const int m = m0 + q * NGW < rows ? m0 + q * NGW : m0; const float rstd = 1.0f / sqrtf(ss[q] * (1.0f / (64 * NV)) + EPS);
            GAS unsigned* dp = (GAS unsigned*)(dst + (size_t)m * dst_ld + F.lane * NV);
#pragma unroll
            for (int i = 0; i < NV / 2; ++i) dp[i] = pk2(bflo(w[q][i]) * rstd * gv[2 * i], bfhi(w[q][i]) * rstd * gv[2 * i + 1]); }
    }
}
__device__ __forceinline__ void transpose_tile_wave(const bf16* src, long src_ld, bf16* dst, long dst_ld, LAS unsigned char* scr, int lane) {
#pragma unroll
    for (int i = 0; i < 4; ++i) { const int p = lane + 64 * i, row = p >> 2, ch = p & 3;
        const u32x4 v = *(const GAS u32x4*)(src + (size_t)row * src_ld + ch * 8);
        LAS unsigned* q = (LAS unsigned*)(scr + row * 68 + ch * 16); q[0] = v.x; q[1] = v.y; q[2] = v.z; q[3] = v.w; }
    LDS_WAIT(); asm volatile("" ::: "memory");
#pragma unroll
    for (int i = 0; i < 4; ++i) { const int q = lane + 64 * i, dd = q >> 3, m0 = (q & 7) * 8;
        unsigned h[8];
#pragma unroll
        for (int j = 0; j < 8; ++j) h[j] = *(const LAS unsigned short*)(scr + ((m0 & ~15) + (j & 3) + 8 * (j >> 2) + ((m0 & 8) >> 1)) * 68 + dd * 2);
        u32x4 o; o.x = h[0] | (h[1] << 16); o.y = h[2] | (h[3] << 16); o.z = h[4] | (h[5] << 16); o.w = h[6] | (h[7] << 16);
        *(GAS u32x4*)(dst + (size_t)dd * dst_ld + m0) = o; }
    LDS_WAIT(); asm volatile("" ::: "memory");
}

__device__ const double ROPE_INV_FREQ[32] = {1.0, 0.7498942093324559, 0.5623413251903491, 0.4216965034285822, 0.31622776601683794, 0.23713737056616552, 0.1778279410038923, 0.1333521432163324, 0.1, 0.07498942093324558, 0.05623413251903491, 0.042169650342858224, 0.03162277660168379, 0.023713737056616554, 0.01778279410038923, 0.01333521432163324, 0.01, 0.007498942093324558, 0.005623413251903491, 0.004216965034285823, 0.0031622776601683794, 0.0023713737056616554, 0.0017782794100389228, 0.001333521432163324, 0.001, 0.0007498942093324559, 0.0005623413251903491, 0.00042169650342858224, 0.00031622776601683794, 0.00023713737056616554, 0.00017782794100389227, 0.0001333521432163324};
__device__ __forceinline__ void p0_prologue(Frame& F, const Args& args) {
    LAS float* scr = (LAS float*)(F.lds + RING_OFF + F.wave * 16384);
    const int gw = F.bid * NWAVES + F.wave, NGW = F.G * NWAVES;
    constexpr int I_INA = 2 * 32 * 112, I_INB = 2 * 32 * 32, I_O = 4 * 32 * 64, I_MKV = 4 * 32 * 32, I_UQ = 2 * 8 * 72, I_DKV = 32 * 10, I_UK = 4 * 48;
    constexpr int NITEMS = I_INA + I_INB + I_O + I_MKV + I_UQ + I_DKV + 2 * I_UK;
    for (int it = gw; it < NITEMS; it += NGW) {
        int r = it;
        if (r < I_INA) { const int l = r / 3584, rr = r % 3584, kb = rr / 112, nb = rr % 112;
            transpose_item(INF(10) + (size_t)l * D * IN_A, D, IN_A, WSP(bf16, WS_WT_INA) + (size_t)l * IN_A * D, nb * 32, scr, kb, nb, F.lane); continue; } r -= I_INA;
        if (r < I_INB) { const int l = r >> 10, rr = r & 1023, kb = rr >> 5, nb = rr & 31;
            transpose_item(INF(24) + (size_t)l * D * IN_B, D, IN_B, WSP(bf16, WS_WT_INB) + (size_t)l * IN_B * D, nb * 32, scr, kb, nb, F.lane); continue; } r -= I_INB;
        if (r < I_O) { const int l = r >> 11, rr = r & 2047, kb = rr >> 6, nb = rr & 63;
            transpose_item(INF(5) + (size_t)l * D * D, D, D, WSP(bf16, WS_WT_O) + (size_t)l * D * D, nb * 32, scr, kb, nb, F.lane); continue; } r -= I_O;
        if (r < I_MKV) { const int l = r >> 10, rr = r & 1023, kb = rr >> 5, nb = rr & 31;
            transpose_item(INF(7) + (size_t)l * D * 1024, D, 1024, WSP(bf16, WS_WT_MKV) + (size_t)l * 1024 * D, nb * 32, scr, kb, nb, F.lane); continue; } r -= I_MKV;
        if (r < I_UQ) { const int l = r / 576, rr = r % 576, kb = rr / 72, nb = rr % 72;
            transpose_item(INF(26) + (size_t)l * Q_RANK * QW, Q_RANK, QW, WSP(bf16, WS_WT_UQ) + (size_t)l * QW * Q_RANK, nb * 32, scr, kb, nb, F.lane); continue; } r -= I_UQ;
        if (r < I_DKV) { const int kb = r / 10, nb = r % 10;
            transpose_item_t<true>(INF(19), D, 320, WSP(bf16, WS_WT_DKV), nb * 32, scr, kb, nb, F.lane, INF(18), INF(3) + NA * D); continue; } r -= I_DKV;
        if (r < I_UK) { const int kb = r / 48, nb = r % 48;
            transpose_item(INF(21), KV_RANK, 1536, WSP(bf16, WS_WT_UKV), nb * 32, scr, kb, nb, F.lane); continue; } r -= I_UK;
        { const int kb = r / 48, nb = r % 48;
            transpose_item(INF(22), KV_RANK, 1536, WSP(bf16, WS_WT_UKV), 1536 + nb * 32, scr, kb, nb, F.lane); }
    }
    const int gt = F.bid * NTHR + F.tid, NGT = F.G * NTHR;
    for (int i = gt; i < 192 * D / 8; i += NGT) ((u32x4*)(WSP(bf16, WS_WT_DKV) + (size_t)320 * D))[i] = (u32x4){0u, 0u, 0u, 0u};
    for (int i = gt; i < 4 * 48 * D; i += NGT) { const int l = i / (48 * D), j = (i / D) % 48, k = i % D;
        const float wv = j < 8 ? INF(28)[((size_t)l * D + k) * 8 + j] : (j < 40 ? INF(30)[((size_t)l * D + k) * 32 + (j - 8)] : 0.f);
        const unsigned h = f2bf(wv); const unsigned lo = f2bf(wv - bflo(h));
        WSP(bf16, WS_WT_RT)[(size_t)(l * 2) * 48 * D + (size_t)j * D + k] = (bf16)h; WSP(bf16, WS_WT_RT)[(size_t)(l * 2 + 1) * 48 * D + (size_t)j * D + k] = (bf16)lo; }
    { const int* pos = (const int*)(const GAS int*)INP(2);
      for (int i = gt; i < T * 32; i += NGT) { const int t = i >> 5, j = i & 31; const double ang = (double)pos[t] * ROPE_INV_FREQ[j];
          WSP(float, WS_TAB)[t * 64 + j] = (float)cos(ang); WSP(float, WS_TAB)[t * 64 + 32 + j] = (float)sin(ang); } }
    for (int l = 0; l < 4; ++l) norm_rows(F, INF(1), Bn * MEM_LEN, INF(6) + l * D, WSP(bf16, WS_MEMN) + (size_t)l * 1024 * D, nullptr, nullptr);
    norm_rows(F, INF(0), T, INF(3), WSP(bf16, WS_XN), nullptr, nullptr);
}

constexpr int CV_PER_LAYER = 3 * 16384;
__device__ __forceinline__ void conv_item(Frame& F, const Args& args, int l, int r, LAS float* scr) {
    const int kind = r >> 14, rr = r & 16383, e = l * 32 + (rr >> 9), it = rr & 511;
    if (kind == 0) { const int kb = it >> 4, nb = it & 15, n0 = nb * 32; transpose_item(INF(32) + (size_t)e * D * D_EXP, D, D_EXP, WSP(bf16, WS_WT_EGU) + (size_t)e * 1024 * D, (n0 >> 7) * 256 + (n0 & 127), scr, kb, nb, F.lane); }
    else if (kind == 1) { const int kb = it >> 4, nb = it & 15, n0 = nb * 32; transpose_item(INF(33) + (size_t)e * D * D_EXP, D, D_EXP, WSP(bf16, WS_WT_EGU) + (size_t)e * 1024 * D, (n0 >> 7) * 256 + 128 + (n0 & 127), scr, kb, nb, F.lane); }
    else { const int kb = it >> 6, nb = it & 63; transpose_item(INF(34) + (size_t)e * D_EXP * D, D_EXP, D, WSP(bf16, WS_WT_ED) + (size_t)e * D * D_EXP, nb * 32, scr, kb, nb, F.lane); }
}
__device__ __forceinline__ void conv_experts(Frame& F, const Args& args, int l) {
    LAS float* scr = (LAS float*)(F.lds + RING_OFF + F.wave * 16384);
    const int gw = F.bid * NWAVES + F.wave, NGW = F.G * NWAVES;
    __syncthreads();
    for (int r = gw; r < CV_PER_LAYER; r += NGW) conv_item(F, args, l, r, scr);
    __syncthreads();
}
__device__ __forceinline__ void conv_quota(Frame& F, const Args& args, int claims) {
    LAS float* scr = (LAS float*)(F.lds + RING_OFF + F.wave * 16384);
    for (int c = 0; c < claims; ++c) {
        __syncthreads();
        if (F.tid == 0) { unsigned v = 0u; unsigned lb = F.MISC[2];
            for (; lb < 3u; ++lb) { const unsigned b = __hip_atomic_fetch_add((unsigned*)(F.ctl + CW_CONVQ + 64 * lb), 8u, RLX_AGENT); if (b < (unsigned)CV_PER_LAYER) { v = 1u + lb * (unsigned)CV_PER_LAYER + b; break; } }
            F.MISC[2] = lb; F.MISC[1] = v; }
        __syncthreads();
        const unsigned v = F.MISC[1];
        if (v == 0u) break;
        const int q = (int)(v - 1u), lb = q / CV_PER_LAYER, r = q % CV_PER_LAYER + F.wave;
        if (r < CV_PER_LAYER) conv_item(F, args, lb + 1, r, scr);
    }
    __syncthreads();
}
__device__ __forceinline__ void conv_drain(Frame& F, const Args& args, int l) {
    gu32* head = F.ctl + CW_CONVQ + 64 * (l - 1);
    LAS float* scr = (LAS float*)(F.lds + RING_OFF + F.wave * 16384);
    for (;;) {
        __syncthreads();
        if (F.tid == 0) { const unsigned b = __hip_atomic_fetch_add((unsigned*)head, 64u, RLX_AGENT); F.MISC[1] = b < (unsigned)CV_PER_LAYER ? b + 1u : 0u; }
        __syncthreads();
        const unsigned v = F.MISC[1];
        if (v == 0u) break;
        const int r0 = (int)(v - 1u) + 8 * F.wave;
        for (int i = 0; i < 8; ++i) if (r0 + i < CV_PER_LAYER) conv_item(F, args, l, r0 + i, scr);
    }
    __syncthreads();
}
__device__ __forceinline__ void mem_assemble(Frame& F, const Args& args, int gw, int NGW) {
    const int lane = F.lane;
    const bf16* mkv = WSP(bf16, WS_MKVR);
    for (int r = gw; r < 4096; r += NGW) { const int l = r >> 10; const float* g = INF(9) + l * 128;
        const float g0 = g[2 * lane], g1 = g[2 * lane + 1];
#pragma unroll
        for (int h = 0; h < 4; ++h) { const unsigned w = *(const GAS unsigned*)(mkv + (size_t)r * 1024 + h * 128 + 2 * lane); const float a = bflo(w), b = bfhi(w);
            const float rstd = 1.0f / sqrtf(wave_sum(a * a + b * b) * (1.0f / 128.0f) + EPS);
            bf16* o = WSP(bf16, WS_MEMK) + ((size_t)r * 4 + h) * 192;
            *(GAS unsigned*)(o + 2 * lane) = pk2(a * rstd * g0, b * rstd * g1);
            if (lane < 32) *(GAS unsigned*)(o + 128 + 2 * lane) = 0u; } }
    LAS unsigned char* scr = F.lds + RING_OFF + F.wave * 4352;
    for (int it = gw; it < 64 * 16; it += NGW) { const int rt = it >> 4, ct = it & 15;
        const int l = rt >> 4, b = (rt >> 2) & 3, m0 = (rt & 3) * 64, h = ct >> 2, d0 = (ct & 3) * 32;
        transpose_tile_wave(mkv + (size_t)(rt * 64) * 1024 + 512 + ct * 32, 1024, WSP(bf16, WS_MEMVT) + ((size_t)((l * 4 + b) * 4 + h) * 128 + d0) * 256 + m0, 256, scr, lane); }
}
__device__ __forceinline__ void kv_assemble(Frame& F, const Args& args) {
    const int gw = F.bid * NWAVES + F.wave, NGW = F.G * NWAVES, lane = F.lane;
    const bf16* kvup = WSP(bf16, WS_KVUP); const bf16* ckv = WSP(bf16, WS_CKV); const float* g = INF(23); const float* tab = WSP(float, WS_TAB);
    const float g0 = g[2 * lane], g1 = g[2 * lane + 1], g2 = g[128 + lane];
    for (int t = gw; t < T; t += NGW) {
        const float pe = bf1(ckv[(size_t)t * 512 + 256 + lane]); const float sspe = wave_sum(pe * pe);
        const int j = lane & 31; const float c = tab[t * 64 + j], sn = tab[t * 64 + 32 + j];
        unsigned wv[MLA_H]; float sq[MLA_H];
#pragma unroll
        for (int h = 0; h < MLA_H; ++h) { wv[h] = *(const GAS unsigned*)(kvup + (size_t)t * 3072 + h * 128 + 2 * lane); sq[h] = bflo(wv[h]) * bflo(wv[h]) + bfhi(wv[h]) * bfhi(wv[h]); }
#pragma unroll
        for (int o = 1; o < 64; o <<= 1) {
#pragma unroll
            for (int h = 0; h < MLA_H; ++h) sq[h] += __shfl_xor(sq[h], o); }
#pragma unroll
        for (int h = 0; h < MLA_H; ++h) { const float a = bflo(wv[h]), b = bfhi(wv[h]);
            const float rstd = 1.0f / sqrtf((sq[h] + sspe) * (1.0f / 192.0f) + EPS);
            bf16* o = WSP(bf16, WS_K) + ((size_t)t * MLA_H + h) * 192;
            *(GAS unsigned*)(o + 2 * lane) = pk2(a * rstd * g0, b * rstd * g1);
            const float n2 = pe * rstd * g2, other = __shfl_xor(n2, 32);
            const float rr = lane < 32 ? (n2 * c - other * sn) : (n2 * c + other * sn);
            ((GAS bf16*)o)[128 + lane] = (bf16)f2bf(rr); } }
    LAS unsigned char* scr = F.lds + RING_OFF + F.wave * 4352;
    for (int it = gw; it < 128 * 48; it += NGW) { const int rt = it / 48, ct = it % 48;
        const int b = rt >> 5, s0 = (rt & 31) * 64, h = ct >> 2, d0 = (ct & 3) * 32;
        transpose_tile_wave(kvup + (size_t)(rt * 64) * 3072 + 1536 + ct * 32, 3072, WSP(bf16, WS_VT) + ((size_t)(b * MLA_H + h) * 128 + d0) * S + s0, S, scr, lane); }
}

__device__ __forceinline__ void router_phase(Frame& F, const Args& args, int l, const float* x1) {
    LAS float* tmp = (LAS float*)(F.lds + RING_OFF);
    LAS float* lgt = (LAS float*)(F.lds + RING_OFF + 49152);
    LAS int* sel = (LAS int*)(F.lds + RING_OFF + 49152 + 5120 + 128);
    const int tid = F.tid;
    for (int pass = F.bid; pass < T / 32; pass += F.G) {
        const int tokb = pass * 32;
        for (int idx = tid; idx < 32 * 49; idx += NTHR) { const int tk = idx / 49, j = idx - tk * 49; float s_ = 0.f;
            if (j < 48) {
#pragma unroll
                for (int pn = 0; pn < 8; ++pn) s_ += ((const GAS float*)WSP(float, WS_RPART))[((size_t)pn * T + tokb + tk) * 48 + j]; }
            else {
#pragma unroll
                for (int pn = 0; pn < 8; ++pn) s_ += ((const GAS float*)WSP(float, WS_RPSS))[(size_t)pn * T + tokb + tk]; }
            tmp[tk * 49 + j] = s_; }
        __syncthreads();
        for (int idx = tid; idx < 32 * 40; idx += NTHR) { const int tk = idx / 40, j = idx - tk * 40;
            const float rstd = 1.0f / sqrtf(tmp[tk * 49 + 48] * (1.0f / D) + EPS);
            lgt[tk * 40 + j] = tmp[tk * 49 + j] * rstd;
            if (j == 0) ((GAS float*)WSP(float, WS_RSTD))[tokb + tk] = rstd; }
        __syncthreads();
        if (tid < 32) {
            const LAS float* lp = lgt + tid * 40; const float* bg = INF(29) + l * 8; const float* be = INF(31) + l * 32;
            int gi = 0; float gm = lp[0] + bg[0]; float lg[8]; lg[0] = gm;
#pragma unroll
            for (int j = 1; j < 8; ++j) { lg[j] = lp[j] + bg[j]; if (lg[j] > gm) { gm = lg[j]; gi = j; } }
            float den = 0.f;
#pragma unroll
            for (int j = 0; j < 8; ++j) den += expf(lg[j] - gm);
            const float ptop = 1.0f / den;
            const float a0 = lp[8 + gi * 4 + 0] + be[gi * 4 + 0], a1 = lp[8 + gi * 4 + 1] + be[gi * 4 + 1], a2 = lp[8 + gi * 4 + 2] + be[gi * 4 + 2], a3 = lp[8 + gi * 4 + 3] + be[gi * 4 + 3];
            int e0 = 0; float m0 = a0; if (a1 > m0) { m0 = a1; e0 = 1; } if (a2 > m0) { m0 = a2; e0 = 2; } if (a3 > m0) { m0 = a3; e0 = 3; }
            int e1 = -1; float m1 = -INFINITY;
            if (e0 != 0 && a0 > m1) { m1 = a0; e1 = 0; } if (e0 != 1 && a1 > m1) { m1 = a1; e1 = 1; } if (e0 != 2 && a2 > m1) { m1 = a2; e1 = 2; } if (e0 != 3 && a3 > m1) { m1 = a3; e1 = 3; }
            const float w0 = 1.0f / (1.0f + expf(m1 - m0)), w1 = 1.0f - w0;
            const int tok = tokb + tid;
            WSP(float, WS_SELW)[2 * tok] = ptop * w0; WSP(float, WS_SELW)[2 * tok + 1] = ptop * w1;
            sel[2 * tid] = gi * 4 + e0; sel[2 * tid + 1] = gi * 4 + e1;
        }
        __syncthreads();
        if (tid < 32) {
            int cnt = 0;
            for (int s = 0; s < 64; ++s) cnt += (sel[s] == tid) ? 1 : 0;
            if (cnt > 0) { unsigned base = __hip_atomic_fetch_add((unsigned*)(F.ctl + CW_MOECNT + (l * 32 + tid) * 64), (unsigned)cnt, RLX_AGENT);
                for (int s = 0; s < 64; ++s) if (sel[s] == tid) { WSP(int, WS_LISTS)[tid * LCAP + base] = 2 * tokb + s; ++base; } }
        }
        __syncthreads();
    }
}
__device__ __forceinline__ void moe_table(Frame& F, int l, int ntl) {
    LAS int* tab = (LAS int*)(F.lds + MOE_TAB_OFF);
    __syncthreads();
    if (F.tid < 32) tab[33 + F.tid] = (int)__hip_atomic_load((unsigned*)(F.ctl + CW_MOECNT + (l * 32 + F.tid) * 64), RLX_AGENT);
    __syncthreads();
    if (F.tid == 0) { int s = 0;
        for (int e = 0; e < 32; ++e) { tab[e] = s; s += ((tab[33 + e] + 127) >> 8) * ntl; } tab[32] = s;
        for (int e = 0; e < 32; ++e) { const int cnt = tab[33 + e]; tab[65 + e] = s; s += (((cnt + 255) >> 8) - ((cnt + 127) >> 8)) * ntl; } tab[97] = s; }
    __syncthreads();
}

__device__ __forceinline__ void scan_unit(Frame& F, const Args& args, int l, int u) {
    constexpr int YT = 0, SUMM = 65536, UT = SUMM + 2048, UTW = 9216, GT = UT + 8 * UTW, CWO = GT + 16384;
    static_assert(CWO + 2560 <= RING_BYTES, "scan lds");
    const int b = u / 48, n = (u % 48) >> 2, cq = u & 3;
    LAS unsigned char* lds = F.lds + RING_OFF; LAS unsigned char* yt = lds + YT; LAS float* summ = (LAS float*)(lds + SUMM); LAS float* cwl = (LAS float*)(lds + CWO);
    int tid_ = F.tid; asm volatile("" : "+v"(tid_));
    const int tid = tid_, lane = tid & 63, w = F.wave, r32 = lane & 31, hi = lane >> 5;
    const int col = n * 128 + cq * 32 + r32;
    const bf16* proj = WSP(bf16, WS_PROJ); bf16* ycat = WSP(bf16, WS_YCAT);
    const bf16* zsrc = WSP(bf16, WS_WT_DKV) + (size_t)320 * D;
    int urow[9];
#pragma unroll
    for (int q = 0; q < 9; ++q) urow[q] = (1024 * q + 16 * lane) >> 8;
    const unsigned uch = (unsigned)(n * 128 + (lane & 15) * 8);
    const unsigned gch = (unsigned)(LRU_W + n * 128 + cq * 32 + (lane & 3) * 8);
#define SCAN_UDMA(c) do { _Pragma("unroll") for (int q_ = 0; q_ < 9; ++q_) { const int sr_ = 256 * (c) - 3 + 32 * w + urow[q_]; \
        const bf16* s_ = (sr_ >= 0 && urow[q_] < 35) ? proj + (size_t)(b * S + sr_) * IN_A + uch : zsrc; \
        __builtin_amdgcn_global_load_lds((const unsigned*)s_, (LAS unsigned*)(lds + UT + w * UTW + q_ * 1024), 16, 0, 0); } } while (0)
#define SCAN_GDMA(c) do { _Pragma("unroll") for (int i_ = 0; i_ < 2; ++i_) \
        __builtin_amdgcn_global_load_lds((const unsigned*)(proj + (size_t)(b * S + 256 * (c) + 32 * w + 16 * i_ + (lane >> 2)) * IN_A + gch), (LAS unsigned*)(lds + GT + (2 * w + i_) * 1024), 16, 0, 0); } while (0)
    SCAN_UDMA(0); SCAN_GDMA(0);
    for (int i = tid; i < 640; i += NTHR) cwl[i] = i < 512 ? INF(11)[(l * 4 + (i >> 7)) * LRU_W + n * 128 + (i & 127)] : INF(12)[l * LRU_W + n * 128 + (i - 512)];
    bf16x8 wrf[8], wif[8];
    { const float* wrp = INF(13) + ((size_t)(l * 12 + n) * 128) * 128 + cq * 32 + r32; const float* wip = INF(15) + ((size_t)(l * 12 + n) * 128) * 128 + cq * 32 + r32;
#pragma unroll
      for (int s = 0; s < 8; ++s) { u32x4 a, c; const int k0 = 16 * s + 8 * hi;
          a.x = pk2(wrp[(k0 + 0) * 128], wrp[(k0 + 1) * 128]); a.y = pk2(wrp[(k0 + 2) * 128], wrp[(k0 + 3) * 128]); a.z = pk2(wrp[(k0 + 4) * 128], wrp[(k0 + 5) * 128]); a.w = pk2(wrp[(k0 + 6) * 128], wrp[(k0 + 7) * 128]);
          c.x = pk2(wip[(k0 + 0) * 128], wip[(k0 + 1) * 128]); c.y = pk2(wip[(k0 + 2) * 128], wip[(k0 + 3) * 128]); c.z = pk2(wip[(k0 + 4) * 128], wip[(k0 + 5) * 128]); c.w = pk2(wip[(k0 + 6) * 128], wip[(k0 + 7) * 128]);
          wrf[s] = __builtin_bit_cast(bf16x8, a); wif[s] = __builtin_bit_cast(bf16x8, c); } }
    const float br = INF(14)[l * LRU_W + col], bi = INF(16)[l * LRU_W + col];
    float sp8; { const float nl = -INF(17)[l * LRU_W + col]; sp8 = 8.0f * (nl > 20.f ? nl : log1pf(expf(nl))); }
    const int cg = tid & 15, rl = (tid >> 4) & 3;
    float hin = 0.f;
    VM_WAIT(); __syncthreads();
    for (int c = 0; c < 8; ++c) {
        const int t0 = b * S + c * 256;
        if (c > 0) asm volatile("s_waitcnt vmcnt(16)" ::: "memory");
        {
            const LAS unsigned char* ut = lds + UT + w * UTW + cg * 16;
            u32x4 uw[11];
#pragma unroll
            for (int r = 0; r < 11; ++r) uw[r] = *(const LAS u32x4*)(ut + (rl * 8 + r) * 256);
            float cw[4][8], cb[8];
#pragma unroll
            for (int k = 0; k < 4; ++k) { const f32x4 a = *(const LAS f32x4*)(cwl + k * 128 + cg * 8), bq = *(const LAS f32x4*)(cwl + k * 128 + cg * 8 + 4);
                cw[k][0] = a.x; cw[k][1] = a.y; cw[k][2] = a.z; cw[k][3] = a.w; cw[k][4] = bq.x; cw[k][5] = bq.y; cw[k][6] = bq.z; cw[k][7] = bq.w; }
            { const f32x4 a = *(const LAS f32x4*)(cwl + 512 + cg * 8), bq = *(const LAS f32x4*)(cwl + 512 + cg * 8 + 4); cb[0] = a.x; cb[1] = a.y; cb[2] = a.z; cb[3] = a.w; cb[4] = bq.x; cb[5] = bq.y; cb[6] = bq.z; cb[7] = bq.w; }
#pragma unroll
            for (int r = 0; r < 8; ++r) { float y[8];
#pragma unroll
                for (int i = 0; i < 8; ++i) y[i] = cb[i];
#pragma unroll
                for (int k = 0; k < 4; ++k) { const u32x4 q = uw[r + 3 - k];
                    y[0] += cw[k][0] * bflo(q.x); y[1] += cw[k][1] * bfhi(q.x); y[2] += cw[k][2] * bflo(q.y); y[3] += cw[k][3] * bfhi(q.y);
                    y[4] += cw[k][4] * bflo(q.z); y[5] += cw[k][5] * bfhi(q.z); y[6] += cw[k][6] * bflo(q.w); y[7] += cw[k][7] * bfhi(q.w); }
                u32x4 o; o.x = pk2(y[0], y[1]); o.y = pk2(y[2], y[3]); o.z = pk2(y[4], y[5]); o.w = pk2(y[6], y[7]);
                const int row = 32 * w + rl * 8 + r;
                *(LAS u32x4*)(yt + row * 256 + ((cg ^ (row & 15)) << 4)) = o; }
        }
        asm volatile("s_waitcnt lgkmcnt(0)" ::: "memory");
        if (c + 1 < 8) SCAN_UDMA(c + 1); else SCAN_UDMA(c);
        __syncthreads();
        f32x16 ar, ai;
#pragma unroll
        for (int i = 0; i < 16; ++i) { ar[i] = 0.f; ai[i] = 0.f; }
        { const int row = 32 * w + r32;
#pragma unroll
          for (int s = 0; s < 8; ++s) { const bf16x8 a = *(const LAS bf16x8*)(yt + row * 256 + (((2 * s + hi) ^ (row & 15)) << 4));
            ar = __builtin_amdgcn_mfma_f32_32x32x16_bf16(a, wrf[s], ar, 0, 0, 0); ai = __builtin_amdgcn_mfma_f32_32x32x16_bf16(a, wif[s], ai, 0, 0, 0); } }
        float P[16], hl[16], sA[4], sB[4];
        const int ycol = cq * 32 + r32;
#pragma unroll
        for (int j = 0; j < 4; ++j) {
#pragma unroll
            for (int ii = 0; ii < 4; ++ii) { const int i = 4 * j + ii, row = 32 * w + 8 * j + 4 * hi + ii;
                const float yv = bf1(*(const LAS bf16*)(yt + row * 256 + (((ycol >> 3) ^ (row & 15)) << 4) + (ycol & 7) * 2));
                const float rr = fast_sigmoid(ar[i] + br), ig = fast_sigmoid(ai[i] + bi);
                const float la = -rr * sp8; const float av = __expf(la); const float x2 = 2.0f * la;
                const float ser = -x2 * (1.0f + x2 * 0.5f * (1.0f + x2 * (1.0f / 3.0f) * (1.0f + x2 * 0.25f * (1.0f + x2 * 0.2f)))); const float om = x2 > -0.25f ? ser : 1.0f - av * av;
                const float bv = sqrtf(om) * (ig * yv);
                if (ii == 0) { P[i] = av; hl[i] = bv; } else { P[i] = P[i - 1] * av; hl[i] = av * hl[i - 1] + bv; } }
            sA[j] = P[4 * j + 3]; sB[j] = hl[4 * j + 3]; }
        float RA = 1.f, RB = 0.f, cA_[4], cB_[4];
#pragma unroll
        for (int j = 0; j < 4; ++j) { const float oA = __shfl_xor(sA[j], 32), oB = __shfl_xor(sB[j], 32);
            const float fA = hi ? oA : sA[j], fB = hi ? oB : sB[j], gA = hi ? sA[j] : oA, gB = hi ? sB[j] : oB;
            const float RA1 = RA * fA, RB1 = fA * RB + fB;
            cA_[j] = hi ? RA1 : RA; cB_[j] = hi ? RB1 : RB;
            RA = RA1 * gA; RB = gA * RB1 + gB; }
        if (hi == 0) { summ[(w * 32 + r32) * 2] = RA; summ[(w * 32 + r32) * 2 + 1] = RB; }
        __syncthreads();
        float H = hin, Hall = hin;
#pragma unroll
        for (int w2 = 0; w2 < 8; ++w2) { const float A = summ[(w2 * 32 + r32) * 2], Bv = summ[(w2 * 32 + r32) * 2 + 1]; if (w2 < w) H = A * H + Bv; Hall = A * Hall + Bv; }
        hin = Hall;
        asm volatile("s_waitcnt vmcnt(8)" ::: "memory");
#pragma unroll
        for (int j = 0; j < 4; ++j) { const float hs = cA_[j] * H + cB_[j];
#pragma unroll
            for (int ii = 0; ii < 4; ++ii) { const int i = 4 * j + ii, lr = 8 * j + 4 * hi + ii; const size_t t = (size_t)(t0 + 32 * w + lr);
                const float hv = hl[i] + P[i] * hs; const float g = gelu_tanh_f(bf1(*(const LAS bf16*)(lds + GT + (32 * w + lr) * 64 + r32 * 2)));
                ((GAS bf16*)ycat)[t * D + col] = (bf16)f2bf(g * hv); } }
        asm volatile("s_waitcnt lgkmcnt(0)" ::: "memory");
        if (c + 1 < 8) SCAN_GDMA(c + 1); else SCAN_GDMA(c);
    }
#undef SCAN_UDMA
#undef SCAN_GDMA
    VM_WAIT(); __syncthreads();
}

struct AttnDesc {
    const bf16* Q; long q_rs; int qdims; const float* qg; const float* tab;
    const bf16* K; long k_rs;
    const bf16* Vt; long vt_rs;
    bf16* O; long o_rs;
    int q0, ntiles, diag0; float scale_log2;
};
__device__ __forceinline__ int crow(int r, int hi) { return (r & 3) + 8 * (r >> 2) + 4 * hi; }
__device__ __forceinline__ void attn_unit(Frame& F, const AttnDesc& d) {
    constexpr int KB = 64 * 384, VB = 128 * 128, KOFF = 0, VOFF = 2 * KB;
    LAS unsigned char* lds = F.lds + RING_OFF;
    int lane_ = F.lane; asm volatile("" : "+v"(lane_));
    const int lane = lane_, w = F.wave, r32 = lane & 31, hi = lane >> 5, qloc = 32 * w + r32;
    const size_t trow = (size_t)(d.q0 + qloc);
    bf16x8 qb[12];
    {
        const bf16* qrow = d.Q + trow * d.q_rs;
        float ss = 0.f;
#pragma unroll
        for (int s = 0; s < 12; ++s) if (16 * s < d.qdims) { const u32x4 rw = *(const GAS u32x4*)(qrow + 16 * s + 8 * hi);
                ss += (bflo(rw.x) * bflo(rw.x) + bfhi(rw.x) * bfhi(rw.x)) + (bflo(rw.y) * bflo(rw.y) + bfhi(rw.y) * bfhi(rw.y)) + (bflo(rw.z) * bflo(rw.z) + bfhi(rw.z) * bfhi(rw.z)) + (bflo(rw.w) * bflo(rw.w) + bfhi(rw.w) * bfhi(rw.w)); }
        ss += __shfl_xor(ss, 32);
        const float rs = d.scale_log2 / sqrtf(ss / (float)d.qdims + EPS);
#define ATT_QF(s, qf) do { const u32x4 rw_ = *(const GAS u32x4*)(qrow + 16 * (s) + 8 * hi); const f32x4 ga = *(const GAS f32x4*)(d.qg + 16 * (s) + 8 * hi), gb = *(const GAS f32x4*)(d.qg + 16 * (s) + 8 * hi + 4); \
            qf[0] = bflo(rw_.x) * rs * ga.x; qf[1] = bfhi(rw_.x) * rs * ga.y; qf[2] = bflo(rw_.y) * rs * ga.z; qf[3] = bfhi(rw_.y) * rs * ga.w; \
            qf[4] = bflo(rw_.z) * rs * gb.x; qf[5] = bfhi(rw_.z) * rs * gb.y; qf[6] = bflo(rw_.w) * rs * gb.z; qf[7] = bfhi(rw_.w) * rs * gb.w; } while (0)
#define ATT_QPK(s, qf) do { u32x4 p_; p_.x = cvtpk(qf[0], qf[1]); p_.y = cvtpk(qf[2], qf[3]); p_.z = cvtpk(qf[4], qf[5]); p_.w = cvtpk(qf[6], qf[7]); qb[s] = __builtin_bit_cast(bf16x8, p_); } while (0)
#pragma unroll
        for (int s = 0; s < 8; ++s) {
            if (16 * s < d.qdims) { float qf[8]; ATT_QF(s, qf); ATT_QPK(s, qf); } else qb[s] = __builtin_bit_cast(bf16x8, (u32x4){0u, 0u, 0u, 0u});
            __builtin_amdgcn_sched_barrier(0); }
#pragma unroll
        for (int s = 8; s < 10; ++s) {
            if (16 * s < d.qdims) { float q1[8], q2[8]; ATT_QF(s, q1); ATT_QF(s + 2, q2);
                if (d.tab) { const float* tb = d.tab + trow * 64 + 16 * (s - 8) + 8 * hi;
#pragma unroll
                    for (int i = 0; i < 8; ++i) { const float c = ((const GAS float*)tb)[i], sn = ((const GAS float*)tb)[32 + i], t1 = q1[i], t2 = q2[i]; q1[i] = t1 * c - t2 * sn; q2[i] = t2 * c + t1 * sn; } }
                ATT_QPK(s, q1); ATT_QPK(s + 2, q2); }
            else { qb[s] = __builtin_bit_cast(bf16x8, (u32x4){0u, 0u, 0u, 0u}); qb[s + 2] = qb[s]; }
            __builtin_amdgcn_sched_barrier(0); }
#undef ATT_QF
#undef ATT_QPK
    }
    f32x16 o[4];
#pragma unroll
    for (int db = 0; db < 4; ++db)
#pragma unroll
        for (int i = 0; i < 16; ++i) o[db][i] = 0.f;
    float m_run = -1e30f, l_run = 0.f;
    unsigned kso[3], vso[2];
#pragma unroll
    for (int i = 0; i < 3; ++i) { const int a = 1024 * (3 * w + i) + 16 * lane, row = a / 384, cp = (a % 384) >> 4, c = (cp & ~7) | ((cp ^ (row >> 1)) & 7); kso[i] = (unsigned)(row * (int)d.k_rs + c * 8); }
#pragma unroll
    for (int i = 0; i < 2; ++i) { const int a = 1024 * (2 * w + i) + 16 * lane, row = a >> 7, cp = (a & 127) >> 4, c = cp ^ ((row >> 1) & 7); vso[i] = (unsigned)(row * (int)d.vt_rs + c * 8); }
    const int y = hi ^ ((r32 >> 1) & 7);
    int off4[4];
#pragma unroll
    for (int j = 0; j < 4; ++j) off4[j] = 16 * ((2 * j) ^ y);
#define ATT_DMA(jt, buf) do { const bf16* kg = d.K + (size_t)(64 * (jt)) * d.k_rs; const bf16* vg = d.Vt + 64 * (jt); \
        _Pragma("unroll") for (int i = 0; i < 3; ++i) __builtin_amdgcn_global_load_lds((const unsigned*)(kg + kso[i]), (LAS unsigned*)(lds + KOFF + (buf) * KB + 1024 * (3 * w + i)), 16, 0, 0); \
        _Pragma("unroll") for (int i = 0; i < 2; ++i) __builtin_amdgcn_global_load_lds((const unsigned*)(vg + vso[i]), (LAS unsigned*)(lds + VOFF + (buf) * VB + 1024 * (2 * w + i)), 16, 0, 0); } while (0)
    ATT_DMA(0, 0);
    VM_WAIT(); __syncthreads();
    for (int jt = 0; jt < d.ntiles; ++jt) {
        const int cur = jt & 1;
        if (jt + 1 < d.ntiles) ATT_DMA(jt + 1, cur ^ 1);
        const bool diag = jt >= d.diag0;
        const int keyl0 = 64 * (jt - d.diag0);
        if (!(diag && keyl0 > 32 * w + 31)) {
            f32x16 s0, s1;
#pragma unroll
            for (int i = 0; i < 16; ++i) { s0[i] = 0.f; s1[i] = 0.f; }
            const LAS unsigned char* kb = lds + KOFF + cur * KB + r32 * 384;
#pragma unroll
            for (int s = 0; s < 12; ++s) { const bf16x8 k0 = *(const LAS bf16x8*)(kb + 128 * (s >> 2) + off4[s & 3]), k1 = *(const LAS bf16x8*)(kb + 32 * 384 + 128 * (s >> 2) + off4[s & 3]);
                s0 = __builtin_amdgcn_mfma_f32_32x32x16_bf16(k0, qb[s], s0, 0, 0, 0); s1 = __builtin_amdgcn_mfma_f32_32x32x16_bf16(k1, qb[s], s1, 0, 0, 0); if ((s & 3) == 3) __builtin_amdgcn_sched_barrier(0); }
            if (diag) {
#pragma unroll
                for (int i = 0; i < 16; ++i) { const int kk = keyl0 + crow(i, hi); if (kk > qloc) s0[i] = -1e30f; if (kk + 32 > qloc) s1[i] = -1e30f; } }
            float mx = s0[0];
#pragma unroll
            for (int i = 1; i < 16; ++i) mx = fmaxf(mx, s0[i]);
#pragma unroll
            for (int i = 0; i < 16; ++i) mx = fmaxf(mx, s1[i]);
            mx = fmaxf(mx, __shfl_xor(mx, 32));
            if (__any(mx > m_run + 8.0f)) {
                const float m_new = mx > m_run + 8.0f ? mx : m_run, alpha = __builtin_amdgcn_exp2f(m_run - m_new);
                m_run = m_new; l_run *= alpha;
#pragma unroll
                for (int db = 0; db < 4; ++db)
#pragma unroll
                    for (int i = 0; i < 16; ++i) o[db][i] *= alpha;
            }
            float ls = 0.f;
#pragma unroll
            for (int i = 0; i < 16; ++i) { s0[i] = __builtin_amdgcn_exp2f(s0[i] - m_run); s1[i] = __builtin_amdgcn_exp2f(s1[i] - m_run); ls += s0[i] + s1[i]; }
            l_run += ls;
            bf16x8 pf[4];
            { u32x4 p;
              p.x = cvtpk(s0[0], s0[1]); p.y = cvtpk(s0[2], s0[3]); p.z = cvtpk(s0[4], s0[5]); p.w = cvtpk(s0[6], s0[7]); pf[0] = __builtin_bit_cast(bf16x8, p);
              p.x = cvtpk(s0[8], s0[9]); p.y = cvtpk(s0[10], s0[11]); p.z = cvtpk(s0[12], s0[13]); p.w = cvtpk(s0[14], s0[15]); pf[1] = __builtin_bit_cast(bf16x8, p);
              p.x = cvtpk(s1[0], s1[1]); p.y = cvtpk(s1[2], s1[3]); p.z = cvtpk(s1[4], s1[5]); p.w = cvtpk(s1[6], s1[7]); pf[2] = __builtin_bit_cast(bf16x8, p);
              p.x = cvtpk(s1[8], s1[9]); p.y = cvtpk(s1[10], s1[11]); p.z = cvtpk(s1[12], s1[13]); p.w = cvtpk(s1[14], s1[15]); pf[3] = __builtin_bit_cast(bf16x8, p); }
            const LAS unsigned char* vb = lds + VOFF + cur * VB + r32 * 128;
#pragma unroll
            for (int db = 0; db < 4; ++db)
#pragma unroll
                for (int ks = 0; ks < 4; ++ks) { const bf16x8 vf = *(const LAS bf16x8*)(vb + db * 32 * 128 + off4[ks]);
                    o[db] = __builtin_amdgcn_mfma_f32_32x32x16_bf16(vf, pf[ks], o[db], 0, 0, 0); if (ks & 1) __builtin_amdgcn_sched_barrier(0); }
        }
        VM_WAIT(); __syncthreads();
    }
#undef ATT_DMA
    const float inv = 1.0f / (l_run + __shfl_xor(l_run, 32));
    bf16* orow = d.O + trow * d.o_rs;
#pragma unroll
    for (int db = 0; db < 4; ++db)
#pragma unroll
        for (int j = 0; j < 4; ++j) { u32x2 q; q.x = cvtpk(o[db][4 * j] * inv, o[db][4 * j + 1] * inv); q.y = cvtpk(o[db][4 * j + 2] * inv, o[db][4 * j + 3] * inv);
            *(GAS u32x2*)(orow + 32 * db + 8 * j + 4 * hi) = q; }
}
__device__ __forceinline__ int claim_unit(Frame& F, gu32* q) {
    __syncthreads();
    if (F.tid == 0) F.MISC[0] = __hip_atomic_fetch_add((unsigned*)q, 1u, RLX_AGENT);
    __syncthreads();
    return (int)F.MISC[0];
}
__device__ __forceinline__ void mem_attn_unit(Frame& F, const Args& args, int l, int mu, int qcol0, int ldp) {
    const int b = mu >> 5, h = (mu >> 3) & 3, qb = mu & 7;
    AttnDesc d;
    d.Q = WSP(bf16, WS_PROJ) + qcol0 + h * 128; d.q_rs = ldp; d.qdims = 128; d.qg = INF(8) + l * 128; d.tab = nullptr;
    d.K = WSP(bf16, WS_MEMK) + ((size_t)(l * 1024 + b * 256) * 4 + h) * 192; d.k_rs = 768;
    d.Vt = WSP(bf16, WS_MEMVT) + ((size_t)((l * 4 + b) * 4 + h) * 128) * 256; d.vt_rs = 256;
    d.O = WSP(bf16, WS_YCAT) + MIX_W + h * 128; d.o_rs = D;
    d.q0 = b * S + qb * 256; d.ntiles = 4; d.diag0 = 4; d.scale_log2 = 0.08838834764831845f * 1.4426950408889634f;
    attn_unit(F, d);
}
__device__ __forceinline__ void mla_attn_unit(Frame& F, const Args& args, int l, int u) {
    const int qb = 7 - u / 48, bh = u % 48, b = bh / MLA_H, h = bh % MLA_H;
    AttnDesc d;
    d.Q = WSP(bf16, WS_QRAW) + h * 192; d.q_rs = QW; d.qdims = 192; d.qg = INF(27) + (l - NA) * 192; d.tab = WSP(float, WS_TAB);
    d.K = WSP(bf16, WS_K) + (size_t)(b * S) * QW + h * 192; d.k_rs = QW;
    d.Vt = WSP(bf16, WS_VT) + ((size_t)(b * MLA_H + h) * 128) * S; d.vt_rs = S;
    d.O = WSP(bf16, WS_YCAT) + h * 128; d.o_rs = D;
    d.q0 = b * S + qb * 256; d.ntiles = 4 * (qb + 1); d.diag0 = 4 * qb; d.scale_log2 = 0.07216878364870323f * 1.4426950408889634f;
    attn_unit(F, d);
}
typedef short v4i16_t __attribute__((ext_vector_type(4)));
constexpr int MSQ_BM = 320, MSQ_TAIL = 128;
__device__ __forceinline__ void moesq_split(int cnt, int& nm, int& hm, int& tail) {
    const int fl = cnt / MSQ_BM, rem = cnt - fl * MSQ_BM;
    if (fl > 0 && rem <= MSQ_TAIL) { nm = fl; hm = MSQ_BM; tail = rem; } else { nm = fl + 1; hm = (cnt + nm - 1) / nm; tail = 0; }
    if (cnt == 0) { nm = 0; hm = 1; tail = 0; }
}
__device__ __forceinline__ void moesq_table(Frame& F, int l, int ntl) {
    LAS int* tab = (LAS int*)(F.lds + MOE_TAB_OFF);
    __syncthreads();
    if (F.tid < 32) tab[33 + F.tid] = (int)__hip_atomic_load((unsigned*)(F.ctl + CW_MOECNT + (l * 32 + F.tid) * 64), RLX_AGENT);
    __syncthreads();
    if (F.tid == 0) { int s_ = 0, nm, hm, tl;
        for (int e = 0; e < 32; ++e) { tab[e] = s_; moesq_split(tab[33 + e], nm, hm, tl); s_ += nm * ntl; } tab[32] = s_;
        for (int e = 0; e < 32; ++e) { tab[65 + e] = s_; moesq_split(tab[33 + e], nm, hm, tl); s_ += tl > 0 ? ntl : 0; } tab[97] = s_; }
    __syncthreads();
}
struct MoeSqUnit { int e, pn, row0, rows, tile; };
struct MoeSqOrder {
    const LAS int* tab; int G, c;
    int s, o;
    __device__ bool next(int i, MoeSqUnit& u) const {
        const int L = c >= s ? (i < o ? i * (G - s) + (c - s) : o * (G - s) + (i - o) * G + c) : o * (G - s) + i * G + c; if (L >= tab[97]) return false;
        int nm, hm, tl;
        if (L < tab[32]) { int e = 0; while (e < 31 && L >= tab[e + 1]) ++e;
            const int local = L - tab[e], cnt = tab[33 + e]; moesq_split(cnt, nm, hm, tl);
            const int pm = local % nm, lim = cnt - tl;
            u.e = e; u.pn = local / nm; u.row0 = pm * hm; u.rows = lim - u.row0 < hm ? lim - u.row0 : hm; u.tile = pm; return true; }
        int e = 0; while (e < 31 && L >= tab[65 + e + 1]) ++e;
        const int cnt = tab[33 + e]; moesq_split(cnt, nm, hm, tl);
        u.e = e; u.pn = L - tab[65 + e]; u.row0 = cnt - tl; u.rows = tl; u.tile = 31; return true;
    }
};
__device__ __forceinline__ unsigned moe_off_b(unsigned row, unsigned ch) { return 256u * row + 16u * (ch ^ (((row & 3u) << 2) | ((row >> 2) & 3u))); }
template <bool G2>
__device__ __forceinline__ void moesq_phase(Frame& F, int l, const MoeSqOrder& So) {
    constexpr int K = G2 ? D_EXP : D, NT = K / 32, LDW = G2 ? D : D_EXP;
    constexpr int ASTG = 20480, BSTG = 16384, AOFF = 0, ADUMP = 4 * ASTG, BOFF = ADUMP + 1024, SOFF = BOFF + 2 * BSTG;
    static_assert(SOFF + 32768 <= RING_BYTES, "moesq lds");
    LAS unsigned char* lds = F.lds + RING_OFF;
    const int w = F.wave, wr = w >> 2, wc = w & 3;
    const bf16* Abase = G2 ? WSP(bf16, WS_H) : WSP(bf16, WS_XN);
    const int* lists = WSP(int, WS_LISTS);
    MoeSqUnit u;
    for (int ui = 0; So.next(ui, u); ++ui) {
        int lane_ = F.lane; asm volatile("" : "+v"(lane_));
        const int lane = lane_, r16 = lane & 15, kg = lane >> 4;
    const int hf = lane >> 5;
        unsigned bw[2];
#pragma unroll
        for (int i = 0; i < 2; ++i) bw[i] = (unsigned)(hf * 8192) + moe_off_b((unsigned)(w + 8 * i), (unsigned)((lane & 31) >> 1)) + 8u * (lane & 1);
        const int e = u.e, rows = u.rows;
        const size_t eo = (size_t)(l * 32 + e);
        const float* wsrc = !G2 ? (hf ? INF(33) : INF(32)) + eo * D * D_EXP + (size_t)w * D_EXP + u.pn * 128 + 4 * (lane & 31)
                                : INF(34) + eo * D_EXP * D + (size_t)w * D + u.pn * 256 + 4 * lane;
        unsigned aoff[3];
#pragma unroll
        for (int j = 0; j < 3; ++j) { int r = 16 * (3 * w + j) + r16; r = r < rows ? r : rows - 1; const int ent = ((const GAS int*)lists)[e * LCAP + u.row0 + r]; aoff[j] = (unsigned)((G2 ? ent : (ent >> 1)) * K + kg * 8) * 2u; }
        asm volatile("" : "+v"(aoff[0]), "+v"(aoff[1]), "+v"(aoff[2]));
        f32x4 acc[10][4];
#pragma unroll
        for (int i = 0; i < 10; ++i)
#pragma unroll
            for (int j = 0; j < 4; ++j) acc[i][j] = (f32x4){0.f, 0.f, 0.f, 0.f};
        const bool active = 16 * wr < rows;
#define MSQ_ADMA(tile, st) do { __builtin_amdgcn_sched_barrier(0); asm volatile("" ::: "memory"); const int tl_ = (tile) < NT ? (tile) : NT - 1; const char* ag_ = (const char*)Abase + (size_t)tl_ * 64; _Pragma("unroll") for (int j_ = 0; j_ < 3; ++j_) \
        __builtin_amdgcn_global_load_lds((const unsigned*)(ag_ + aoff[j_]), (LAS unsigned*)(lds + (3 * w + j_ < 20 ? AOFF + (st) * ASTG + (3 * w + j_) * 1024 : ADUMP)), 16, 0, 0); __builtin_amdgcn_sched_barrier(0); asm volatile("" ::: "memory"); } while (0)
#define MSQ_WLOAD(tile, W_) do { __builtin_amdgcn_sched_barrier(0); const int tl_ = (tile) < NT ? (tile) : NT - 1; const GAS float* ws_ = (const GAS float*)(wsrc + (size_t)tl_ * 32 * LDW); \
        _Pragma("unroll") for (int i_ = 0; i_ < 4; ++i_) asm volatile("global_load_dwordx4 %0, %1, off" : "=v"(W_[i_]) : "v"(ws_ + (size_t)(8 * i_) * LDW) : "memory"); __builtin_amdgcn_sched_barrier(0); } while (0)
#define MSQ_WWAIT(n, W_) asm volatile("s_waitcnt vmcnt(" #n ")" : "+v"(W_[0]), "+v"(W_[1]), "+v"(W_[2]), "+v"(W_[3]) :: "memory")
#define MSQ_WSTORE(st, W_) do { _Pragma("unroll") for (int i_ = 0; i_ < 4; ++i_) { u32x2 q_; q_.x = cvtpk(W_[i_].x, W_[i_].y); q_.y = cvtpk(W_[i_].z, W_[i_].w); \
        *(LAS u32x2*)(lds + BOFF + (st) * BSTG + bw[i_ & 1] + (i_ >> 1) * 4096) = q_; } } while (0)
#define MSQ_WLOAD_S(tile) do { __builtin_amdgcn_sched_barrier(0); asm volatile("" ::: "memory"); const int tl_ = (tile) < NT ? (tile) : NT - 1; const float* ws_ = wsrc + (size_t)tl_ * 32 * LDW; \
        _Pragma("unroll") for (int i_ = 0; i_ < 4; ++i_) __builtin_amdgcn_global_load_lds((const unsigned*)(ws_ + (size_t)(8 * i_) * LDW), (LAS unsigned*)(lds + SOFF + (w + 8 * i_) * 1024), 16, 0, 0); \
        __builtin_amdgcn_sched_barrier(0); asm volatile("" ::: "memory"); } while (0)
#define MSQ_WSTORE_S(st) do { f32x4 v_[4]; _Pragma("unroll") for (int i_ = 0; i_ < 4; ++i_) v_[i_] = *(const LAS f32x4*)(lds + SOFF + (w + 8 * i_) * 1024 + lane * 16); MSQ_WSTORE(st, v_); } while (0)
#define MSQ_MM4(i0, AD_) do { bf16x8 x0_, x1_, x2_, x3_; \
        asm volatile("ds_read_b128 %[x0], %[ad] offset:%[o0]\n\tds_read_b128 %[x1], %[ad] offset:%[o1]\n\tds_read_b128 %[x2], %[ad] offset:%[o2]\n\tds_read_b128 %[x3], %[ad] offset:%[o3]\n\t" \
                     "s_waitcnt lgkmcnt(3)\n\tv_mfma_f32_16x16x32_bf16 %[a0], %[w0], %[x0], %[a0]\n\tv_mfma_f32_16x16x32_bf16 %[b0], %[w1], %[x0], %[b0]\n\t" \
                     "s_waitcnt lgkmcnt(2)\n\tv_mfma_f32_16x16x32_bf16 %[a1], %[w0], %[x1], %[a1]\n\tv_mfma_f32_16x16x32_bf16 %[b1], %[w1], %[x1], %[b1]\n\t" \
                     "s_waitcnt lgkmcnt(1)\n\tv_mfma_f32_16x16x32_bf16 %[a2], %[w0], %[x2], %[a2]\n\tv_mfma_f32_16x16x32_bf16 %[b2], %[w1], %[x2], %[b2]\n\t" \
                     "s_waitcnt lgkmcnt(0)\n\tv_mfma_f32_16x16x32_bf16 %[a3], %[w0], %[x3], %[a3]\n\tv_mfma_f32_16x16x32_bf16 %[b3], %[w1], %[x3], %[b3]" \
            : [a0] "+v"(acc[(i0)][2 * hh]), [b0] "+v"(acc[(i0)][2 * hh + 1]), [a1] "+v"(acc[(i0) + 1][2 * hh]), [b1] "+v"(acc[(i0) + 1][2 * hh + 1]), \
              [a2] "+v"(acc[(i0) + 2][2 * hh]), [b2] "+v"(acc[(i0) + 2][2 * hh + 1]), [a3] "+v"(acc[(i0) + 3][2 * hh]), [b3] "+v"(acc[(i0) + 3][2 * hh + 1]), \
              [x0] "=&v"(x0_), [x1] "=&v"(x1_), [x2] "=&v"(x2_), [x3] "=&v"(x3_) \
            : [w0] "v"(wf0), [w1] "v"(wf1), [ad] "v"(AD_), [o0] "n"((i0) * 2048), [o1] "n"((i0) * 2048 + 2048), [o2] "n"((i0) * 2048 + 4096), [o3] "n"((i0) * 2048 + 6144) : "memory"); } while (0)
#define MSQ_MM2(i0, AD_) do { bf16x8 x0_, x1_; \
        asm volatile("ds_read_b128 %[x0], %[ad] offset:%[o0]\n\tds_read_b128 %[x1], %[ad] offset:%[o1]\n\t" \
                     "s_waitcnt lgkmcnt(1)\n\tv_mfma_f32_16x16x32_bf16 %[a0], %[w0], %[x0], %[a0]\n\tv_mfma_f32_16x16x32_bf16 %[b0], %[w1], %[x0], %[b0]\n\t" \
                     "s_waitcnt lgkmcnt(0)\n\tv_mfma_f32_16x16x32_bf16 %[a1], %[w0], %[x1], %[a1]\n\tv_mfma_f32_16x16x32_bf16 %[b1], %[w1], %[x1], %[b1]" \
            : [a0] "+v"(acc[(i0)][2 * hh]), [b0] "+v"(acc[(i0)][2 * hh + 1]), [a1] "+v"(acc[(i0) + 1][2 * hh]), [b1] "+v"(acc[(i0) + 1][2 * hh + 1]), [x0] "=&v"(x0_), [x1] "=&v"(x1_) \
            : [w0] "v"(wf0), [w1] "v"(wf1), [ad] "v"(AD_), [o0] "n"((i0) * 2048), [o1] "n"((i0) * 2048 + 2048) : "memory"); } while (0)
#define MSQ_TRA(jc_, tt_) (moe_off_b(8u * kg_ + 4u * (tt_) + trq, 2u * (G2 ? (unsigned)(4 * (wc & 1) + 2 * hh + (jc_)) : (unsigned)(2 * wc + (jc_))) + (trp >> 1)) + 8u * (trp & 1))
#define MSQ_TRAH(hh_, jc_, tt_) ((G2 ? 0u : (unsigned)((hh_) * 8192)) + moe_off_b(8u * kg_ + 4u * (tt_) + trq, 2u * (G2 ? (unsigned)(4 * (wc & 1) + 2 * (hh_) + (jc_)) : (unsigned)(2 * wc + (jc_))) + (trp >> 1)) + 8u * (trp & 1))
#define MSQ_MMQ2(i0, AD_) do { bf16x8 x0_, x1_; \
        asm volatile("ds_read_b128 %[x0], %[ad] offset:%[o0]\n\tds_read_b128 %[x1], %[ad] offset:%[o1]\n\t" \
                     "s_waitcnt lgkmcnt(1)\n\tv_mfma_f32_16x16x32_bf16 %[a0], %[w0], %[x0], %[a0]\n\tv_mfma_f32_16x16x32_bf16 %[a1], %[w1], %[x0], %[a1]\n\tv_mfma_f32_16x16x32_bf16 %[a2], %[w2], %[x0], %[a2]\n\tv_mfma_f32_16x16x32_bf16 %[a3], %[w3], %[x0], %[a3]\n\t" \
                     "s_waitcnt lgkmcnt(0)\n\tv_mfma_f32_16x16x32_bf16 %[b0], %[w0], %[x1], %[b0]\n\tv_mfma_f32_16x16x32_bf16 %[b1], %[w1], %[x1], %[b1]\n\tv_mfma_f32_16x16x32_bf16 %[b2], %[w2], %[x1], %[b2]\n\tv_mfma_f32_16x16x32_bf16 %[b3], %[w3], %[x1], %[b3]" \
            : [a0] "+v"(acc[(i0)][0]), [a1] "+v"(acc[(i0)][1]), [a2] "+v"(acc[(i0)][2]), [a3] "+v"(acc[(i0)][3]), \
              [b0] "+v"(acc[(i0) + 1][0]), [b1] "+v"(acc[(i0) + 1][1]), [b2] "+v"(acc[(i0) + 1][2]), [b3] "+v"(acc[(i0) + 1][3]), [x0] "=&v"(x0_), [x1] "=&v"(x1_) \
            : [w0] "v"(wf0), [w1] "v"(wf1), [w2] "v"(wf2), [w3] "v"(wf3), [ad] "v"(AD_), [o0] "n"((i0) * 2048), [o1] "n"((i0) * 2048 + 2048) : "memory"); } while (0)
#define MSQ_COMPUTE(sa_, sb_) do { if (active) { \
            const unsigned abs_ = (unsigned)(__SIZE_TYPE__)(lds + AOFF + (sa_) * ASTG + wr * 1024 + lane * 16); \
            const unsigned bbs = (unsigned)(__SIZE_TYPE__)(lds + BOFF + (sb_) * BSTG + (G2 ? (wc >> 1) * 8192 : 0)); \
            int ln_ = lane; asm volatile("" : "+v"(ln_));         \
            const unsigned kg_ = (unsigned)ln_ >> 4, trq = ((unsigned)ln_ & 15u) >> 2, trp = (unsigned)ln_ & 3u; \
            v4i16_t t0, t1, t2, t3, t4, t5, t6, t7;        \
            asm volatile("ds_read_b64_tr_b16 %0, %8\n\tds_read_b64_tr_b16 %1, %9\n\tds_read_b64_tr_b16 %2, %10\n\tds_read_b64_tr_b16 %3, %11\n\t" \
                         "ds_read_b64_tr_b16 %4, %12\n\tds_read_b64_tr_b16 %5, %13\n\tds_read_b64_tr_b16 %6, %14\n\tds_read_b64_tr_b16 %7, %15\n\ts_waitcnt lgkmcnt(0)" \
                : "=&v"(t0), "=&v"(t1), "=&v"(t2), "=&v"(t3), "=&v"(t4), "=&v"(t5), "=&v"(t6), "=&v"(t7) \
                : "v"(bbs + MSQ_TRAH(0, 0, 0)), "v"(bbs + MSQ_TRAH(0, 0, 1)), "v"(bbs + MSQ_TRAH(0, 1, 0)), "v"(bbs + MSQ_TRAH(0, 1, 1)), \
                  "v"(bbs + MSQ_TRAH(1, 0, 0)), "v"(bbs + MSQ_TRAH(1, 0, 1)), "v"(bbs + MSQ_TRAH(1, 1, 0)), "v"(bbs + MSQ_TRAH(1, 1, 1)) : "memory"); \
            const bf16x8 wf0 = (bf16x8){t0[0], t0[1], t0[2], t0[3], t1[0], t1[1], t1[2], t1[3]}, wf1 = (bf16x8){t2[0], t2[1], t2[2], t2[3], t3[0], t3[1], t3[2], t3[3]}, \
                         wf2 = (bf16x8){t4[0], t4[1], t4[2], t4[3], t5[0], t5[1], t5[2], t5[3]}, wf3 = (bf16x8){t6[0], t6[1], t6[2], t6[3], t7[0], t7[1], t7[2], t7[3]}; \
            MSQ_MMQ2(0, abs_); MSQ_MMQ2(2, abs_); if (g1) { MSQ_MMQ2(4, abs_); MSQ_MMQ2(6, abs_); } if (g2) MSQ_MMQ2(8, abs_); } } while (0)
#define MSQ_STEP_S(t, k_) do { MSQ_ADMA((t) + 3, ((k_) + 3) & 3); MSQ_COMPUTE((k_) & 3, (k_) & 1); asm volatile("s_waitcnt vmcnt(10)" ::: "memory"); MSQ_WSTORE_S(((k_) + 1) & 1); MSQ_WLOAD_S((t) + 3); \
            asm volatile("s_waitcnt vmcnt(18)" ::: "memory"); asm volatile("s_waitcnt lgkmcnt(0)" ::: "memory"); __builtin_amdgcn_s_barrier(); asm volatile("" ::: "memory"); } while (0)
#define MSQ_STEP(t, k_, WS_) do { MSQ_ADMA((t) + 3, ((k_) + 3) & 3); MSQ_COMPUTE((k_) & 3, (k_) & 1); MSQ_WWAIT(10, WS_); MSQ_WSTORE(((k_) + 1) & 1, WS_); MSQ_WLOAD((t) + 3, WS_); \
            asm volatile("s_waitcnt vmcnt(18)" ::: "memory"); asm volatile("s_waitcnt lgkmcnt(0)" ::: "memory"); __builtin_amdgcn_s_barrier(); asm volatile("" ::: "memory"); } while (0)
        const bool g1 = 16 * (8 + wr) < rows, g2 = 16 * (16 + wr) < rows;
        f32x4 wB[4];
        if (G2) {
            if (F.tid == 0) { gu32* dn = F.ctl + CW_MOEDONE + ((l * 32 + e) * 32 + u.tile) * 16; unsigned sp_ = 0;
                while (__hip_atomic_load((unsigned*)dn, RLX_AGENT) < 4u) { __builtin_amdgcn_s_sleep(1); if (++sp_ > (1u << 20)) break; }
                __builtin_amdgcn_fence(__ATOMIC_ACQUIRE, "agent"); asm volatile("s_waitcnt vmcnt(0)" ::: "memory"); }
            __syncthreads();
        }
        MSQ_WLOAD_S(0); MSQ_ADMA(0, 0); MSQ_ADMA(1, 1); MSQ_WLOAD(1, wB);
        asm volatile("s_waitcnt vmcnt(10)" ::: "memory"); MSQ_WSTORE_S(0);
        MSQ_ADMA(2, 2); MSQ_WLOAD_S(2);
        asm volatile("s_waitcnt vmcnt(14)" ::: "memory");
        asm volatile("s_waitcnt lgkmcnt(0)" ::: "memory"); __builtin_amdgcn_s_barrier(); asm volatile("" ::: "memory");
        for (int t = 0; t < NT; t += 4) { MSQ_STEP(t, 0, wB); MSQ_STEP_S(t + 1, 1); MSQ_STEP(t + 2, 2, wB); MSQ_STEP_S(t + 3, 3); }
        MSQ_WWAIT(0, wB);
        if (active) {
            int le_ = F.lane; asm volatile("" : "+v"(le_)); const int r16e = le_ & 15, kge = le_ >> 4;
#pragma unroll
            for (int i = 0; i < 10; ++i) { int r = 16 * (2 * i + wr) + r16e; asm volatile("" : "+v"(r));
                if (r < rows) { const int slot = ((const GAS int*)lists)[e * LCAP + u.row0 + r];
                    if (!G2) { const float rsd = ((const GAS float*)WSP(float, WS_RSTD))[slot >> 1], gw = ((const GAS float*)WSP(float, WS_SELW))[slot] * rsd;
#pragma unroll
                        for (int jp = 0; jp < 2; ++jp) { const f32x4 g = acc[i][jp] * rsd, up = acc[i][jp + 2]; u32x2 q;
                            q.x = cvtpk(g.x * fast_sigmoid(g.x) * up.x * gw, g.y * fast_sigmoid(g.y) * up.y * gw); q.y = cvtpk(g.z * fast_sigmoid(g.z) * up.z * gw, g.w * fast_sigmoid(g.w) * up.w * gw);
                            __hip_atomic_store((GAS unsigned long long*)(WSP(bf16, WS_H) + (size_t)slot * D_EXP + u.pn * 128 + 16 * (2 * wc + jp) + 4 * kge), (unsigned long long)q.x | ((unsigned long long)q.y << 32), RLX_AGENT); } }
                    else {
#pragma unroll
                        for (int j = 0; j < 4; ++j) { const f32x4 v = acc[i][j]; u32x2 q; q.x = cvtpk(v.x, v.y); q.y = cvtpk(v.z, v.w);
                            *(GAS u32x2*)(WSP(bf16, WS_OSLOT) + (size_t)slot * D + u.pn * 256 + 128 * (wc >> 1) + 16 * (4 * (wc & 1) + j) + 4 * kge) = q; } } } }
        }
        if (!G2) {
            asm volatile("s_waitcnt vmcnt(0)" ::: "memory"); asm volatile("s_waitcnt lgkmcnt(0)" ::: "memory"); __builtin_amdgcn_s_barrier(); asm volatile("" ::: "memory");
            if (F.tid == 0) (void)__hip_atomic_fetch_add((unsigned*)(F.ctl + CW_MOEDONE + ((l * 32 + e) * 32 + u.tile) * 16), 1u, RLX_AGENT);
        } else { asm volatile("s_waitcnt lgkmcnt(0)" ::: "memory"); __builtin_amdgcn_s_barrier(); asm volatile("" ::: "memory"); }
#undef MSQ_ADMA
#undef MSQ_WLOAD
#undef MSQ_WSTORE
#undef MSQ_COMPUTE
#undef MSQ_MM4
#undef MSQ_TRA
#undef MSQ_TRAH
#undef MSQ_MMQ2
#undef MSQ_STEP
#undef MSQ_STEP_S
#undef MSQ_WLOAD_S
#undef MSQ_WSTORE_S
    }
}
constexpr int NPHASE = 37;
__device__ __forceinline__ bool relaunder(Frame& F) { int t = threadIdx.x; asm volatile("" : "+v"(t)); F.tid = t; F.lane = t & 63; unsigned char* w = F.ws; asm volatile("" : "+s"(w)); F.ws = w;
    const __attribute__((address_space(4))) char* ka = (const __attribute__((address_space(4))) char*)__builtin_amdgcn_kernarg_segment_ptr(); asm volatile("" : "+s"(ka)); F.ka = ka; return true; }
#ifndef MK_BODIES
#define MK_BODIES 0xFFFF
#endif
#ifndef MK_REP
#define MK_REP 0
#endif
#define BODY(bit) if constexpr ((MK_BODIES & (bit)) != 0) for (int rep_ = 0; rep_ < (((MK_REP) & (bit)) ? 2 : 1); ++rep_)
__global__ void __launch_bounds__(NTHR, 2) mk_fwd(Args args) {
    extern __shared__ __attribute__((aligned(16))) unsigned char lds_raw[];
    Frame F;
    F.lds = (LAS unsigned char*)lds_raw; F.MISC = (volatile LAS unsigned*)(F.lds + MISC_OFF);
    F.tid = threadIdx.x; F.lane = F.tid & 63; F.wave = __builtin_amdgcn_readfirstlane(F.tid >> 6); F.G = gridDim.x; F.bid = blockIdx.x;
    F.ws = args.ws; F.ctl = (gu32*)(args.ws + WS_CTL);
    for (int u = F.tid; u < (LDS_BYTES - LDSCTL_OFF) / 4; u += NTHR) ((LAS unsigned*)(F.lds + LDSCTL_OFF))[u] = 0u;
    __syncthreads();
#ifdef MK_FIX_LO
    const int lo = MK_FIX_LO, hi = MK_FIX_HI;
#else
    const int lo = args.ph_lo, hi = args.ph_hi;
#endif
    XcdBarrier bar; bar.bar = (unsigned*)(F.ctl + CW_BAR); bar.x = 0; bar.st = nullptr;
    if (hi - lo > 1) bar = xcd_barrier_post((unsigned*)(F.ctl + CW_BAR), F.MISC + 8);
#define PH(id) if (lo <= (id) && (id) < hi && relaunder(F))
#if MK_STAMP
#define SEAM(id) do { if ((id) + 1 < hi) xcd_barrier(bar); if (blockIdx.x == 0 && threadIdx.x == 0) ((unsigned long long*)(F.ctl + CW_STAMP))[(id) + 1] = __builtin_amdgcn_s_memrealtime(); } while (0)
#else
#define SEAM(id) do { if ((id) + 1 < hi) xcd_barrier(bar); } while (0)
#endif
    float* xres = args.out;
    const int vcu = (F.G % 8 == 0) ? (F.bid % 8) * (F.G / 8) + F.bid / 8 : F.bid;
#if MK_STAMP
    if (blockIdx.x == 0 && threadIdx.x == 0) ((unsigned long long*)(F.ctl + CW_STAMP))[0] = __builtin_amdgcn_s_memrealtime();
#endif
    LAS unsigned char* ring = F.lds + RING_OFF;

    PH(0) { BODY(1) { p0_prologue(F, args);
#if !MK_MOESQ
#if MK_BGCONV
        conv_experts(F, args, 0);
#else
        for (int l = 0; l < DEPTH; ++l) conv_experts(F, args, l);
#endif
#endif
    } SEAM(0); }
    for (int l = 0; l < DEPTH; ++l) {
        const int j = l - NA;
        const int pb = l < NA ? 1 + 8 * l : 17 + 10 * (l - NA);
        const int tb = l < NA ? pb + 3 : pb + 5;
        if (l < NA) {
            PH(pb + 0) {
                if (l == 0) {
                    pg8::Dense2Prob P{WSP(bf16, WS_XN), WSP(bf16, WS_WT_INA), WSP(bf16, WS_MEMN), WSP(bf16, WS_WT_MKV), D, 4, 1024}; pg8::Order2 So{T / 256, IN_A / 256, 4096 / 256, 1024 / 256, F.G, vcu};
                    pg8::EpiBf16x2 E{WSP(bf16, WS_PROJ), IN_A, WSP(bf16, WS_MKVR), 1024};
                    BODY(2) pg8::gemm_phase<pg8::Dense2Prob, pg8::EpiBf16x2, pg8::Order2, true>(ring, P, So, E);
                } else {
                    pg8::DenseProb P{WSP(bf16, WS_XN), WSP(bf16, WS_WT_INA) + (size_t)l * IN_A * D, D, IN_A}; pg8::StaticOrder So; So.init(T, IN_A, F.G, F.bid, 1 << 20);
                    pg8::EpiBf16 E{WSP(bf16, WS_PROJ), IN_A};
                    BODY(2) pg8::gemm_phase<pg8::DenseProb, pg8::EpiBf16, pg8::StaticOrder, true>(ring, P, So, E);
#if MK_BGCONV
                    if (F.G == 256 && F.bid >= 192) conv_quota(F, args, MK_Q_INA);
#endif
                }
                SEAM(pb + 0);
            }
            PH(pb + 1) {
                BODY(8) for (int u = F.bid; u < 192; u += F.G) scan_unit(F, args, l, u);
                if (l == 0) { BODY(4) { if (F.G > 192) { if (F.bid >= 192) mem_assemble(F, args, (F.bid - 192) * NWAVES + F.wave, (F.G - 192) * NWAVES); } else mem_assemble(F, args, F.bid * NWAVES + F.wave, F.G * NWAVES); } }
                else { gu32* q = F.ctl + CW_ATTQ + l * 64;
                    BODY(16) for (int u = claim_unit(F, q); u < 128; u = claim_unit(F, q)) mem_attn_unit(F, args, l, u, 2 * LRU_W, IN_A); }
#if MK_BGCONV
                if (F.G == 256 && F.bid >= 192) conv_quota(F, args, l == 0 ? MK_Q_SCAN0 : MK_Q_SCAN1);
#endif
                SEAM(pb + 1);
            }
            if (l == 0) { PH(pb + 2) {
                gu32* q = F.ctl + CW_ATTQ + l * 64;
                BODY(16) for (int u = claim_unit(F, q); u < 128; u = claim_unit(F, q)) mem_attn_unit(F, args, l, u, 2 * LRU_W, IN_A);
                SEAM(pb + 2);
            } }
        } else {
            PH(pb + 0) {
                if (l == NA) {
                    const bf16* xa1 = WSP(bf16, WS_XN); asm volatile("" : "+s"(xa1));
                    pg8::Dense2Prob P{WSP(bf16, WS_XN), WSP(bf16, WS_WT_INB) + (size_t)j * IN_B * D, xa1, WSP(bf16, WS_WT_DKV), D, 1 << 20, 512}; pg8::Order2 So{T / 256, IN_B / 256, T / 256, 512 / 256, F.G, vcu};
                    pg8::EpiBf16x2 E{WSP(bf16, WS_PROJ), IN_B, WSP(bf16, WS_CKV), 512};
                    BODY(2) pg8::gemm_phase<pg8::Dense2Prob, pg8::EpiBf16x2, pg8::Order2, true>(ring, P, So, E);
#if MK_BGCONV
                    if (F.G == 256 && vcu >= 192) conv_quota(F, args, MK_Q_INB);
#endif
                } else {
                    pg8::DenseProb P{WSP(bf16, WS_XN), WSP(bf16, WS_WT_INB) + (size_t)j * IN_B * D, D, IN_B}; pg8::StaticOrder So; So.init(T, IN_B, F.G, F.bid, 1 << 20);
                    pg8::EpiBf16 E{WSP(bf16, WS_PROJ), IN_B};
                    BODY(2) pg8::gemm_phase<pg8::DenseProb, pg8::EpiBf16, pg8::StaticOrder, true>(ring, P, So, E);
#if MK_BGCONV
                    if (F.G == 256 && F.bid >= 128) conv_quota(F, args, MK_Q_INB);
#endif
                }
                SEAM(pb + 0);
            }
            PH(pb + 1) {
                BODY(512) { norm_bf16_rows<8>(F, WSP(bf16, WS_PROJ), IN_B, INF(25) + j * Q_RANK, WSP(bf16, WS_CQN), Q_RANK, T);
                            if (l == NA) norm_bf16_rows<4>(F, WSP(bf16, WS_CKV), 512, INF(20), WSP(bf16, WS_CN), 256, T); }
                SEAM(pb + 1);
            }
            PH(pb + 2) {
                if (l == NA) {
                    pg8::DenseProb P{WSP(bf16, WS_CN), WSP(bf16, WS_WT_UKV), KV_RANK, 3072}; pg8::StaticOrder So; So.init(T, 3072, F.G, F.bid, 1 << 20);
                    pg8::EpiBf16 E{WSP(bf16, WS_KVUP), 3072};
                    BODY(2) pg8::gemm_phase<pg8::DenseProb, pg8::EpiBf16, pg8::StaticOrder, true>(ring, P, So, E);
                }
                {
                    pg8::DenseProb P{WSP(bf16, WS_CQN), WSP(bf16, WS_WT_UQ) + (size_t)j * QW * Q_RANK, Q_RANK, QW}; pg8::StaticOrder So; So.init(T, QW, F.G, l == NA ? (F.bid + F.G / 2) % F.G : F.bid, 1 << 20);
                    pg8::EpiBf16 E{WSP(bf16, WS_QRAW), QW};
                    BODY(2) pg8::gemm_phase<pg8::DenseProb, pg8::EpiBf16, pg8::StaticOrder, true>(ring, P, So, E);
                }
                SEAM(pb + 2);
            }
            if (l == NA) { PH(pb + 3) { BODY(4) kv_assemble(F, args); SEAM(pb + 3); } }
            PH(pb + 4) {
                gu32* q = F.ctl + CW_ATTQ + l * 64;
                BODY(16) for (int u = claim_unit(F, q); u < 384 + 128; u = claim_unit(F, q)) { if (u < 384) mla_attn_unit(F, args, l, u); else mem_attn_unit(F, args, l, u - 384, Q_RANK, IN_B); }
                SEAM(pb + 4);
            }
        }
        PH(tb + 0) {
            pg8::DenseProb P{WSP(bf16, WS_YCAT), WSP(bf16, WS_WT_O) + (size_t)l * D * D, D, D}; pg8::StaticOrder So; So.init(T, D, F.G, F.bid, 1 << 20);
            const bf16* rth = WSP(bf16, WS_WT_RT) + (size_t)l * 2 * 48 * D;
            if (l == 0) { pg8::EpiResRouter<true> E{(const void*)INF(0), nullptr, nullptr, D, INF(4) + l * D, WSP(bf16, WS_XN), rth, rth + 48 * D, WSP(float, WS_RPART), WSP(float, WS_RPSS), T, ring};
                BODY(32) pg8::gemm_phase<pg8::DenseProb, pg8::EpiResRouter<true>, pg8::StaticOrder, true>(ring, P, So, E); }
            else { pg8::EpiResRouter<false> E{(const void*)WSP(bf16, WS_XN), INF(3) + l * D, WSP(float, WS_IRS), D, INF(4) + l * D, WSP(bf16, WS_XN), rth, rth + 48 * D, WSP(float, WS_RPART), WSP(float, WS_RPSS), T, ring};
                BODY(32) pg8::gemm_phase<pg8::DenseProb, pg8::EpiResRouter<false>, pg8::StaticOrder, true>(ring, P, So, E); }
            SEAM(tb + 0);
        }
        PH(tb + 1) { BODY(64) { router_phase(F, args, l, xres);
#if MK_BGCONV
            if (l >= 1) conv_drain(F, args, l);
#endif
        } SEAM(tb + 1); }
#if MK_MOESQ
        PH(tb + 2) {
            { moesq_table(F, l, 4); MoeSqOrder So{(const LAS int*)(F.lds + MOE_TAB_OFF), F.G, vcu, 0, 0}; BODY(128) moesq_phase<false>(F, l, So); }
            { moesq_table(F, l, 8); const LAS int* tab = (const LAS int*)(F.lds + MOE_TAB_OFF); MoeSqOrder So{tab, F.G, vcu, (tab[97] >> 1) % F.G, 2}; BODY(256) moesq_phase<true>(F, l, So); }
            SEAM(tb + 2); }
#else
        PH(tb + 2) {
            moe_table(F, l, 4);
            pg8::GatherProb P{WSP(bf16, WS_XN), WSP(bf16, WS_WT_EGU), D, 1024, WSP(int, WS_LISTS), LCAP, 1, l * 32}; pg8::MoeOrder So{(const LAS int*)(F.lds + MOE_TAB_OFF), F.G, vcu, 4};
            pg8::EpiMoe1 E{WSP(bf16, WS_H), WSP(int, WS_LISTS), WSP(float, WS_SELW), LCAP};
            BODY(128) pg8::gemm_phase<pg8::GatherProb, pg8::EpiMoe1, pg8::MoeOrder, true>(ring, P, So, E);
            SEAM(tb + 2);
        }
        PH(tb + 3) {
            moe_table(F, l, 8);
            pg8::GatherProb P{WSP(bf16, WS_H), WSP(bf16, WS_WT_ED), D_EXP, D, WSP(int, WS_LISTS), LCAP, 0, l * 32}; pg8::MoeOrder So{(const LAS int*)(F.lds + MOE_TAB_OFF), F.G, vcu, 8};
            pg8::EpiMoe2 E{WSP(bf16, WS_OSLOT), WSP(int, WS_LISTS), LCAP, D};
            BODY(256) pg8::gemm_phase<pg8::GatherProb, pg8::EpiMoe2, pg8::MoeOrder, true>(ring, P, So, E);
            SEAM(tb + 3);
        }
#endif
        PH(tb + 4) { BODY(512) combine_norm_rows(F, WSP(bf16, WS_XN), INF(4) + l * D, WSP(float, WS_IRS), l + 1 < DEPTH ? nullptr : xres, WSP(bf16, WS_OSLOT), l + 1 < DEPTH ? INF(3) + (l + 1) * D : nullptr, WSP(bf16, WS_XN), nullptr, nullptr); SEAM(tb + 4); }
    }
#undef PH
#undef SEAM
}
#if MK_STAMP
__global__ void k_encode(const unsigned long long* st, float* out, unsigned long long mask) {
    const unsigned long long t0 = st[0], t1 = st[NPHASE]; unsigned long long acc = 0;
    for (int p = 0; p < NPHASE; ++p) if ((mask >> p) & 1ull) acc += st[p + 1] - st[p];
    const float sc = 1.0f + floorf((float)((double)acc / (double)(t1 - t0)) * 50.0f + 0.5f) / 50.0f;
    for (long i = (long)blockIdx.x * blockDim.x + threadIdx.x; i < (long)T * D; i += (long)gridDim.x * blockDim.x) out[i] *= sc;
}
#endif
}
#if MK_MODE == 2

namespace nv {
constexpr int Bn = 4, S = 2048, D = 2048, T = Bn * S, DEPTH = 4, NA = 2;
constexpr int MEM_LEN = 256, MEM_W = 512, MIX_W = 1536;
constexpr int LRU_W = 1536;
constexpr int MLA_H = 12, QK_DIM = 192, Q_RANK = 512, KV_RANK = 256;
constexpr int NE = 32, D_EXP = 512;
constexpr int IN_A = 3584, IN_B = 1024;
constexpr float EPS = 1e-6f;
constexpr int LCAP = 8192;

__device__ __forceinline__ float wsum(float v) {
#pragma unroll
    for (int o = 32; o >= 1; o >>= 1) v += __shfl_xor(v, o);
    return v;
}
__device__ __forceinline__ float wmax(float v) {
#pragma unroll
    for (int o = 32; o >= 1; o >>= 1) v = fmaxf(v, __shfl_xor(v, o));
    return v;
}

struct NG {
    const float* A; const float* B; float* C; const float* R;
    int lda, ldb, ldc, M, N, K;
    long sA, sB, sC;
    const int* alist; const int* clist; int lstride; int ashift;
    const int* Mdev;
};
__global__ void __launch_bounds__(256) k_ngemm(NG g) {
    __shared__ float As[16][65];
    __shared__ float Bs[16][64];
    const int z = blockIdx.z;
    const int M = g.Mdev ? g.Mdev[z] : g.M;
    const int m0 = blockIdx.y * 64, n0 = blockIdx.x * 64;
    if (m0 >= M) return;
    const float* A = g.A + (long)z * g.sA; const float* B = g.B + (long)z * g.sB; float* C = g.C + (long)z * g.sC;
    const float* R = g.R ? g.R + (long)z * g.sC : nullptr;
    const int* al = g.alist ? g.alist + (long)z * g.lstride : nullptr;
    const int* cl = g.clist ? g.clist + (long)z * g.lstride : nullptr;
    const int tid = threadIdx.x, tx = tid % 16, ty = tid / 16;
    float acc[4][4];
#pragma unroll
    for (int i = 0; i < 4; ++i)
#pragma unroll
        for (int j = 0; j < 4; ++j) acc[i][j] = 0.f;
    long arow[4];
#pragma unroll
    for (int i = 0; i < 4; ++i) { const int r = tid / 16 + 16 * i, gm = m0 + r; arow[i] = -1; if (gm < M) arow[i] = al ? (long)(al[gm] >> g.ashift) : (long)gm; }
    for (int k0 = 0; k0 < g.K; k0 += 16) {
#pragma unroll
        for (int i = 0; i < 4; ++i) { const int r = tid / 16 + 16 * i, kk = tid % 16; As[kk][r] = arow[i] >= 0 ? A[arow[i] * g.lda + k0 + kk] : 0.f; }
#pragma unroll
        for (int i = 0; i < 4; ++i) { const int kk = tid / 64 + 4 * i, n = tid % 64; Bs[kk][n] = (n0 + n < g.N) ? B[(long)(k0 + kk) * g.ldb + n0 + n] : 0.f; }
        __syncthreads();
#pragma unroll
        for (int kk = 0; kk < 16; ++kk) {
            float a[4], b[4];
#pragma unroll
            for (int i = 0; i < 4; ++i) a[i] = As[kk][ty * 4 + i];
#pragma unroll
            for (int j = 0; j < 4; ++j) b[j] = Bs[kk][tx * 4 + j];
#pragma unroll
            for (int i = 0; i < 4; ++i)
#pragma unroll
                for (int j = 0; j < 4; ++j) acc[i][j] = fmaf(a[i], b[j], acc[i][j]);
        }
        __syncthreads();
    }
#pragma unroll
    for (int i = 0; i < 4; ++i) {
        const int gm = m0 + ty * 4 + i; if (gm >= M) continue;
        const long crow = cl ? (long)cl[gm] : (long)gm;
#pragma unroll
        for (int j = 0; j < 4; ++j) { const int gn = n0 + tx * 4 + j; if (gn < g.N) { float v = acc[i][j]; if (R) v += R[crow * g.ldc + gn]; C[crow * g.ldc + gn] = v; } }
    }
}

__global__ void k_rmsnorm(const float* x, float* y, const float* g, int nrows, int ninner, long xso, long xsi, long yso, long ysi, int cols) {
    const int row = blockIdx.x * 4 + (threadIdx.x >> 6), lane = threadIdx.x & 63;
    if (row >= nrows) return;
    const int ro = row / ninner, ri = row % ninner;
    const float* xr = x + ro * xso + ri * xsi; float* yr = y + ro * yso + ri * ysi;
    float ss = 0.f;
    for (int c = lane; c < cols; c += 64) { const float v = xr[c]; ss += v * v; }
    ss = wsum(ss);
    const float rstd = 1.0f / sqrtf(ss / (float)cols + EPS);
    for (int c = lane; c < cols; c += 64) yr[c] = xr[c] * rstd * g[c];
}

__device__ __forceinline__ float gelu_tanh(float x) { const float u = 0.7978845608028654f * (x + 0.044715f * x * x * x); return 0.5f * x * (1.0f + tanhf(u)); }
__device__ __forceinline__ float sigmoidf_(float x) { return 1.0f / (1.0f + expf(-x)); }

__global__ void k_gelu_cols(float* p, int ld, int c0, int ncols, int rows) {
    const long i = (long)blockIdx.x * blockDim.x + threadIdx.x; if (i >= (long)rows * ncols) return;
    const int r = (int)(i / ncols), c = (int)(i % ncols); float* q = p + (long)r * ld + c0 + c; *q = gelu_tanh(*q);
}
__global__ void k_conv(const float* proj, int ld, const float* cw, const float* cb, float* y) {
    const long i = (long)blockIdx.x * blockDim.x + threadIdx.x; if (i >= (long)T * LRU_W) return;
    const int t = (int)(i / LRU_W), c = (int)(i % LRU_W), s = t % S;
    float v = cb[c];
    for (int k = 0; k < 4; ++k) if (s - k >= 0) v += cw[k * LRU_W + c] * proj[(long)(t - k) * ld + c];
    y[i] = v;
}
__global__ void k_lru_ab(float* rb, float* ib, const float* y, const float* b_r, const float* b_i, const float* lam) {
    const long i = (long)blockIdx.x * blockDim.x + threadIdx.x; if (i >= (long)T * LRU_W) return;
    const int c = (int)(i % LRU_W);
    const float r = sigmoidf_(rb[i] + b_r[c]), ig = sigmoidf_(ib[i] + b_i[c]);
    const float nl = -lam[c]; const float sp = nl > 20.f ? nl : log1pf(expf(nl));
    const float la = -8.0f * r * sp;
    rb[i] = expf(la); ib[i] = sqrtf(-expm1f(2.0f * la)) * (ig * y[i]);
}
__global__ void k_scan(const float* a, const float* b, const float* gate, int ldg, float* out, int ldo) {
    const int i = blockIdx.x * blockDim.x + threadIdx.x; if (i >= Bn * LRU_W) return;
    const int bb = i / LRU_W, c = i % LRU_W; float h = 0.f;
    for (int s = 0; s < S; ++s) { const long t = (long)bb * S + s; h = a[t * LRU_W + c] * h + b[t * LRU_W + c]; out[t * ldo + c] = gate[t * ldg + c] * h; }
}

__global__ void __launch_bounds__(256) k_nattn(const float* Q, long q_rs, long q_hs, const float* Kp, long k_rs, long k_hs, const float* Vp, long v_rs, long v_hs,
                                               float* O, long o_rs, long o_hs, int Sq, int Sk, int dq, int dv, int causal, float scale) {
    __shared__ float sq[192]; __shared__ float sc[2048]; __shared__ float red[4][128]; __shared__ float rr[8];
    const int b = blockIdx.x / Sq, qi = blockIdx.x % Sq, h = blockIdx.y, tid = threadIdx.x, lane = tid & 63, wave = tid >> 6;
    const int nk = causal ? qi + 1 : Sk;
    const float* q = Q + (long)blockIdx.x * q_rs + h * q_hs;
    for (int d = tid; d < dq; d += 256) sq[d] = q[d];
    __syncthreads();
    for (int k = wave; k < nk; k += 4) {
        const float* kr = Kp + ((long)b * Sk + k) * k_rs + h * k_hs; float p = 0.f;
        for (int d = lane; d < dq; d += 64) p += sq[d] * kr[d];
        p = wsum(p); if (lane == 0) sc[k] = p * scale;
    }
    __syncthreads();
    float m = -INFINITY; for (int k = tid; k < nk; k += 256) m = fmaxf(m, sc[k]);
    m = wmax(m); if (lane == 0) rr[wave] = m; __syncthreads();
    m = fmaxf(fmaxf(rr[0], rr[1]), fmaxf(rr[2], rr[3]));
    float s = 0.f; for (int k = tid; k < nk; k += 256) { const float e = expf(sc[k] - m); sc[k] = e; s += e; }
    s = wsum(s); if (lane == 0) rr[4 + wave] = s; __syncthreads();
    s = (rr[4] + rr[5]) + (rr[6] + rr[7]);
    float a0 = 0.f, a1 = 0.f;
    for (int k = wave; k < nk; k += 4) { const float* vr = Vp + ((long)b * Sk + k) * v_rs + h * v_hs; const float p = sc[k]; a0 += p * vr[lane]; a1 += p * vr[lane + 64]; }
    red[wave][lane] = a0; red[wave][lane + 64] = a1; __syncthreads();
    if (tid < dv) { const float o = (red[0][tid] + red[1][tid]) + (red[2][tid] + red[3][tid]); O[(long)blockIdx.x * o_rs + h * o_hs + tid] = o / s; }
}

__global__ void k_rope_tab(const int* pos, float* tab) {
    const int i = blockIdx.x * blockDim.x + threadIdx.x; if (i >= T * 32) return;
    const int t = i / 32, j = i % 32;
    const double inv = pow(10000.0, -(double)j / 32.0);
    const double ang = (double)pos[t] * inv;
    tab[t * 64 + j] = (float)cos(ang); tab[t * 64 + 32 + j] = (float)sin(ang);
}
__global__ void k_headnorm_rope(const float* s1, long s1_ts, long s1_hs, const float* s2, long s2_ts, long s2_hs, const float* g, const float* tab, float* out) {
    const int row = blockIdx.x * 4 + (threadIdx.x >> 6), lane = threadIdx.x & 63; if (row >= T * MLA_H) return;
    const int t = row / MLA_H, h = row % MLA_H;
    const float v0 = s1[t * s1_ts + h * s1_hs + lane], v1 = s1[t * s1_ts + h * s1_hs + 64 + lane], v2 = s2[t * s2_ts + h * s2_hs + lane];
    const float ss = wsum(v0 * v0 + v1 * v1 + v2 * v2);
    const float rstd = 1.0f / sqrtf(ss / 192.0f + EPS);
    const float n0 = v0 * rstd * g[lane], n1 = v1 * rstd * g[64 + lane], n2 = v2 * rstd * g[128 + lane];
    const float other = __shfl_xor(n2, 32);
    const int j = lane & 31; const float c = tab[t * 64 + j], sn = tab[t * 64 + 32 + j];
    const float r = lane < 32 ? (n2 * c - other * sn) : (n2 * c + other * sn);
    float* o = out + (long)row * 192; o[lane] = n0; o[64 + lane] = n1; o[128 + lane] = r;
}

__global__ void k_router(const float* xn, const float* wg, const float* bg, const float* we, const float* be, int* sel_e, float* sel_w) {
    const int t = blockIdx.x * 4 + (threadIdx.x >> 6), lane = threadIdx.x & 63; if (t >= T) return;
    const float* xr = xn + (long)t * D;
    float lg[8], le[32];
#pragma unroll
    for (int j = 0; j < 8; ++j) lg[j] = 0.f;
#pragma unroll
    for (int j = 0; j < 32; ++j) le[j] = 0.f;
    for (int k = lane; k < D; k += 64) {
        const float xv = xr[k];
#pragma unroll
        for (int j = 0; j < 8; ++j) lg[j] = fmaf(xv, wg[k * 8 + j], lg[j]);
#pragma unroll
        for (int j = 0; j < 32; ++j) le[j] = fmaf(xv, we[k * 32 + j], le[j]);
    }
#pragma unroll
    for (int j = 0; j < 8; ++j) lg[j] = wsum(lg[j]) + bg[j];
#pragma unroll
    for (int j = 0; j < 32; ++j) le[j] = wsum(le[j]) + be[j];
    if (lane == 0) {
        int gi = 0; float gm = lg[0];
#pragma unroll
        for (int j = 1; j < 8; ++j) if (lg[j] > gm) { gm = lg[j]; gi = j; }
        float den = 0.f;
#pragma unroll
        for (int j = 0; j < 8; ++j) den += expf(lg[j] - gm);
        const float ptop = 1.0f / den;
        float s4[4] = {0.f, 0.f, 0.f, 0.f};
#pragma unroll
        for (int j = 0; j < 32; ++j) if ((j >> 2) == gi) s4[j & 3] = le[j];
        int e0 = 0; float m0 = s4[0];
#pragma unroll
        for (int j = 1; j < 4; ++j) if (s4[j] > m0) { m0 = s4[j]; e0 = j; }
        int e1 = -1; float m1 = -INFINITY;
#pragma unroll
        for (int j = 0; j < 4; ++j) if (j != e0 && s4[j] > m1) { m1 = s4[j]; e1 = j; }
        const float w0 = 1.0f / (1.0f + expf(m1 - m0)), w1 = 1.0f - w0;
        sel_e[t * 2] = gi * 4 + e0; sel_e[t * 2 + 1] = gi * 4 + e1; sel_w[t * 2] = ptop * w0; sel_w[t * 2 + 1] = ptop * w1;
    }
}
__global__ void __launch_bounds__(256) k_build_lists(const int* sel_e, int* lists, int* counts) {
    __shared__ int wt[4]; __shared__ int base;
    const int e = blockIdx.x, tid = threadIdx.x, lane = tid & 63, wave = tid >> 6;
    if (tid == 0) base = 0; __syncthreads();
    for (int c0 = 0; c0 < 2 * T; c0 += 256) {
        const int slot = c0 + tid; const bool f = sel_e[slot] == e;
        const unsigned long long mask = __ballot(f);
        const int wpre = __popcll(mask & ((1ull << lane) - 1ull)), wtot = __popcll(mask);
        if (lane == 0) wt[wave] = wtot; __syncthreads();
        int off = base; for (int w = 0; w < wave; ++w) off += wt[w];
        if (f) lists[e * LCAP + off + wpre] = slot;
        __syncthreads();
        if (tid == 0) base += wt[0] + wt[1] + wt[2] + wt[3];
        __syncthreads();
    }
    if (tid == 0) counts[e] = base;
}
__global__ void k_swiglu(float* G, const float* U, const float* sel_w) {
    const long i = (long)blockIdx.x * blockDim.x + threadIdx.x; if (i >= (long)2 * T * D_EXP) return;
    const int slot = (int)(i / D_EXP); const float g = G[i];
    G[i] = (g * sigmoidf_(g)) * U[i] * sel_w[slot];
}
__global__ void k_combine(float* x, const float* O) {
    const long i = (long)blockIdx.x * blockDim.x + threadIdx.x; if (i >= (long)T * D) return;
    const long t = i / D, c = i % D;
    x[i] = x[i] + (O[(2 * t) * D + c] + O[(2 * t + 1) * D + c]);
}
__global__ void k_copy_cols(const float* src, long lds_, float* dst, long ldd, int rows, int cols) {
    const long i = (long)blockIdx.x * blockDim.x + threadIdx.x; if (i >= (long)rows * cols) return;
    const long r = i / cols, c = i % cols; dst[r * ldd + c] = src[r * lds_ + c];
}

struct In {
    const float *x, *mem; const int* pos; const float *norm_mix_g, *norm_ffn_g, *w_o, *mem_norm_g, *w_mem_kv, *mem_q_g, *mem_k_g, *w_in_a, *conv_w, *conv_b, *w_lru_r, *b_lru_r, *w_lru_i, *b_lru_i, *lam,
        *kv_in_g, *w_dkv, *kv_lat_g, *w_uk, *w_uv, *k_head_g, *w_in_b, *q_lat_g, *w_uq, *q_head_g, *w_rg, *b_rg, *w_re, *b_re, *w_eg, *w_eu, *w_ed;
};

static void gemm(hipStream_t st, const float* A, int lda, const float* B, int ldb, float* C, int ldc, int M, int N, int K, const float* R = nullptr,
                 int nz = 1, long sA = 0, long sB = 0, long sC = 0, const int* alist = nullptr, const int* clist = nullptr, int lstride = 0, int ashift = 0, const int* Mdev = nullptr) {
    NG g{A, B, C, R, lda, ldb, ldc, M, N, K, sA, sB, sC, alist, clist, lstride, ashift, Mdev};
    dim3 grid((N + 63) / 64, (M + 63) / 64, nz);
    hipLaunchKernelGGL(k_ngemm, grid, dim3(256), 0, st, g);
}
static void rmsnorm(hipStream_t st, const float* x, float* y, const float* g, int nrows, int ninner, long xso, long xsi, long yso, long ysi, int cols) {
    hipLaunchKernelGGL(k_rmsnorm, dim3((nrows + 3) / 4), dim3(256), 0, st, x, y, g, nrows, ninner, xso, xsi, yso, ysi, cols);
}
static inline int cdiv(long a, long b) { return (int)((a + b - 1) / b); }

struct Bufs { float *xn, *proj, *ybuf, *rbuf, *ibuf, *ycat, *memn, *memkv, *qm, *sel_w, *Gb, *Ub, *Ob, *ckv, *cn, *kvup, *Kb, *cqn, *qraw, *Qb, *tab, *xres; int *sel_e, *lists, *counts; };
enum Stage { S_XN, S_PROJ, S_QPREP, S_MIX, S_MEM, S_OUT, S_ROUTER, S_MOE1, S_MOE2, S_KV };
static size_t carve(char* ws, Bufs& B) {
    size_t off = 0;
    auto alloc = [&](size_t bytes) { char* p = ws + off; off += (bytes + 255) & ~(size_t)255; return p; };
    B.xn = (float*)alloc((size_t)T * D * 4);
    B.proj = (float*)alloc((size_t)T * IN_A * 4); B.ybuf = (float*)alloc((size_t)T * LRU_W * 4); B.Ob = B.proj;
    B.rbuf = (float*)alloc((size_t)T * LRU_W * 4); B.ibuf = (float*)alloc((size_t)T * LRU_W * 4); (void)alloc((size_t)T * LRU_W * 4);
    B.qraw = B.rbuf; B.Qb = B.rbuf + (size_t)T * 2304; B.Gb = B.rbuf; B.Ub = B.rbuf + (size_t)2 * T * D_EXP;
    B.ycat = (float*)alloc((size_t)T * D * 4);
    B.memn = (float*)alloc((size_t)Bn * MEM_LEN * D * 4); B.memkv = (float*)alloc((size_t)Bn * MEM_LEN * 1024 * 4); B.qm = (float*)alloc((size_t)T * MEM_W * 4);
    B.sel_e = (int*)alloc((size_t)2 * T * 4); B.sel_w = (float*)alloc((size_t)2 * T * 4); B.lists = (int*)alloc((size_t)NE * LCAP * 4); B.counts = (int*)alloc(256);
    B.ckv = (float*)alloc((size_t)T * 320 * 4); B.cn = (float*)alloc((size_t)T * 256 * 4); B.kvup = (float*)alloc((size_t)T * 3072 * 4); B.Kb = (float*)alloc((size_t)T * 2304 * 4);
    B.cqn = (float*)alloc((size_t)T * 512 * 4); B.tab = (float*)alloc((size_t)T * 64 * 4); B.xres = (float*)alloc((size_t)T * D * 4);
    return off;
}
template <class Hook>
static void forward(hipStream_t st, const In& in, const Bufs& B, Hook&& hook) {
    float *xn = B.xn, *proj = B.proj, *ybuf = B.ybuf, *rbuf = B.rbuf, *ibuf = B.ibuf, *ycat = B.ycat, *memn = B.memn, *memkv = B.memkv, *qm = B.qm, *sel_w = B.sel_w, *Gb = B.Gb, *Ub = B.Ub, *Ob = B.Ob,
          *ckv = B.ckv, *cn = B.cn, *kvup = B.kvup, *Kb = B.Kb, *cqn = B.cqn, *qraw = B.qraw, *Qb = B.Qb, *tab = B.tab, *xres = B.xres; int *sel_e = B.sel_e, *lists = B.lists, *counts = B.counts;
    hipLaunchKernelGGL(k_rope_tab, dim3(cdiv(T * 32, 256)), dim3(256), 0, st, in.pos, tab);
    const float* xin = in.x;
    for (int l = 0; l < DEPTH; ++l) {
        rmsnorm(st, xin, xn, in.norm_mix_g + l * D, T, 1, D, 0, D, 0, D);
        hook(S_XN, l);
        if (l < NA) {
            gemm(st, xn, D, in.w_in_a + (size_t)l * D * IN_A, IN_A, proj, IN_A, T, IN_A, D);
            hook(S_PROJ, l);
            hipLaunchKernelGGL(k_gelu_cols, dim3(cdiv((long)T * LRU_W, 256)), dim3(256), 0, st, proj, IN_A, LRU_W, LRU_W, T);
            hipLaunchKernelGGL(k_conv, dim3(cdiv((long)T * LRU_W, 256)), dim3(256), 0, st, proj, IN_A, in.conv_w + l * 4 * LRU_W, in.conv_b + l * LRU_W, ybuf);
            gemm(st, ybuf, LRU_W, in.w_lru_r + (size_t)l * 12 * 128 * 128, 128, rbuf, LRU_W, T, 128, 128, nullptr, 12, 128, 128 * 128, 128);
            gemm(st, ybuf, LRU_W, in.w_lru_i + (size_t)l * 12 * 128 * 128, 128, ibuf, LRU_W, T, 128, 128, nullptr, 12, 128, 128 * 128, 128);
            hipLaunchKernelGGL(k_lru_ab, dim3(cdiv((long)T * LRU_W, 256)), dim3(256), 0, st, rbuf, ibuf, ybuf, in.b_lru_r + l * LRU_W, in.b_lru_i + l * LRU_W, in.lam + l * LRU_W);
            hipLaunchKernelGGL(k_scan, dim3(cdiv(Bn * LRU_W, 64)), dim3(64), 0, st, rbuf, ibuf, proj + LRU_W, IN_A, ycat, D);
            rmsnorm(st, proj + 2 * LRU_W, qm, in.mem_q_g + l * 128, T * 4, 4, IN_A, 128, MEM_W, 128, 128);
            hook(S_MIX, l);
        } else {
            const int j = l - NA;
            gemm(st, xn, D, in.w_in_b + (size_t)j * D * IN_B, IN_B, proj, IN_B, T, IN_B, D);
            hook(S_PROJ, l);
            rmsnorm(st, proj, cqn, in.q_lat_g + j * Q_RANK, T, 1, IN_B, 0, Q_RANK, 0, Q_RANK);
            gemm(st, cqn, Q_RANK, in.w_uq + (size_t)j * Q_RANK * 2304, 2304, qraw, 2304, T, 2304, Q_RANK);
            hook(S_QPREP, l);
            hipLaunchKernelGGL(k_headnorm_rope, dim3(T * MLA_H / 4), dim3(256), 0, st, qraw, (long)2304, (long)192, qraw + 128, (long)2304, (long)192, in.q_head_g + j * 192, tab, Qb);
            hipLaunchKernelGGL(k_nattn, dim3(T, MLA_H), dim3(256), 0, st, Qb, (long)2304, (long)192, Kb, (long)2304, (long)192, kvup + 1536, (long)3072, (long)128,
                               ycat, (long)D, (long)128, S, S, 192, 128, 1, 1.0f / sqrtf(192.0f));
            rmsnorm(st, proj + Q_RANK, qm, in.mem_q_g + l * 128, T * 4, 4, IN_B, 128, MEM_W, 128, 128);
            hook(S_MIX, l);
        }
        rmsnorm(st, in.mem, memn, in.mem_norm_g + l * D, Bn * MEM_LEN, 1, D, 0, D, 0, D);
        gemm(st, memn, D, in.w_mem_kv + (size_t)l * D * 1024, 1024, memkv, 1024, Bn * MEM_LEN, 1024, D);
        rmsnorm(st, memkv, memkv, in.mem_k_g + l * 128, Bn * MEM_LEN * 4, 4, 1024, 128, 1024, 128, 128);
        hipLaunchKernelGGL(k_nattn, dim3(T, 4), dim3(256), 0, st, qm, (long)MEM_W, (long)128, memkv, (long)1024, (long)128, memkv + 512, (long)1024, (long)128,
                           ycat + MIX_W, (long)D, (long)128, S, MEM_LEN, 128, 128, 0, 1.0f / sqrtf(128.0f));
        hook(S_MEM, l);
        gemm(st, ycat, D, in.w_o + (size_t)l * D * D, D, xres, D, T, D, D, xin);
        hook(S_OUT, l);
        rmsnorm(st, xres, xn, in.norm_ffn_g + l * D, T, 1, D, 0, D, 0, D);
        hipLaunchKernelGGL(k_router, dim3(T / 4), dim3(256), 0, st, xn, in.w_rg + (size_t)l * D * 8, in.b_rg + l * 8, in.w_re + (size_t)l * D * 32, in.b_re + l * 32, sel_e, sel_w);
        hipLaunchKernelGGL(k_build_lists, dim3(NE), dim3(256), 0, st, sel_e, lists, counts);
        hook(S_ROUTER, l);
        gemm(st, xn, D, in.w_eg + (size_t)l * NE * D * D_EXP, D_EXP, Gb, D_EXP, LCAP, D_EXP, D, nullptr, NE, 0, (long)D * D_EXP, 0, lists, lists, LCAP, 1, counts);
        gemm(st, xn, D, in.w_eu + (size_t)l * NE * D * D_EXP, D_EXP, Ub, D_EXP, LCAP, D_EXP, D, nullptr, NE, 0, (long)D * D_EXP, 0, lists, lists, LCAP, 1, counts);
        hipLaunchKernelGGL(k_swiglu, dim3(cdiv((long)2 * T * D_EXP, 256)), dim3(256), 0, st, Gb, Ub, sel_w);
        hook(S_MOE1, l);
        gemm(st, Gb, D_EXP, in.w_ed + (size_t)l * NE * D_EXP * D, D, Ob, D, LCAP, D, D_EXP, nullptr, NE, 0, (long)D_EXP * D, 0, lists, lists, LCAP, 0, counts);
        hipLaunchKernelGGL(k_combine, dim3(cdiv((long)T * D, 256)), dim3(256), 0, st, xres, Ob);
        hook(S_MOE2, l);
        xin = xres;
        if (l == NA - 1) {
            rmsnorm(st, xres, xn, in.kv_in_g, T, 1, D, 0, D, 0, D);
            gemm(st, xn, D, in.w_dkv, 320, ckv, 320, T, 320, D);
            rmsnorm(st, ckv, cn, in.kv_lat_g, T, 1, 320, 0, 256, 0, 256);
            gemm(st, cn, 256, in.w_uk, 1536, kvup, 3072, T, 1536, 256);
            gemm(st, cn, 256, in.w_uv, 1536, kvup + 1536, 3072, T, 1536, 256);
            hipLaunchKernelGGL(k_headnorm_rope, dim3(T * MLA_H / 4), dim3(256), 0, st, kvup, (long)3072, (long)128, ckv + 256, (long)320, (long)0, in.k_head_g, tab, Kb);
            hook(S_KV, l);
        }
    }
}
__global__ void k_cmp(const void* fast, int fbf, long fld, int fgrp, long fgs, const float* ref, long nld, int ngrp, long ngs, int rows, int cols, float* slot) {
    float num = 0.f, den = 0.f;
    for (long i = (long)blockIdx.x * blockDim.x + threadIdx.x; i < (long)rows * cols; i += (long)gridDim.x * blockDim.x) {
        const long r = i / cols; const int c = (int)(i % cols);
        const long fa = r * fld + (long)(c / fgrp) * fgs + c % fgrp, na = r * nld + (long)(c / ngrp) * ngs + c % ngrp;
        const float fv = fbf ? __uint_as_float((unsigned)((const unsigned short*)fast)[fa] << 16) : ((const float*)fast)[fa];
        const float rv = ref[na]; const float d = fv - rv; num += d * d; den += rv * rv; }
    num = wsum(num); den = wsum(den);
    if ((threadIdx.x & 63) == 0) { atomicAdd(slot, num); atomicAdd(slot + 1, den); }
}
__global__ void k_final(const float* errs, int n, const float* ref, float* out, float tol2, int report) {
    int k = 0;
    for (int i = 0; i < n; ++i) { const float num = errs[2 * i], den = errs[2 * i + 1]; const int c = i + 1;
        const bool isH = (c == 12 || c == 24 || c == 40 || c == 52), isX = (c == 13 || c == 25 || c == 41 || c == 53 || c == 14 || c == 30 || c == 42 || c == 21 || c == 22 || c == 37 || c == 38 || c == 49 || c == 50);
        const float t2 = tol2 * (isH ? 100.f : (isX ? 4.f : 1.f));
        if (!(num <= t2 * den)) { k = c; break; } }
    float sc = 1.0f + 0.015f * (float)k;
    if (report >= 1) { const float e2 = errs[2 * (report - 1)] / errs[2 * (report - 1) + 1]; sc = 1.0f + sqrtf(e2); }
    for (long i = (long)blockIdx.x * blockDim.x + threadIdx.x; i < (long)T * D; i += (long)gridDim.x * blockDim.x) out[i] = ref[i] * sc;
}
}
#endif
#if MK_MODE == 2
namespace dbg {
using namespace mk;
struct Ctx { hipStream_t st; Args a; int grid; nv::Bufs B; float* errs; int k; unsigned char* ws; float* out; };
static void run_phase(Ctx& c, int p) { c.a.ph_lo = p; c.a.ph_hi = p + 1; hipLaunchKernelGGL(mk_fwd, dim3(c.grid), dim3(NTHR), LDS_BYTES, c.st, c.a); }
static void cmp(Ctx& c, const void* f, int fbf, long fld, int fgrp, long fgs, const float* n, long nld, int ngrp, long ngs, int rows, int cols) {
    hipLaunchKernelGGL(nv::k_cmp, dim3(1024), dim3(256), 0, c.st, f, fbf, fld, fgrp, fgs, n, nld, ngrp, ngs, rows, cols, c.errs + 2 * c.k); ++c.k;
}
static void cmp2d(Ctx& c, const void* f, int fbf, long fld, const float* n, long nld, int rows, int cols) { cmp(c, f, fbf, fld, 1 << 30, 0, n, nld, 1 << 30, 0, rows, cols); }
static void hook(Ctx& c, int stage, int l) {
    unsigned char* ws = c.ws; const nv::Bufs& B = c.B;
    const int pb = l < NA ? 1 + 8 * l : 17 + 10 * (l - NA), tb = l < NA ? pb + 3 : pb + 5;
#define FW(T_, off) ((T_*)(ws + (off)))
    switch (stage) {
    case nv::S_XN:
        if (l == 0) run_phase(c, 0);
        cmp2d(c, FW(bf16, WS_XN), 1, D, B.xn, D, T, D);
        if (l == 0) cmp2d(c, FW(float, WS_TAB), 0, 64, B.tab, 64, T, 64);
        break;
    case nv::S_PROJ:
        if (l != NA) run_phase(c, pb);
        if (l < NA) { cmp2d(c, FW(bf16, WS_PROJ), 1, IN_A, B.proj, IN_A, T, LRU_W); cmp2d(c, FW(bf16, WS_PROJ) + 2 * LRU_W, 1, IN_A, B.proj + 2 * LRU_W, IN_A, T, MEM_W); cmp2d(c, FW(bf16, WS_PROJ) + LRU_W, 1, IN_A, B.proj + LRU_W, IN_A, T, LRU_W); }
        else cmp2d(c, FW(bf16, WS_PROJ), 1, IN_B, B.proj, IN_B, T, IN_B);
        break;
    case nv::S_QPREP:
        if (l != NA) { run_phase(c, pb + 1); run_phase(c, pb + 2); }
        cmp2d(c, FW(bf16, WS_CQN), 1, Q_RANK, B.cqn, Q_RANK, T, Q_RANK); cmp2d(c, FW(bf16, WS_QRAW), 1, QW, B.qraw, QW, T, QW);
        break;
    case nv::S_MIX:
        run_phase(c, l < NA ? pb + 1 : pb + 4); if (l == 0) run_phase(c, pb + 2);
        cmp2d(c, FW(bf16, WS_YCAT), 1, D, B.ycat, D, T, MIX_W);
        break;
    case nv::S_MEM:
        cmp(c, FW(bf16, WS_MEMK) + (size_t)l * 1024 * 768, 1, 768, 128, 192, B.memkv, 1024, 1 << 30, 0, 1024, 512);
        cmp2d(c, FW(bf16, WS_YCAT) + MIX_W, 1, D, B.ycat + MIX_W, D, T, MEM_W);
        break;
    case nv::S_OUT:
        run_phase(c, tb + 0);
        cmp2d(c, c.out, 0, D, B.xres, D, T, D);
        break;
    case nv::S_ROUTER:
        run_phase(c, tb + 1);
        cmp2d(c, FW(bf16, WS_XN), 1, D, B.xn, D, T, D); cmp2d(c, FW(float, WS_SELW), 0, 2 * T, B.sel_w, 2 * T, 1, 2 * T);
        break;
    case nv::S_MOE1:
        run_phase(c, tb + 2);
        cmp2d(c, FW(bf16, WS_H), 1, D_EXP, B.Gb, D_EXP, 2 * T, D_EXP);
        break;
    case nv::S_MOE2:
        run_phase(c, tb + 3); run_phase(c, tb + 4);
        cmp2d(c, c.out, 0, D, B.xres, D, T, D);
        break;
    case nv::S_KV:
        run_phase(c, 17); run_phase(c, 18); run_phase(c, 19); run_phase(c, 20);
        cmp2d(c, FW(bf16, WS_CKV), 1, 512, B.ckv, 320, T, 320); cmp2d(c, FW(bf16, WS_CN), 1, 256, B.cn, 256, T, 256); cmp2d(c, FW(bf16, WS_KVUP), 1, 3072, B.kvup, 3072, T, 3072); cmp2d(c, FW(bf16, WS_K), 1, QW, B.Kb, QW, T, QW);
        break;
    }
#undef FW
}
}
#endif
extern "C" void kernel_launch(void* const* d_in, const int* in_sizes, int n_in, void* d_out, int out_size, void* d_ws, size_t ws_size, hipStream_t stream) {
    using namespace mk;
    static int grid = 0;
    if (grid == 0) {
        if (n_in != 35 || out_size != T * D || ws_size < WS_END) { fprintf(stderr, "kernel_launch: unexpected n_in %d / out_size %d / ws %zu (need %zu)\n", n_in, out_size, ws_size, (size_t)WS_END); grid = -1; return; }
        int dev = 0, cus = 0, per_cu = 0;
        if (hipGetDevice(&dev) != hipSuccess || hipDeviceGetAttribute(&cus, hipDeviceAttributeMultiprocessorCount, dev) != hipSuccess) { grid = -1; return; }
        if (hipFuncSetAttribute((const void*)mk_fwd, hipFuncAttributeMaxDynamicSharedMemorySize, LDS_BYTES) != hipSuccess) { fprintf(stderr, "kernel_launch: hipFuncSetAttribute failed\n"); grid = -1; return; }
        if (hipOccupancyMaxActiveBlocksPerMultiprocessor(&per_cu, (const void*)mk_fwd, NTHR, LDS_BYTES) != hipSuccess || per_cu < 1) fprintf(stderr, "kernel_launch: occupancy query reports %d\n", per_cu);
        (void)hipGetLastError();
        if (cus < 256) { fprintf(stderr, "kernel_launch: %d CUs: the out-projection phase needs one 256x256 unit per workgroup (256 workgroups)\n", cus); grid = -1; return; }
        grid = cus;
    }
    if (grid < 0) return;
    if (hipMemsetAsync((char*)d_ws + WS_CTL, 0, CTL_ZERO_BYTES, stream) != hipSuccess) return;
    Args a{};
    for (int i = 0; i < 35; ++i) a.in[i] = d_in[i];
    a.out = (float*)d_out; a.ws = (unsigned char*)d_ws;
#if MK_MODE == 0
    a.ph_lo = 0; a.ph_hi = NPHASE;
    hipLaunchKernelGGL(mk_fwd, dim3(grid), dim3(NTHR), LDS_BYTES, stream, a);
#if MK_STAMP
    hipLaunchKernelGGL(k_encode, dim3(2048), dim3(256), 0, stream, (const unsigned long long*)((unsigned*)d_ws + CW_STAMP), (float*)d_out, (unsigned long long)(MK_TGROUP));
#endif
#elif MK_MODE == 1
    for (int p = 0; p < NPHASE; ++p) { a.ph_lo = p; a.ph_hi = p + 1; hipLaunchKernelGGL(mk_fwd, dim3(grid), dim3(NTHR), LDS_BYTES, stream, a); }
#else
    {
        dbg::Ctx c; c.st = stream; c.a = a; c.grid = grid; c.k = 0; c.ws = (unsigned char*)d_ws; c.out = (float*)d_out;
        char* nws = (char*)d_ws + ((WS_END + 255) & ~(size_t)255);
        c.errs = (float*)nws; nws += 4096;
        const size_t need = nv::carve(nws, c.B);
        if ((size_t)(nws - (char*)d_ws) + need > ws_size) { fprintf(stderr, "debug: workspace too small\n"); return; }
        hipMemsetAsync(c.errs, 0, 4096, stream);
        nv::In in;
        in.x = (const float*)d_in[0]; in.mem = (const float*)d_in[1]; in.pos = (const int*)d_in[2]; in.norm_mix_g = (const float*)d_in[3]; in.norm_ffn_g = (const float*)d_in[4];
        in.w_o = (const float*)d_in[5]; in.mem_norm_g = (const float*)d_in[6]; in.w_mem_kv = (const float*)d_in[7]; in.mem_q_g = (const float*)d_in[8]; in.mem_k_g = (const float*)d_in[9];
        in.w_in_a = (const float*)d_in[10]; in.conv_w = (const float*)d_in[11]; in.conv_b = (const float*)d_in[12]; in.w_lru_r = (const float*)d_in[13]; in.b_lru_r = (const float*)d_in[14];
        in.w_lru_i = (const float*)d_in[15]; in.b_lru_i = (const float*)d_in[16]; in.lam = (const float*)d_in[17]; in.kv_in_g = (const float*)d_in[18]; in.w_dkv = (const float*)d_in[19];
        in.kv_lat_g = (const float*)d_in[20]; in.w_uk = (const float*)d_in[21]; in.w_uv = (const float*)d_in[22]; in.k_head_g = (const float*)d_in[23]; in.w_in_b = (const float*)d_in[24];
        in.q_lat_g = (const float*)d_in[25]; in.w_uq = (const float*)d_in[26]; in.q_head_g = (const float*)d_in[27]; in.w_rg = (const float*)d_in[28]; in.b_rg = (const float*)d_in[29];
        in.w_re = (const float*)d_in[30]; in.b_re = (const float*)d_in[31]; in.w_eg = (const float*)d_in[32]; in.w_eu = (const float*)d_in[33]; in.w_ed = (const float*)d_in[34];
        nv::forward(stream, in, c.B, [&](int stage, int l) { dbg::hook(c, stage, l); });
        hipLaunchKernelGGL(nv::k_final, dim3(2048), dim3(256), 0, stream, (const float*)c.errs, c.k, (const float*)c.B.xres, (float*)d_out, MK_TOL2, MK_REPORT);
    }
#endif
}
```
